# Optimizing an MI355X kernel written in HIP

```python
import jax, jax.numpy as jnp
from jax import lax
import numpy as np

D_MODEL = 1024
BATCH = 32
SEQ = 256
DEPTH = 1
DEC_BATCH = 2
DEC_SEQ = 2048
PAST_LEN = 512

GRID_W = 64
F_GROUPS = 4
F_GROUP_W = D_MODEL // 4
F_WIDTH = F_GROUPS * F_GROUP_W
D_INNER = 2 * D_MODEL
HEAD_DIM = 64
N_HEADS = D_INNER // HEAD_DIM
N_BC_GROUPS = 4
HEADS_PER_GROUP = N_HEADS // N_BC_GROUPS
D_STATE = 128
CONV_W = 5
CHUNK = 128
D_FF = 4 * D_MODEL
N_BRANCH = 2
N_MOD = 6
D_XBC = D_INNER + 2 * N_BC_GROUPS * D_STATE
D_IN_PROJ = F_WIDTH + D_INNER + D_XBC + 2 * N_HEADS + N_BRANCH * D_MODEL
SPLITS = (F_WIDTH, F_WIDTH + D_INNER, F_WIDTH + D_INNER + D_XBC,
          F_WIDTH + D_INNER + D_XBC + 2 * N_HEADS)
EPS = 1e-6

kernel_name = "hybrid_fnet_bissd_dit_step"


def rmsnorm(x, g):
    xf = x.astype(jnp.float32)
    y = xf * lax.rsqrt(jnp.mean(xf * xf, axis=-1, keepdims=True) + EPS)
    return (y * g.astype(jnp.float32)).astype(x.dtype)


def dwconv_centred(u, w, b):
    y = lax.conv_general_dilated(
        u, w[:, None, :].astype(u.dtype), window_strides=(1,),
        padding=[(CONV_W // 2, CONV_W // 2)],
        dimension_numbers=('NWC', 'WIO', 'NWC'), feature_group_count=u.shape[-1])
    return y + b.astype(u.dtype)


def fourier_mix(u, grid):
    b, l, _ = u.shape
    uf = u.astype(jnp.float32).reshape(b, l, F_GROUPS, F_GROUP_W)
    if grid:
        rows = l // GRID_W
        uf = uf.reshape(b, rows, GRID_W, F_GROUPS, F_GROUP_W)
        y = jnp.fft.fftn(uf, axes=(1, 2, 4), norm="ortho").real
    else:
        y = jnp.fft.fftn(uf, axes=(1, 3), norm="ortho").real
    return y.reshape(b, l, F_WIDTH).astype(u.dtype)


def ssd_scan(xh, dt, A, Bm, Cm, h0):
    b, l = xh.shape[:2]
    nc = l // CHUNK
    G, R = N_BC_GROUPS, HEADS_PER_GROUP
    x = xh.reshape(b, nc, CHUNK, G, R, HEAD_DIM)
    dtc = dt.reshape(b, nc, CHUNK, G, R)
    acum = jnp.cumsum(dtc * A.reshape(G, R), axis=2)
    xdt = x * dtc[..., None]
    Bc = Bm.reshape(b, nc, CHUNK, G, D_STATE)
    Cc = Cm.reshape(b, nc, CHUNK, G, D_STATE)
    seg = acum[:, :, :, None] - acum[:, :, None, :]
    lower = jnp.tril(jnp.ones((CHUNK, CHUNK), dtype=bool))[:, :, None, None]
    Lmat = jnp.exp(jnp.where(lower, seg, -jnp.inf))
    cb = jnp.einsum('bcign,bcjgn->bcijg', Cc, Bc)
    y_diag = jnp.einsum('bcijg,bcijgr,bcjgrp->bcigrp', cb, Lmat, xdt)
    decay = jnp.exp(acum[:, :, -1:] - acum)
    states = jnp.einsum('bcjgn,bcjgr,bcjgrp->bcgrpn', Bc, decay, xdt)
    chunk_decay = jnp.exp(acum[:, :, -1])

    def step(h, inp):
        s, dcy = inp
        return h * dcy[..., None, None] + s, h

    h0g = h0.reshape(b, G, R, HEAD_DIM, D_STATE)
    h_fin, h_enter = lax.scan(step, h0g, (jnp.moveaxis(states, 1, 0), jnp.moveaxis(chunk_decay, 1, 0)))
    h_enter = jnp.moveaxis(h_enter, 0, 1)
    y_off = jnp.einsum('bcign,bcgrpn,bcigr->bcigrp', Cc, h_enter, jnp.exp(acum))
    y = (y_diag + y_off).reshape(b, l, N_HEADS, HEAD_DIM)
    return y, h_fin.reshape(b, N_HEADS, HEAD_DIM, D_STATE)


def ssd_mixer(z, xbc, dt_raw, h_f0, h_b0, conv_w, conv_b, dt_bias, A_log, D_skip, norm_g):
    f32 = jnp.float32
    b, l, _ = xbc.shape
    xbc = jax.nn.silu(dwconv_centred(xbc, conv_w, conv_b))
    xs, Bm, Cm = jnp.split(xbc, [D_INNER, D_INNER + N_BC_GROUPS * D_STATE], axis=-1)
    xh = xs.astype(f32).reshape(b, l, N_HEADS, HEAD_DIM)
    Bm = Bm.astype(f32).reshape(b, l, N_BC_GROUPS, D_STATE)
    Cm = Cm.astype(f32).reshape(b, l, N_BC_GROUPS, D_STATE)
    dt = jax.nn.softplus(dt_raw.astype(f32).reshape(b, l, 2, N_HEADS) + dt_bias.astype(f32))
    A = -jnp.exp(A_log.astype(f32))
    y_f, h_f = ssd_scan(xh, dt[:, :, 0], A[0], Bm, Cm, h_f0.astype(f32))
    flip = lambda t: jnp.flip(t, axis=1)
    y_b, h_b = ssd_scan(flip(xh), flip(dt[:, :, 1]), A[1], flip(Bm), flip(Cm), h_b0.astype(f32))
    y = y_f + flip(y_b) + xh * D_skip.astype(f32)[:, None]
    y = y.reshape(b, l, D_INNER) * jax.nn.silu(z.astype(f32))
    return rmsnorm(y, norm_g).astype(z.dtype), h_f, h_b


def layer(x, mod, h_f0, h_b0, grid, norm1_g, w_in, w_fourier, conv_w, conv_b, dt_bias, A_log,
          D_skip, ssd_norm_g, w_ssd_out, w_out, norm2_g, w_ff1, w_ff2):
    shift1, scale1, gate1, shift2, scale2, gate2 = [mod[:, k][:, None] for k in range(N_MOD)]
    h = rmsnorm(x, norm1_g) * (1 + scale1) + shift1
    proj = h @ w_in
    u_f, z, xbc, dt_raw, gates = jnp.split(proj, list(SPLITS), axis=-1)
    y_f = fourier_mix(u_f, grid) @ w_fourier
    y_s, h_f, h_b = ssd_mixer(z, xbc, dt_raw, h_f0, h_b0, conv_w, conv_b, dt_bias, A_log,
                              D_skip, ssd_norm_g)
    y_s = y_s @ w_ssd_out
    g_f, g_s = jnp.split(jax.nn.sigmoid(gates), N_BRANCH, axis=-1)
    x = x + gate1 * ((g_f * y_f + g_s * y_s) @ w_out)
    h2 = rmsnorm(x, norm2_g) * (1 + scale2) + shift2
    x = x + gate2 * (jnp.square(jax.nn.relu(h2 @ w_ff1)) @ w_ff2)
    return x, h_f, h_b


def setup_inputs(seed: int = 0) -> dict:
    key = jax.random.key(seed)
    ks = jax.random.split(key, 32)
    f32 = jnp.float32
    nrm = lambda k, shape, s: jax.random.normal(k, shape, f32) * s
    dt0 = jnp.exp(jax.random.uniform(ks[10], (DEPTH, 2, N_HEADS), f32, np.log(1e-3), np.log(1e-1)))
    return {
        "x_prompt": nrm(ks[0], (BATCH, SEQ, D_MODEL), 1.0),
        "x_sample": nrm(ks[1], (DEC_BATCH, DEC_SEQ, D_MODEL), 1.0),
        "state_ssm_fwd": nrm(ks[2], (DEC_BATCH, DEPTH, N_HEADS, HEAD_DIM, D_STATE), 0.1),
        "state_ssm_bwd": nrm(ks[3], (DEC_BATCH, DEPTH, N_HEADS, HEAD_DIM, D_STATE), 0.1),
        "c": nrm(ks[4], (DEC_BATCH, D_MODEL), 1.0),
        "c_ctx": nrm(ks[5], (D_MODEL,), 1.0),
        "w_mod": nrm(ks[6], (DEPTH, D_MODEL, N_MOD * D_MODEL), D_MODEL ** -0.5),
        "b_mod": nrm(ks[7], (DEPTH, N_MOD * D_MODEL), 0.02),
        "norm1_g": 1.0 + nrm(ks[8], (DEPTH, D_MODEL), 0.02),
        "w_in": nrm(ks[9], (DEPTH, D_MODEL, D_IN_PROJ), D_MODEL ** -0.5),
        "w_fourier": nrm(ks[11], (DEPTH, F_WIDTH, D_MODEL), F_WIDTH ** -0.5),
        "conv_w": nrm(ks[12], (DEPTH, CONV_W, D_XBC), CONV_W ** -0.5),
        "conv_b": nrm(ks[13], (DEPTH, D_XBC), 0.02),
        "dt_bias": dt0 + jnp.log(-jnp.expm1(-dt0)),
        "A_log": jnp.log(jax.random.uniform(ks[14], (DEPTH, 2, N_HEADS), f32, 1.0, 16.0)),
        "D_skip": 1.0 + nrm(ks[15], (DEPTH, N_HEADS), 0.1),
        "ssd_norm_g": 1.0 + nrm(ks[16], (DEPTH, D_INNER), 0.02),
        "w_ssd_out": nrm(ks[17], (DEPTH, D_INNER, D_MODEL), D_INNER ** -0.5),
        "w_out": nrm(ks[18], (DEPTH, D_MODEL, D_MODEL), D_MODEL ** -0.5),
        "norm2_g": 1.0 + nrm(ks[19], (DEPTH, D_MODEL), 0.02),
        "w_ff1": nrm(ks[20], (DEPTH, D_MODEL, D_FF), D_MODEL ** -0.5),
        "w_ff2": nrm(ks[21], (DEPTH, D_FF, D_MODEL), D_FF ** -0.5),
        "final_norm_g": 1.0 + nrm(ks[22], (D_MODEL,), 0.02),
    }


def reference(x_prompt, x_sample, state_ssm_fwd, state_ssm_bwd, c, c_ctx, w_mod, b_mod, norm1_g,
              w_in, w_fourier, conv_w, conv_b, dt_bias, A_log, D_skip, ssd_norm_g, w_ssd_out,
              w_out, norm2_g, w_ff1, w_ff2, final_norm_g):
    bp = x_prompt.shape[0]
    xp, xs = x_prompt, x_sample
    zeros = jnp.zeros((bp, N_HEADS, HEAD_DIM, D_STATE), jnp.float32)
    new_f, new_b = [], []
    for i in range(DEPTH):
        mod_ctx = (jax.nn.silu(c_ctx)[None] @ w_mod[i] + b_mod[i]).reshape(1, N_MOD, D_MODEL)
        mod_lat = (jax.nn.silu(c) @ w_mod[i] + b_mod[i]).reshape(c.shape[0], N_MOD, D_MODEL)
        lw = (norm1_g[i], w_in[i], w_fourier[i], conv_w[i], conv_b[i], dt_bias[i], A_log[i],
              D_skip[i], ssd_norm_g[i], w_ssd_out[i], w_out[i], norm2_g[i], w_ff1[i], w_ff2[i])
        xp, hf, hb = layer(xp, mod_ctx, zeros, zeros, False, *lw)
        new_f.append(hf.astype(x_prompt.dtype))
        new_b.append(hb.astype(x_prompt.dtype))
        xs, _, _ = layer(xs, mod_lat, state_ssm_fwd[:, i], state_ssm_bwd[:, i], True, *lw)
    y_prompt = rmsnorm(xp, final_norm_g)
    y_sample = rmsnorm(xs, final_norm_g)
    new_state_fwd = jnp.stack(new_f, axis=1)
    new_state_bwd = jnp.stack(new_b, axis=1)
    return (y_prompt, y_sample, new_state_fwd, new_state_bwd)
```

```cpp
#include <hip/hip_runtime.h>
#include <hip/hip_cooperative_groups.h>
#include <cstdio>
#include <cstdint>
namespace cg = cooperative_groups;

#ifndef PHMASK
#define PHMASK 0xFFFF
#endif
#define PH_ON(n) ((PHMASK >> (n)) & 1)
#ifndef REPEAT_PH
#define REPEAT_PH -1
#endif
#ifndef ONE_LAUNCH
#define ONE_LAUNCH 1
#endif

typedef unsigned short bf16_t;
typedef short bf16x8 __attribute__((ext_vector_type(8)));
typedef float f32x16 __attribute__((ext_vector_type(16)));

#define NT 512
constexpr int T = 12288, TP = 8192;
constexpr int NPH = 13;
constexpr size_t MiB = 1048576;
constexpr size_t WS_WF = 0, WS_WSO = 2 * MiB, WS_WO = 6 * MiB, WS_W1 = 8 * MiB, WS_W2 = 16 * MiB;
constexpr size_t WS_CSC = 24 * MiB, WS_A256 = 24 * MiB + 262144, WS_MOD = 24 * MiB + 524288, WS_DTB = 25 * MiB;
constexpr size_t WS_WIN = 28 * MiB;
constexpr size_t WS_YSB2 = 28 * MiB;
constexpr size_t WS_ZS = 45 * MiB;
constexpr size_t WS_XBC = 93 * MiB;
constexpr size_t WS_Z1P = 93 * MiB;
constexpr size_t WS_Z1S = 125 * MiB;
constexpr size_t WS_YFM = 141 * MiB;
constexpr size_t WS_YSSD = 93 * MiB;
constexpr size_t WS_XT = 165 * MiB;
constexpr size_t WS_CM = 213 * MiB, WS_BM = 225 * MiB, WS_BT = 237 * MiB;
constexpr size_t WS_M = 165 * MiB;
constexpr size_t WS_H2 = 189 * MiB;
constexpr size_t WS_F = 45 * MiB;
constexpr size_t WS_BAR = 249 * MiB;
constexpr size_t WS_END = 250 * MiB;
constexpr size_t DO_GATES = 0, DO_H1 = 48 * MiB, DO_UF = 72 * MiB, DO_APOS = 96 * MiB;
constexpr int LDS_ST = 147456;
constexpr int LDS_BYTES = 147472;

struct Params {
    const float* in[23];
    float* out;
    unsigned char* ws;
    int ph_lo, ph_hi;
};

__device__ __forceinline__ int tid_opaque() { int t = (int)__builtin_amdgcn_workitem_id_x(); asm volatile("" : "+v"(t)); return t; }
typedef __bf16 bf16x2v __attribute__((ext_vector_type(2)));
typedef float f32x2v __attribute__((ext_vector_type(2)));
__device__ __forceinline__ unsigned pk2(float lo, float hi) { f32x2v v = {lo, hi}; bf16x2v b = __builtin_convertvector(v, bf16x2v); return __builtin_bit_cast(unsigned, b); }
__device__ __forceinline__ bf16_t f2bf(float f) { return (bf16_t)(pk2(f, f) & 0xffffu); }
__device__ __forceinline__ float bf2f(bf16_t h) { return __uint_as_float(((unsigned)h) << 16); }
__device__ __forceinline__ float sigmf(float v) { return __builtin_amdgcn_rcpf(1.f + __expf(-v)); }
__device__ __forceinline__ float siluf(float v) { return v * sigmf(v); }
__device__ __forceinline__ int rowmap(int reg, int lane) { return (reg & 3) + 8 * (reg >> 2) + 4 * (lane >> 5); }


#define XB_TMO      128
#define XB_XCNT(j)  (256  + 64 * (j))
#define XB_XSUB(j)  (1280 + 64 * (j))
#define XB_XGEN(j)  (2304 + 64 * (j))
#define XB_TOP      3328
#define XB_TOPGEN   3392
#define XCD_BAR_WORDS 3456
#define XB_SPIN_CAP (1u << 18)
#define LAS __attribute__((address_space(3)))
__device__ __forceinline__ unsigned xb_ld(unsigned* p)              { return __hip_atomic_load(p, __ATOMIC_RELAXED, __HIP_MEMORY_SCOPE_AGENT); }
__device__ __forceinline__ unsigned xb_add(unsigned* p, unsigned v) { return __hip_atomic_fetch_add(p, v, __ATOMIC_RELAXED, __HIP_MEMORY_SCOPE_AGENT); }
__device__ __forceinline__ unsigned xb_xcc_id() { return (unsigned)__builtin_amdgcn_s_getreg((3 << 11) | 20) & 0xFu; }
#define XB_SPIN(cond, bar) do { unsigned _sp = 0; while (cond) { __builtin_amdgcn_s_sleep(1); \
    if ((++_sp & 255u) == 0u) { if (xb_ld(&(bar)[XB_TMO])) break; if (_sp > XB_SPIN_CAP) { atomicAdd(&(bar)[XB_TMO], 1u); break; } } } } while (0)
struct XcdBarrier { unsigned* bar; unsigned x; volatile LAS unsigned* st; };
__device__ __forceinline__ XcdBarrier xcd_barrier_post(unsigned* bar, volatile LAS unsigned* st) {
    XcdBarrier b; b.bar = bar; b.x = xb_xcc_id(); b.st = st;
    if (__builtin_amdgcn_workitem_id_x() == 0) (void)xb_add(&bar[XB_XCNT(b.x)], 1u);
    return b;
}
__device__ __forceinline__ void xcd_barrier_complete(unsigned* bar, unsigned x, unsigned& nloc, unsigned& nx) {
    const unsigned G = gridDim.x * gridDim.y * gridDim.z;
    unsigned sum, cnt, mine, sp = 0u;
    for (;;) {
        sum = 0u; cnt = 0u; mine = 0u;
#pragma unroll
        for (unsigned j = 0; j < 16; ++j) { const unsigned c = xb_ld(&bar[XB_XCNT(j)]); sum += c; cnt += (c > 0u) ? 1u : 0u; mine = (j == x) ? c : mine; }
        if (sum == G) break;
        __builtin_amdgcn_s_sleep(1);
        if ((++sp & 255u) == 0u) { if (xb_ld(&bar[XB_TMO])) break; if (sp > XB_SPIN_CAP) { atomicAdd(&bar[XB_TMO], 1u); break; } }
    }
    nloc = mine > 0u ? mine : 1u; nx = cnt > 0u ? cnt : 1u;
}
__device__ __forceinline__ void xcd_barrier(const XcdBarrier& b) {
    asm volatile("s_waitcnt vmcnt(0)" ::: "memory");
    __syncthreads();
    if (__builtin_amdgcn_workitem_id_x() == 0) {
        unsigned* bar = b.bar;
        __builtin_amdgcn_s_waitcnt(0);
        unsigned nloc = b.st[0], nx = b.st[1];
        if (nloc == 0u) { xcd_barrier_complete(bar, b.x, nloc, nx); b.st[0] = nloc; b.st[1] = nx; }
        const unsigned old = xb_add(&bar[XB_XSUB(b.x)], 1u);
        const unsigned gen = old / nloc;
        if (old + 1u == (gen + 1u) * nloc) {
            __builtin_amdgcn_fence(__ATOMIC_RELEASE, "agent");
            asm volatile("s_waitcnt vmcnt(0)" ::: "memory");
            const unsigned og = xb_add(&bar[XB_TOP], 1u);
            const unsigned tg = og / nx;
            if (og + 1u == (tg + 1u) * nx) xb_add(&bar[XB_TOPGEN], 1u);
            else XB_SPIN(xb_ld(&bar[XB_TOPGEN]) == tg, bar);
            __builtin_amdgcn_fence(__ATOMIC_ACQUIRE, "agent");
            xb_add(&bar[XB_XGEN(b.x)], 1u);
            asm volatile("s_waitcnt vmcnt(0)" ::: "memory");
        } else {
            XB_SPIN(xb_ld(&bar[XB_XGEN(b.x)]) == gen, bar);
            __builtin_amdgcn_fence(__ATOMIC_ACQUIRE, "agent");
            asm volatile("s_waitcnt vmcnt(0)" ::: "memory");
        }
    }
    __syncthreads();
}

template <int MI, int BK = 64, int NI = 2, int WR = 4, bool TR = false>
__device__ __forceinline__ void gemm_mainloop(f32x16 (&acc)[MI][NI], const bf16_t* __restrict__ A, int lda, const bf16_t* __restrict__ Bt, int ldb, int K, unsigned char* lds) {
    constexpr int WC = 8 / WR;
    constexpr int BM = 32 * MI * WR, BN = 32 * NI * WC;
    constexpr int RS = (BK + 8) * 2;
    constexpr int VPR = BK / 8;
    constexpr int RPP = NT / VPR;
    constexpr int NA = BM / RPP, NB = BN / RPP;
    constexpr int ABYTES = BM * RS, BBYTES = BN * RS, STAGE = ABYTES + BBYTES;
    static_assert(NA >= 2 && NA <= 4 && NB >= 2 && NB <= 4 && BM % RPP == 0 && BN % RPP == 0, "tile config");
    const int tid = tid_opaque(), lane = tid & 63, wid = tid >> 6, wr = wid / WC, wc = wid % WC;
    const int lr = tid / VPR, lk = tid % VPR;
    uint4 ra0, ra1, ra2, ra3, rb0, rb1, rb2, rb3;
    const bf16_t* Ap = A + (size_t)lr * lda + lk * 8;
    const bf16_t* Bp = Bt + (size_t)lr * ldb + lk * 8;
    const int nk = K / BK;
    const int wo = lr * RS + lk * 16;
#define G_LOAD(k0) { ra0 = *(const uint4*)(Ap + (k0)); ra1 = *(const uint4*)(Ap + (size_t)RPP * lda + (k0)); \
        if (NA >= 3) ra2 = *(const uint4*)(Ap + (size_t)(2 * RPP) * lda + (k0)); \
        if (NA >= 4) ra3 = *(const uint4*)(Ap + (size_t)(3 * RPP) * lda + (k0)); \
        rb0 = *(const uint4*)(Bp + (k0)); rb1 = *(const uint4*)(Bp + (size_t)RPP * ldb + (k0)); \
        if (NB >= 3) rb2 = *(const uint4*)(Bp + (size_t)(2 * RPP) * ldb + (k0)); \
        if (NB >= 4) rb3 = *(const uint4*)(Bp + (size_t)(3 * RPP) * ldb + (k0)); }
#define S_STORE(buf) { *(uint4*)((buf) + wo) = ra0; *(uint4*)((buf) + wo + RPP * RS) = ra1; \
        if (NA >= 3) *(uint4*)((buf) + wo + 2 * RPP * RS) = ra2; \
        if (NA >= 4) *(uint4*)((buf) + wo + 3 * RPP * RS) = ra3; \
        *(uint4*)((buf) + ABYTES + wo) = rb0; *(uint4*)((buf) + ABYTES + wo + RPP * RS) = rb1; \
        if (NB >= 3) *(uint4*)((buf) + ABYTES + wo + 2 * RPP * RS) = rb2; \
        if (NB >= 4) *(uint4*)((buf) + ABYTES + wo + 3 * RPP * RS) = rb3; }
    ra2 = ra3 = rb2 = rb3 = make_uint4(0, 0, 0, 0);
    __syncthreads();
    G_LOAD(0)
    S_STORE(lds)
    __syncthreads();
    const int aoff = (wr * 32 * MI + (lane & 31)) * RS + (lane >> 5) * 16;
    const int boff = ABYTES + (wc * 32 * NI + (lane & 31)) * RS + (lane >> 5) * 16;
#pragma unroll 1
    for (int kt = 0; kt < nk; ++kt) {
        unsigned char* cur = lds + (kt & 1) * STAGE;
        unsigned char* nxt = lds + ((kt + 1) & 1) * STAGE;
        const bool more = (kt + 1 < nk);
        if (more) { const int k0 = (kt + 1) * BK; G_LOAD(k0) }
#pragma unroll
        for (int ks = 0; ks < BK / 16; ++ks) {
            bf16x8 af[MI], bfr[NI];
#pragma unroll
            for (int mi = 0; mi < MI; ++mi) af[mi] = *(const bf16x8*)(cur + aoff + mi * 32 * RS + ks * 32);
#pragma unroll
            for (int ni = 0; ni < NI; ++ni) bfr[ni] = *(const bf16x8*)(cur + boff + ni * 32 * RS + ks * 32);
#pragma unroll
            for (int mi = 0; mi < MI; ++mi)
#pragma unroll
                for (int ni = 0; ni < NI; ++ni)
                    acc[mi][ni] = TR ? __builtin_amdgcn_mfma_f32_32x32x16_bf16(bfr[ni], af[mi], acc[mi][ni], 0, 0, 0)
                                     : __builtin_amdgcn_mfma_f32_32x32x16_bf16(af[mi], bfr[ni], acc[mi][ni], 0, 0, 0);
        }
        if (more) S_STORE(nxt)
        __syncthreads();
    }
#undef G_LOAD
#undef S_STORE
}

template <int MI, int NI = 2>
__device__ __forceinline__ void zero_acc(f32x16 (&acc)[MI][NI]) {
#pragma unroll
    for (int mi = 0; mi < MI; ++mi)
#pragma unroll
        for (int ni = 0; ni < NI; ++ni)
#pragma unroll
            for (int r = 0; r < 16; ++r) acc[mi][ni][r] = 0.f;
}

template <int MI, int NI = 2, int WR = 4, class F>
__device__ __forceinline__ void for_each_acc(f32x16 (&acc)[MI][NI], int row0, int col0, F f) {
    constexpr int WC = 8 / WR;
    const int lane = tid_opaque() & 63, wid = tid_opaque() >> 6, wr = wid / WC, wc = wid % WC;
#pragma unroll
    for (int mi = 0; mi < MI; ++mi)
#pragma unroll
        for (int ni = 0; ni < NI; ++ni) {
            const int col = col0 + wc * 32 * NI + ni * 32 + (lane & 31);
            const int rb = row0 + wr * 32 * MI + mi * 32 + 4 * (lane >> 5);
#pragma unroll
            for (int r = 0; r < 16; ++r) { float v = acc[mi][ni][r]; f(rb + (r & 3) + 8 * (r >> 2), col, v); acc[mi][ni][r] = v; }
        }
}

template <int MI, int NI = 2, int WR = 4, class F>
__device__ __forceinline__ void for_each_acc4(f32x16 (&acc)[MI][NI], int row0, int col0, F f) {
    constexpr int WC = 8 / WR;
    const int lane = tid_opaque() & 63, wid = tid_opaque() >> 6, wr = wid / WC, wc = wid % WC;
#pragma unroll
    for (int mi = 0; mi < MI; ++mi)
#pragma unroll
        for (int ni = 0; ni < NI; ++ni) {
            const int row = row0 + wr * 32 * MI + mi * 32 + (lane & 31);
            const int cb = col0 + wc * 32 * NI + ni * 32 + 4 * (lane >> 5);
#pragma unroll
            for (int g = 0; g < 4; ++g) {
                float4 v = make_float4(acc[mi][ni][4 * g], acc[mi][ni][4 * g + 1], acc[mi][ni][4 * g + 2], acc[mi][ni][4 * g + 3]);
                f(row, cb + 8 * g, v);
                acc[mi][ni][4 * g] = v.x; acc[mi][ni][4 * g + 1] = v.y; acc[mi][ni][4 * g + 2] = v.z; acc[mi][ni][4 * g + 3] = v.w;
            }
        }
}
__device__ __forceinline__ float4 bf4_to_f4(uint2 u) { return make_float4(__uint_as_float(u.x << 16), __uint_as_float(u.x & 0xffff0000u), __uint_as_float(u.y << 16), __uint_as_float(u.y & 0xffff0000u)); }
__device__ __forceinline__ uint2 f4_to_bf4(float4 v) { return make_uint2(pk2(v.x, v.y), pk2(v.z, v.w)); }

template <class F>
__device__ __forceinline__ void for_tiles(int n_mt, int n_nt, F f) {
    const int G = gridDim.x, b = blockIdx.x;
    const bool ok = ((G & 7) == 0) && ((n_mt & 7) == 0);
    const int xcd = ok ? (b & 7) : 0, mul = ok ? 8 : 1, mpx = ok ? (n_mt >> 3) : n_mt;
    const int t0 = ok ? (b >> 3) : b, tstep = ok ? (G >> 3) : G, ntot = mpx * n_nt;
#pragma unroll 1
    for (int t = t0; t < ntot; t += tstep) f(xcd + mul * (t % mpx), t / mpx);
}

__device__ __forceinline__ const float* xrow(const Params& p, int t) { return t < TP ? p.in[0] + (size_t)t * 1024 : p.in[1] + (size_t)(t - TP) * 1024; }
__device__ __forceinline__ int modidx(int t) { return t < TP ? 0 : 1 + ((t - TP) >> 11); }

__device__ __forceinline__ void phase_prep(const Params& p, unsigned char* lds) {
    const int tid = tid_opaque();
    float* mod = (float*)(p.ws + WS_MOD);
    constexpr int N_GEMV = 192, N_TR = 5136, N_ZERO = 1, N_TAB = 32 + 32 + 2048;
    constexpr int NITEMS = N_GEMV + N_TR + N_ZERO + N_TAB;
    for (int item = blockIdx.x; item < NITEMS; item += gridDim.x) {
        if (item < N_GEMV) {
            float* sv = (float*)lds;
            float* part = sv + 3072;
            __syncthreads();
            for (int i = tid; i < 3072; i += NT) { const int r = i >> 10, k = i & 1023; const float v = (r == 0) ? p.in[5][k] : p.in[4][(r - 1) * 1024 + k]; sv[i] = siluf(v); }
            __syncthreads();
            const int col = tid & 31, kq = tid >> 5, col0 = item * 32;
            const float* w = p.in[6] + (size_t)(kq * 64) * 6144 + col0 + col;
            float a0 = 0.f, a1 = 0.f, a2 = 0.f;
#pragma unroll 16
            for (int k = 0; k < 64; ++k) { const float wv = w[(size_t)k * 6144]; const int kk = kq * 64 + k; a0 += sv[kk] * wv; a1 += sv[1024 + kk] * wv; a2 += sv[2048 + kk] * wv; }
            part[(kq * 3 + 0) * 32 + col] = a0; part[(kq * 3 + 1) * 32 + col] = a1; part[(kq * 3 + 2) * 32 + col] = a2;
            __syncthreads();
            if (tid < 96) { const int r = tid >> 5, c = tid & 31; float s = p.in[7][col0 + c];
                for (int q = 0; q < 16; ++q) s += part[(q * 3 + r) * 32 + c];
                mod[r * 6144 + col0 + c] = s; }
        } else if (item < N_GEMV + N_TR) {
            int tI = item - N_GEMV; const float* src; bf16_t* dst; int K, N;
            if (tI < 2064) { src = p.in[9]; dst = (bf16_t*)(p.ws + WS_WIN); K = 1024; N = 8256; }
            else if (tI < 2320) { tI -= 2064; src = p.in[10]; dst = (bf16_t*)(p.ws + WS_WF); K = 1024; N = 1024; }
            else if (tI < 2832) { tI -= 2320; src = p.in[17]; dst = (bf16_t*)(p.ws + WS_WSO); K = 2048; N = 1024; }
            else if (tI < 3088) { tI -= 2832; src = p.in[18]; dst = (bf16_t*)(p.ws + WS_WO); K = 1024; N = 1024; }
            else if (tI < 4112) { tI -= 3088; src = p.in[20]; dst = (bf16_t*)(p.ws + WS_W1); K = 1024; N = 4096; }
            else { tI -= 4112; src = p.in[21]; dst = (bf16_t*)(p.ws + WS_W2); K = 4096; N = 1024; }
            const int nkt = K >> 6; const int k0 = (tI % nkt) * 64, n0 = (tI / nkt) * 64;
            bf16_t* ts = (bf16_t*)lds;
            __syncthreads();
#pragma unroll
            for (int i = 0; i < 2; ++i) { const int idx = tid + i * NT, kr = idx >> 4, nv = idx & 15;
                const float4 v = *(const float4*)(src + (size_t)(k0 + kr) * N + n0 + nv * 4);
                ts[(nv * 4 + 0) * 72 + kr] = f2bf(v.x); ts[(nv * 4 + 1) * 72 + kr] = f2bf(v.y); ts[(nv * 4 + 2) * 72 + kr] = f2bf(v.z); ts[(nv * 4 + 3) * 72 + kr] = f2bf(v.w); }
            __syncthreads();
            { const int n = tid >> 3, kv = tid & 7; *(uint4*)(dst + (size_t)(n0 + n) * K + k0 + kv * 8) = *(const uint4*)(ts + n * 72 + kv * 8); }
        } else if (item < N_GEMV + N_TR + N_ZERO) {
            uint4* d = (uint4*)(p.ws + WS_WIN + (size_t)8256 * 1024 * 2);
            for (int i = tid; i < 64 * 1024 * 2 / 16; i += NT) d[i] = make_uint4(0, 0, 0, 0);
        } else {
            const int tb = item - (N_GEMV + N_TR + N_ZERO);
            unsigned pk[4];
            bf16_t* dst; size_t e0;
            if (tb < 32) { dst = (bf16_t*)(p.ws + WS_CSC); e0 = (size_t)tb * 4096 + tid * 8;
#pragma unroll
                for (int j = 0; j < 8; j += 2) { float v[2];
                    for (int u = 0; u < 2; ++u) { const int e = (int)e0 + j + u, m = e >> 8, k = e & 255, cs = m >> 8, chp = m & 255; const float ang = (float)((chp * k) & 255) * (1.f / 128.f);
                        v[u] = (cs == 0 ? cospif(ang) : sinpif(ang)) * 0.0625f; }
                    pk[j >> 1] = pk2(v[0], v[1]); }
            } else if (tb < 64) { dst = (bf16_t*)(p.ws + WS_A256); e0 = (size_t)(tb - 32) * 4096 + tid * 8;
#pragma unroll
                for (int j = 0; j < 8; j += 2) { float v[2];
                    for (int u = 0; u < 2; ++u) { const int e = (int)e0 + j + u, lp = e >> 9, kk = e & 511, cs = kk >> 8, l = kk & 255; const float ang = (float)((lp * l) & 255) * (1.f / 128.f);
                        v[u] = (cs == 0 ? cospif(ang) : -sinpif(ang)) * 0.0625f; }
                    pk[j >> 1] = pk2(v[0], v[1]); }
            } else { dst = (bf16_t*)((unsigned char*)p.out + DO_APOS); e0 = (size_t)(tb - 64) * 4096 + tid * 8;
#pragma unroll
                for (int j = 0; j < 8; j += 2) { float v[2];
                    for (int u = 0; u < 2; ++u) { const int e = (int)e0 + j + u, lp = e >> 12, kk = e & 4095, cs = kk >> 11, l = kk & 2047;
                        const int r = l >> 6, c = l & 63, rp = lp >> 6, cp = lp & 63; const float ang = (float)((2 * r * rp + c * cp) & 63) * (1.f / 32.f);
                        v[u] = (cs == 0 ? cospif(ang) : -sinpif(ang)) * 0.02209708691f; }
                    pk[j >> 1] = pk2(v[0], v[1]); }
            }
            *(uint4*)(dst + e0) = make_uint4(pk[0], pk[1], pk[2], pk[3]);
        }
    }
}

__device__ __forceinline__ void phase_norm(const Params& p, int which) {
    const int lane = tid_opaque() & 63, wid = tid_opaque() >> 6;
    const float* mod = (const float*)(p.ws + WS_MOD);
    const float* g = which == 0 ? p.in[8] : (which == 1 ? p.in[19] : p.in[22]);
    bf16_t* dst = which == 0 ? (bf16_t*)((unsigned char*)p.out + DO_H1) : (bf16_t*)(p.ws + WS_H2);
    for (int t0 = (blockIdx.x * 8 + wid) * 2; t0 < T; t0 += gridDim.x * 16) {
        float4 v[2][4]; float ss[2] = {0.f, 0.f};
#pragma unroll
        for (int u = 0; u < 2; ++u) { const int t = t0 + u; const float* src = which == 0 ? xrow(p, t) : p.out + (size_t)t * 1024;
#pragma unroll
            for (int i = 0; i < 4; ++i) v[u][i] = *(const float4*)(src + i * 256 + lane * 4); }
#pragma unroll
        for (int u = 0; u < 2; ++u) {
#pragma unroll
            for (int i = 0; i < 4; ++i) ss[u] += v[u][i].x * v[u][i].x + v[u][i].y * v[u][i].y + v[u][i].z * v[u][i].z + v[u][i].w * v[u][i].w;
#pragma unroll
            for (int o = 32; o > 0; o >>= 1) ss[u] += __shfl_xor(ss[u], o);
        }
#pragma unroll
        for (int u = 0; u < 2; ++u) {
            const int t = t0 + u;
            const float rstd = rsqrtf(ss[u] * (1.f / 1024.f) + 1e-6f);
            if (which == 2) {
#pragma unroll
                for (int i = 0; i < 4; ++i) { const int c = i * 256 + lane * 4; const float4 gg = *(const float4*)(g + c);
                    float4 o; o.x = v[u][i].x * rstd * gg.x; o.y = v[u][i].y * rstd * gg.y; o.z = v[u][i].z * rstd * gg.z; o.w = v[u][i].w * rstd * gg.w;
                    *(float4*)(p.out + (size_t)t * 1024 + c) = o; }
            } else {
                const float* mrow = mod + modidx(t) * 6144 + (which == 0 ? 0 : 3072);
#pragma unroll
                for (int i = 0; i < 4; ++i) { const int c = i * 256 + lane * 4; const float4 gg = *(const float4*)(g + c);
                    const float4 sh = *(const float4*)(mrow + c), sc = *(const float4*)(mrow + 1024 + c);
                    const float o0 = v[u][i].x * rstd * gg.x * (1.f + sc.x) + sh.x, o1 = v[u][i].y * rstd * gg.y * (1.f + sc.y) + sh.y;
                    const float o2 = v[u][i].z * rstd * gg.z * (1.f + sc.z) + sh.z, o3 = v[u][i].w * rstd * gg.w * (1.f + sc.w) + sh.w;
                    *(uint2*)(dst + (size_t)t * 1024 + c) = make_uint2(pk2(o0, o1), pk2(o2, o3)); }
            }
        }
    }
}

__device__ __forceinline__ void phase_inproj(const Params& p, unsigned char* lds) {
    const bf16_t* h1 = (const bf16_t*)((unsigned char*)p.out + DO_H1);
    const bf16_t* W = (const bf16_t*)(p.ws + WS_WIN);
    bf16_t* uf = (bf16_t*)((unsigned char*)p.out + DO_UF);
    bf16_t* zs = (bf16_t*)(p.ws + WS_ZS);
    bf16_t* xbc = (bf16_t*)(p.ws + WS_XBC);
    float* dtb = (float*)(p.ws + WS_DTB);
    bf16_t* gates = (bf16_t*)((unsigned char*)p.out + DO_GATES);
    const float* dt_bias = p.in[13];
    auto epi = [&](const f32x16& a, int rb, int cb, int lane) {
        if (cb >= 8256) return;
        if (cb >= 6144 && cb < 6208) {
            const int j = cb - 6144 + (lane & 31); const float bias = dt_bias[j];
#pragma unroll
            for (int r = 0; r < 16; ++r) { const float x = a[r] + bias; dtb[(size_t)(rb + (r & 3) + 8 * (r >> 2)) * 64 + j] = x > 20.f ? x : log1pf(__expf(x)); }
        } else {
            bf16_t* dst; int ld, c0; bool sg = false;
            if (cb < 1024) { dst = uf; ld = 1024; c0 = cb; }
            else if (cb < 3072) { dst = zs; ld = 2048; c0 = cb - 1024; }
            else if (cb < 6144) { dst = xbc; ld = 3072; c0 = cb - 3072; }
            else { dst = gates; ld = 2048; c0 = cb - 6208; sg = true; }
            bf16_t* dp = dst + (size_t)rb * ld + c0 + (lane & 31);
            if (sg) {
#pragma unroll
                for (int r = 0; r < 16; ++r) dp[(size_t)((r & 3) + 8 * (r >> 2)) * ld] = f2bf(sigmf(a[r]));
            } else {
#pragma unroll
                for (int r = 0; r < 16; ++r) dp[(size_t)((r & 3) + 8 * (r >> 2)) * ld] = f2bf(a[r]);
            }
        }
    };
    for_tiles(48, 32, [&](int mt, int nt) {
        f32x16 acc[2][4]; zero_acc<2, 4>(acc);
        gemm_mainloop<2, 64, 4>(acc, h1 + (size_t)mt * 256 * 1024, 1024, W + (size_t)nt * 256 * 1024, 1024, 1024, lds);
        const int lane = tid_opaque() & 63, wid = tid_opaque() >> 6, wr = wid >> 1, wc = wid & 1;
#pragma unroll
        for (int mi = 0; mi < 2; ++mi)
#pragma unroll
            for (int ni = 0; ni < 4; ++ni)
                epi(acc[mi][ni], mt * 256 + wr * 64 + mi * 32 + 4 * (lane >> 5), __builtin_amdgcn_readfirstlane(nt * 256 + wc * 128 + ni * 32), lane);
    });
    for (int mt = (int)gridDim.x - 1 - (int)blockIdx.x; mt < 48; mt += gridDim.x) {
        f32x16 acc[2][2]; zero_acc<2>(acc);
        gemm_mainloop<2>(acc, h1 + (size_t)mt * 256 * 1024, 1024, W + (size_t)8192 * 1024, 1024, 1024, lds);
        const int lane = tid_opaque() & 63, wid = tid_opaque() >> 6, wr = wid >> 1, wc = wid & 1;
#pragma unroll
        for (int mi = 0; mi < 2; ++mi)
#pragma unroll
            for (int ni = 0; ni < 2; ++ni)
                epi(acc[mi][ni], mt * 256 + wr * 64 + mi * 32 + 4 * (lane >> 5), __builtin_amdgcn_readfirstlane(8192 + wc * 64 + ni * 32), lane);
    }
}

struct ConvPre { uint4 v0, v1, v2; float w; };
__device__ __forceinline__ void conv_prefetch(const Params& p, int item, int tid, ConvPre& r) {
    const int q = item / 48, sl = item % 48;
    const int sstart = q < 64 ? (q >> 1) * 256 : TP + ((q - 64) >> 4) * 2048;
    const int send = sstart + (q < 64 ? 256 : 2048);
    const int t0 = q * 128;
    const bf16_t* xbc = (const bf16_t*)(p.ws + WS_XBC);
    r.v0 = r.v1 = r.v2 = make_uint4(0, 0, 0, 0); r.w = 0.f;
    { const int idx = tid, row = idx >> 3, v = idx & 7; const int t = t0 - 2 + row; if (t >= sstart && t < send) r.v0 = *(const uint4*)(xbc + (size_t)t * 3072 + sl * 64 + v * 8); }
    { const int idx = tid + NT, row = idx >> 3, v = idx & 7; const int t = t0 - 2 + row; if (t >= sstart && t < send) r.v1 = *(const uint4*)(xbc + (size_t)t * 3072 + sl * 64 + v * 8); }
    { const int idx = tid + 2 * NT, row = idx >> 3, v = idx & 7; const int t = t0 - 2 + row; if (idx < 132 * 8 && t >= sstart && t < send) r.v2 = *(const uint4*)(xbc + (size_t)t * 3072 + sl * 64 + v * 8); }
    if (tid < 320) r.w = p.in[11][(tid >> 6) * 3072 + sl * 64 + (tid & 63)];
    else if (tid < 384) r.w = p.in[12][sl * 64 + (tid - 320)];
}

__device__ __forceinline__ void conv_item(const Params& p, int item, int next_item, ConvPre& pre, unsigned char* lds) {
    const int tid = tid_opaque();
    const int q = item / 48, sl = item % 48;
    bf16_t* sIn = (bf16_t*)lds;
    bf16_t* sOut = (bf16_t*)(lds + 132 * 144);
    float* sW = (float*)(lds + 132 * 144 + 128 * 144);
    __syncthreads();
    { const int idx = tid; *(uint4*)(sIn + (idx >> 3) * 72 + (idx & 7) * 8) = pre.v0; }
    { const int idx = tid + NT; *(uint4*)(sIn + (idx >> 3) * 72 + (idx & 7) * 8) = pre.v1; }
    { const int idx = tid + 2 * NT; if (idx < 132 * 8) *(uint4*)(sIn + (idx >> 3) * 72 + (idx & 7) * 8) = pre.v2; }
    if (tid < 384) sW[tid] = pre.w;
    if (next_item >= 0) conv_prefetch(p, next_item, tid, pre);
    __syncthreads();
    {
        const int j = tid >> 2, c0 = (tid & 3) * 16;
        float o[16];
#pragma unroll
        for (int c = 0; c < 16; ++c) o[c] = sW[320 + c0 + c];
#pragma unroll
        for (int k = 0; k < 5; ++k) {
            const uint4 a = *(const uint4*)(sIn + (j + k) * 72 + c0), b = *(const uint4*)(sIn + (j + k) * 72 + c0 + 8);
            const unsigned w[8] = {a.x, a.y, a.z, a.w, b.x, b.y, b.z, b.w};
#pragma unroll
            for (int u = 0; u < 8; ++u) { o[2 * u] += sW[k * 64 + c0 + 2 * u] * __uint_as_float(w[u] << 16); o[2 * u + 1] += sW[k * 64 + c0 + 2 * u + 1] * __uint_as_float(w[u] & 0xffff0000u); }
        }
        unsigned pk[8];
#pragma unroll
        for (int u = 0; u < 8; ++u) pk[u] = pk2(siluf(o[2 * u]), siluf(o[2 * u + 1]));
        *(uint4*)(sOut + j * 72 + c0) = make_uint4(pk[0], pk[1], pk[2], pk[3]);
        *(uint4*)(sOut + j * 72 + c0 + 8) = make_uint4(pk[4], pk[5], pk[6], pk[7]);
    }
    __syncthreads();
    if (sl >= 32) {
        const int s2 = sl - 32, isC = s2 >= 8, g = (s2 & 7) >> 1, nh = s2 & 1;
        bf16_t* dst = (bf16_t*)(p.ws + (isC ? WS_CM : WS_BM)) + (size_t)(q * 4 + g) * 128 * 128 + nh * 64;
#pragma unroll
        for (int i = 0; i < 2; ++i) { const int idx = tid + i * NT, j = idx >> 3, v = idx & 7; *(uint4*)(dst + (size_t)j * 128 + v * 8) = *(const uint4*)(sOut + j * 72 + v * 8); }
    }
    if (sl < 40) {
        bf16_t* dst;
        if (sl < 32) dst = (bf16_t*)(p.ws + WS_XT) + (size_t)(q * 32 + sl) * 64 * 128;
        else { const int s2 = sl - 32; dst = (bf16_t*)(p.ws + WS_BT) + (size_t)(q * 4 + (s2 >> 1)) * 128 * 128 + (size_t)(s2 & 1) * 64 * 128; }
        const int ch = tid >> 3, jv = tid & 7;
#pragma unroll
        for (int i = 0; i < 2; ++i) { const int j0 = jv * 8 + i * 64; unsigned pk[4];
#pragma unroll
            for (int u = 0; u < 4; ++u) pk[u] = (unsigned)sOut[(j0 + 2 * u) * 72 + ch] | ((unsigned)sOut[(j0 + 2 * u + 1) * 72 + ch] << 16);
            *(uint4*)(dst + (size_t)ch * 128 + j0) = make_uint4(pk[0], pk[1], pk[2], pk[3]); }
    }
}

__device__ __forceinline__ void phase_conv_f1(const Params& p, unsigned char* lds) {
    const bf16_t* csc = (const bf16_t*)(p.ws + WS_CSC);
    const bf16_t* uf = (const bf16_t*)((unsigned char*)p.out + DO_UF);
    (void)csc; (void)uf;
    ConvPre pre;
    int item = blockIdx.x;
    if (item < 96 * 48) conv_prefetch(p, item, tid_opaque(), pre);
#pragma unroll 1
    for (; item < 96 * 48; item += gridDim.x) {
        const int nxt = item + (int)gridDim.x;
        conv_item(p, item, nxt < 96 * 48 ? nxt : -1, pre, lds);
    }
}

__device__ __forceinline__ void phase_f1(const Params& p, unsigned char* lds) {
    const bf16_t* csc = (const bf16_t*)(p.ws + WS_CSC);
    const bf16_t* uf = (const bf16_t*)((unsigned char*)p.out + DO_UF);
    bf16_t* z1p = (bf16_t*)(p.ws + WS_Z1P);
    bf16_t* z1s = (bf16_t*)(p.ws + WS_Z1S);
    for (int id = blockIdx.x; id < 768; id += gridDim.x) {
        const int g = id / 192, rem = id % 192, mt = rem / 96, nt = rem % 96;
        f32x16 acc[2][2]; zero_acc<2>(acc);
        gemm_mainloop<2>(acc, csc + (size_t)mt * 256 * 256, 256, uf + (size_t)nt * 128 * 1024 + g * 256, 1024, 256, lds);
        for_each_acc<2>(acc, 0, nt * 128, [&](int chp, int t, float& v) {
            if (t < TP) { const int b = t >> 8, l = t & 255; z1p[((size_t)(b * 4 + g) * 256 + chp) * 512 + mt * 256 + l] = f2bf(v); }
            else { const int ts = t - TP, b = ts >> 11, l = ts & 2047; z1s[((size_t)(b * 4 + g) * 256 + chp) * 4096 + mt * 2048 + l] = f2bf(v); }
        });
    }
}

__device__ __forceinline__ void phase_f2(const Params& p, unsigned char* lds) {
    const bf16_t* a256 = (const bf16_t*)(p.ws + WS_A256);
    const bf16_t* apos = (const bf16_t*)((unsigned char*)p.out + DO_APOS);
    const bf16_t* z1p = (const bf16_t*)(p.ws + WS_Z1P);
    const bf16_t* z1s = (const bf16_t*)(p.ws + WS_Z1S);
    bf16_t* yfm = (bf16_t*)(p.ws + WS_YFM);
    for (int id = blockIdx.x; id < 512; id += gridDim.x) {
        if (id < 256) {
            const int bg = id >> 5, rem = id & 31, mt = rem >> 1, nt = rem & 1;
            f32x16 acc[1][2]; zero_acc<1>(acc);
            gemm_mainloop<1, 128>(acc, apos + (size_t)mt * 128 * 4096, 4096, z1s + (size_t)(bg * 256 + nt * 128) * 4096, 4096, 4096, lds);
            const int b = bg >> 2, g = bg & 3;
            for_each_acc<1>(acc, mt * 128, nt * 128, [&](int lp, int chp, float& v) { yfm[(size_t)(TP + b * 2048 + lp) * 1024 + g * 256 + chp] = f2bf(v); });
        } else {
            const int i2 = id - 256, bg = i2 >> 1, nt = i2 & 1;
            f32x16 acc[2][2]; zero_acc<2>(acc);
            gemm_mainloop<2>(acc, a256, 512, z1p + (size_t)(bg * 256 + nt * 128) * 512, 512, 512, lds);
            const int b = bg >> 2, g = bg & 3;
            for_each_acc<2>(acc, 0, nt * 128, [&](int lp, int chp, float& v) { yfm[(size_t)(b * 256 + lp) * 1024 + g * 256 + chp] = f2bf(v); });
        }
    }
}

__device__ __forceinline__ void ssd_item(const Params& p, int seq, int h, int mode, unsigned char* lds) {
    const int tid = tid_opaque(), lane = tid & 63, wid = tid >> 6;
    const bool samp = seq >= 32;
    const int nc = samp ? 16 : 2;
    const int q0 = samp ? 64 + (seq - 32) * 16 : seq * 2;
    const int g = h >> 3;
    unsigned char* sC = lds;
    unsigned char* sB = lds + 34816;
    unsigned char* sX = lds + 69632;
    unsigned char* sH = lds + 87040;
    unsigned char* sXw = lds + 104448;
    float* sCum = (float*)(lds + 121856);
    float* sDt = sCum + 128;
    const bf16_t* gXT = (const bf16_t*)(p.ws + WS_XT);
    const bf16_t* gCM = (const bf16_t*)(p.ws + WS_CM);
    const bf16_t* gBM = (const bf16_t*)(p.ws + WS_BM);
    const bf16_t* gBT = (const bf16_t*)(p.ws + WS_BT);
    const float* dtb = (const float*)(p.ws + WS_DTB);
    bf16_t* yssd = (mode == 1) ? (bf16_t*)(p.ws + WS_YSB2) - (size_t)TP * 2048 : (bf16_t*)(p.ws + WS_YSSD);
    const float Dh = p.in[15][h];
    const int npass = mode == 2 ? 2 : 1;
    const int wr = wid >> 1, wc = wid & 1;
    const int wp = wid >> 2, wn = wid & 3;
    const int l31o = lane & 31;

#pragma unroll 1
    for (int pass = 0; pass < npass; ++pass) {
        const int dir = mode == 2 ? 1 - pass : mode;
        const bool rmw = (mode == 2 && pass == 1);
        const float Aneg = -__expf(p.in[14][dir * 32 + h]);
        f32x16 hacc;
        if (samp) {
            const float* st = p.in[2 + dir] + (size_t)((seq - 32) * 32 + h) * 8192;
#pragma unroll
            for (int r = 0; r < 16; ++r) hacc[r] = st[(wp * 32 + rowmap(r, lane)) * 128 + wn * 32 + l31o];
        } else {
#pragma unroll
            for (int r = 0; r < 16; ++r) hacc[r] = 0.f;
        }
#pragma unroll 1
        for (int step = 0; step < nc; ++step) {
            int ln = lane; asm volatile("" : "+v"(ln));
            const int l31 = ln & 31, lh = ln >> 5;
            const int c = dir == 0 ? step : nc - 1 - step;
            const int q = q0 + c, t0 = q * 128;
            if (wid == 0) {
                const float d0 = dtb[(size_t)(t0 + 2 * lane) * 64 + dir * 32 + h], d1 = dtb[(size_t)(t0 + 2 * lane + 1) * 64 + dir * 32 + h];
                const float a0 = d0 * Aneg, a1 = d1 * Aneg, s = a0 + a1;
                float sc = s;
#pragma unroll
                for (int o = 1; o < 64; o <<= 1) { const float n = __shfl_up(sc, o); if (lane >= o) sc += n; }
                const float tot = __shfl(sc, 63);
                const float ex = sc - s;
                float c0 = ex + a0, c1 = ex + a0 + a1;
                if (dir == 1) { c0 = tot - c0 + a0; c1 = tot - c1 + a1; }
                sCum[2 * lane] = c0; sCum[2 * lane + 1] = c1; sDt[2 * lane] = d0; sDt[2 * lane + 1] = d1;
            }
            const bf16_t* srcC = gCM + (size_t)(q * 4 + g) * 16384;
            const bf16_t* srcB = gBM + (size_t)(q * 4 + g) * 16384;
            const bf16_t* srcBT = gBT + (size_t)(q * 4 + g) * 16384;
            const bf16_t* srcX = gXT + (size_t)(q * 32 + h) * 8192;
            const int lrow = tid >> 4, lv = tid & 15;
            const int goff = lrow * 128 + lv * 8, soff = lrow * 272 + lv * 16;
#pragma unroll
            for (int i = 0; i < 4; ++i) {
                *(uint4*)(sC + soff + i * 32 * 272) = *(const uint4*)(srcC + goff + i * 32 * 128);
                *(uint4*)(sB + soff + i * 32 * 272) = *(const uint4*)(srcB + goff + i * 32 * 128); }
            const uint4 rbt0 = *(const uint4*)(srcBT + goff), rbt1 = *(const uint4*)(srcBT + goff + 32 * 128);
            const uint4 rbt2 = *(const uint4*)(srcBT + goff + 64 * 128), rbt3 = *(const uint4*)(srcBT + goff + 96 * 128);
            bf16_t* yp = yssd + (size_t)t0 * 2048 + h * 64 + wc * 32 + l31;
            f32x16 yprev;
#pragma unroll
            for (int r = 0; r < 16; ++r) yprev[r] = 0.f;
            if (rmw) {
#pragma unroll
                for (int r = 0; r < 16; ++r) yprev[r] = bf2f(yp[(size_t)(wr * 32 + rowmap(r, ln)) * 2048]);
            }
            const uint4 rx0 = *(const uint4*)(srcX + goff), rx1 = *(const uint4*)(srcX + goff + 32 * 128);
            *(uint4*)(sX + soff) = rx0; *(uint4*)(sX + soff + 32 * 272) = rx1;
#pragma unroll
            for (int r = 0; r < 16; ++r) *(bf16_t*)(sH + (wp * 32 + rowmap(r, ln)) * 272 + (wn * 32 + l31) * 2) = f2bf(hacc[r]);
            __syncthreads();
            const float cend = dir == 0 ? sCum[127] : sCum[0];
            {
                float wj[8];
#pragma unroll
                for (int u = 0; u < 8; ++u) wj[u] = __expf(cend - sCum[lv * 8 + u]) * sDt[lv * 8 + u];
#define XW(w, a, b) pk2(__uint_as_float((w) << 16) * wj[a], __uint_as_float((w) & 0xffff0000u) * wj[b])
                *(uint4*)(sXw + soff) = make_uint4(XW(rx0.x, 0, 1), XW(rx0.y, 2, 3), XW(rx0.z, 4, 5), XW(rx0.w, 6, 7));
                *(uint4*)(sXw + soff + 32 * 272) = make_uint4(XW(rx1.x, 0, 1), XW(rx1.y, 2, 3), XW(rx1.z, 4, 5), XW(rx1.w, 6, 7));
#undef XW
            }
            f32x16 cb0, cb1, yo;
#pragma unroll
            for (int r = 0; r < 16; ++r) { cb0[r] = 0.f; cb1[r] = 0.f; yo[r] = 0.f; }
#pragma unroll
            for (int ks = 0; ks < 8; ++ks) {
                const int ko = ks * 32 + lh * 16;
                const bf16x8 a = *(const bf16x8*)(sC + (wr * 32 + l31) * 272 + ko);
                const bf16x8 b0 = *(const bf16x8*)(sB + (wc * 64 + l31) * 272 + ko);
                const bf16x8 b1 = *(const bf16x8*)(sB + (wc * 64 + 32 + l31) * 272 + ko);
                const bf16x8 bh = *(const bf16x8*)(sH + (wc * 32 + l31) * 272 + ko);
                cb0 = __builtin_amdgcn_mfma_f32_32x32x16_bf16(a, b0, cb0, 0, 0, 0);
                cb1 = __builtin_amdgcn_mfma_f32_32x32x16_bf16(a, b1, cb1, 0, 0, 0);
                yo = __builtin_amdgcn_mfma_f32_32x32x16_bf16(a, bh, yo, 0, 0, 0);
            }
            {
                const int j0 = wc * 64 + l31, j1 = j0 + 32;
                const float cj0 = sCum[j0], cj1 = sCum[j1], dj0 = sDt[j0], dj1 = sDt[j1];
#pragma unroll
                for (int r = 0; r < 16; ++r) {
                    const int i = wr * 32 + rowmap(r, ln); const float ci = sCum[i];
                    const bool v0 = dir == 0 ? (j0 <= i) : (j0 >= i), v1 = dir == 0 ? (j1 <= i) : (j1 >= i);
                    float m0 = v0 ? cb0[r] * __expf(ci - cj0) * dj0 : 0.f;
                    float m1 = v1 ? cb1[r] * __expf(ci - cj1) * dj1 : 0.f;
                    if (dir == 0) { if (i == j0) m0 += Dh; if (i == j1) m1 += Dh; }
                    cb0[r] = m0; cb1[r] = m1;
                    yo[r] *= __expf(ci);
                }
            }
            __syncthreads();
            {
                const int j0 = wc * 64 + l31;
#pragma unroll
                for (int r = 0; r < 16; ++r) { const int i = wr * 32 + rowmap(r, ln);
                    *(bf16_t*)(sB + i * 272 + j0 * 2) = f2bf(cb0[r]); *(bf16_t*)(sB + i * 272 + (j0 + 32) * 2) = f2bf(cb1[r]); }
                *(uint4*)(sC + soff) = rbt0; *(uint4*)(sC + soff + 32 * 272) = rbt1; *(uint4*)(sC + soff + 64 * 272) = rbt2; *(uint4*)(sC + soff + 96 * 272) = rbt3;
            }
            __syncthreads();
            const float cdec = __expf(cend);
#pragma unroll
            for (int r = 0; r < 16; ++r) hacc[r] *= cdec;
#pragma unroll
            for (int ks = 0; ks < 8; ++ks) {
                const int ko = ks * 32 + lh * 16;
                const bf16x8 am = *(const bf16x8*)(sB + (wr * 32 + l31) * 272 + ko);
                const bf16x8 bx = *(const bf16x8*)(sX + (wc * 32 + l31) * 272 + ko);
                yo = __builtin_amdgcn_mfma_f32_32x32x16_bf16(am, bx, yo, 0, 0, 0);
                const bf16x8 ax = *(const bf16x8*)(sXw + (wp * 32 + l31) * 272 + ko);
                const bf16x8 bb = *(const bf16x8*)(sC + (wn * 32 + l31) * 272 + ko);
                hacc = __builtin_amdgcn_mfma_f32_32x32x16_bf16(ax, bb, hacc, 0, 0, 0);
            }
            {
#pragma unroll
                for (int r = 0; r < 16; ++r) { const int i = wr * 32 + rowmap(r, ln); yp[(size_t)i * 2048] = f2bf(yo[r] + yprev[r]); }
            }
            __syncthreads();
        }
        if (!samp) {
            float* dst = p.out + (size_t)T * 1024 + (size_t)dir * 8388608 + (size_t)(seq * 32 + h) * 8192;
#pragma unroll
            for (int r = 0; r < 16; ++r) dst[(wp * 32 + rowmap(r, lane)) * 128 + wn * 32 + l31o] = hacc[r];
        }
    }
}

template <bool ALPHA, bool BETA>
__device__ __forceinline__ void ssd_cstep(const Params& p, unsigned char* lds, int q, int h, float AnegF, float AnegB, float Dh,
                                          const f32x16& enter, int enterDir, bool scaleB, f32x16& accF, f32x16& accB, float& piF) {
    const int tid = tid_opaque(), lane = tid & 63, wid = tid >> 6;
    const int g = h >> 3, t0 = q * 128;
    unsigned char* sC = lds;
    unsigned char* sB = lds + 34816;
    unsigned char* sX = lds + 69632;
    unsigned char* sH = lds + 87040;
    unsigned char* sXwF = lds + 104448;
    unsigned char* sXwB = lds + 121856;
    float* sCumF = (float*)(lds + 139264);
    float* sCumB = sCumF + 128;
    float* sDtF = sCumF + 256;
    float* sDtB = sCumF + 384;
    const bf16_t* srcC = (const bf16_t*)(p.ws + WS_CM) + (size_t)(q * 4 + g) * 16384;
    const bf16_t* srcB = (const bf16_t*)(p.ws + WS_BM) + (size_t)(q * 4 + g) * 16384;
    const bf16_t* srcBT = (const bf16_t*)(p.ws + WS_BT) + (size_t)(q * 4 + g) * 16384;
    const bf16_t* srcX = (const bf16_t*)(p.ws + WS_XT) + (size_t)(q * 32 + h) * 8192;
    const float* dtb = (const float*)(p.ws + WS_DTB);
    bf16_t* yssd = (bf16_t*)(p.ws + WS_YSSD);
    const int wr = wid >> 1, wc = wid & 1, wp = wid >> 2, wn = wid & 3;
    const int l31 = lane & 31, lh = lane >> 5;
    if (wid == 0) {
        const float f0 = dtb[(size_t)(t0 + 2 * lane) * 64 + h], f1 = dtb[(size_t)(t0 + 2 * lane + 1) * 64 + h];
        const float b0 = dtb[(size_t)(t0 + 2 * lane) * 64 + 32 + h], b1 = dtb[(size_t)(t0 + 2 * lane + 1) * 64 + 32 + h];
        const float af0 = f0 * AnegF, af1 = f1 * AnegF, ab0 = b0 * AnegB, ab1 = b1 * AnegB;
        float sf = af0 + af1, sb = ab0 + ab1;
        const float sf0 = sf, sb0 = sb;
#pragma unroll
        for (int o = 1; o < 64; o <<= 1) { const float nf = __shfl_up(sf, o), nb = __shfl_up(sb, o); if (lane >= o) { sf += nf; sb += nb; } }
        const float totb = __shfl(sb, 63);
        const float exf = sf - sf0, exb = sb - sb0;
        sCumF[2 * lane] = exf + af0; sCumF[2 * lane + 1] = exf + af0 + af1;
        sCumB[2 * lane] = totb - exb; sCumB[2 * lane + 1] = totb - exb - ab0;
        sDtF[2 * lane] = f0; sDtF[2 * lane + 1] = f1; sDtB[2 * lane] = b0; sDtB[2 * lane + 1] = b1;
    }
    const int lrow = tid >> 4, lv = tid & 15;
    const int goff = lrow * 128 + lv * 8, soff = lrow * 272 + lv * 16;
    if (BETA) {
#pragma unroll
        for (int i = 0; i < 4; ++i) {
            *(uint4*)(sC + soff + i * 32 * 272) = *(const uint4*)(srcC + goff + i * 32 * 128);
            *(uint4*)(sB + soff + i * 32 * 272) = *(const uint4*)(srcB + goff + i * 32 * 128); }
    }
    uint4 rbt0 = make_uint4(0, 0, 0, 0), rbt1 = rbt0, rbt2 = rbt0, rbt3 = rbt0;
    if (ALPHA) {
        rbt0 = *(const uint4*)(srcBT + goff); rbt1 = *(const uint4*)(srcBT + goff + 32 * 128);
        rbt2 = *(const uint4*)(srcBT + goff + 64 * 128); rbt3 = *(const uint4*)(srcBT + goff + 96 * 128);
        if (!BETA) { *(uint4*)(sC + soff) = rbt0; *(uint4*)(sC + soff + 32 * 272) = rbt1; *(uint4*)(sC + soff + 64 * 272) = rbt2; *(uint4*)(sC + soff + 96 * 272) = rbt3; }
    }
    const uint4 rx0 = *(const uint4*)(srcX + goff), rx1 = *(const uint4*)(srcX + goff + 32 * 128);
    if (BETA) {
        *(uint4*)(sX + soff) = rx0; *(uint4*)(sX + soff + 32 * 272) = rx1;
#pragma unroll
        for (int r = 0; r < 16; ++r) *(bf16_t*)(sH + (wp * 32 + rowmap(r, lane)) * 272 + (wn * 32 + l31) * 2) = f2bf(enter[r]);
    }
    __syncthreads();
    const float pF = __expf(sCumF[127]), pB = __expf(sCumB[0]);
    if (ALPHA) {
        float wf[8], wb[8];
#pragma unroll
        for (int u = 0; u < 8; ++u) { wf[u] = __expf(sCumF[127] - sCumF[lv * 8 + u]) * sDtF[lv * 8 + u]; wb[u] = __expf(sCumB[0] - sCumB[lv * 8 + u]) * sDtB[lv * 8 + u]; }
#define XWF(w, a, b) pk2(__uint_as_float((w) << 16) * wf[a], __uint_as_float((w) & 0xffff0000u) * wf[b])
#define XWB(w, a, b) pk2(__uint_as_float((w) << 16) * wb[a], __uint_as_float((w) & 0xffff0000u) * wb[b])
        *(uint4*)(sXwF + soff) = make_uint4(XWF(rx0.x, 0, 1), XWF(rx0.y, 2, 3), XWF(rx0.z, 4, 5), XWF(rx0.w, 6, 7));
        *(uint4*)(sXwF + soff + 32 * 272) = make_uint4(XWF(rx1.x, 0, 1), XWF(rx1.y, 2, 3), XWF(rx1.z, 4, 5), XWF(rx1.w, 6, 7));
        *(uint4*)(sXwB + soff) = make_uint4(XWB(rx0.x, 0, 1), XWB(rx0.y, 2, 3), XWB(rx0.z, 4, 5), XWB(rx0.w, 6, 7));
        *(uint4*)(sXwB + soff + 32 * 272) = make_uint4(XWB(rx1.x, 0, 1), XWB(rx1.y, 2, 3), XWB(rx1.z, 4, 5), XWB(rx1.w, 6, 7));
#undef XWF
#undef XWB
    }
    f32x16 yo;
#pragma unroll
    for (int r = 0; r < 16; ++r) yo[r] = 0.f;
    if (BETA) {
        f32x16 cb0, cb1;
#pragma unroll
        for (int r = 0; r < 16; ++r) { cb0[r] = 0.f; cb1[r] = 0.f; }
#pragma unroll
        for (int ks = 0; ks < 8; ++ks) {
            const int ko = ks * 32 + lh * 16;
            const bf16x8 a = *(const bf16x8*)(sC + (wr * 32 + l31) * 272 + ko);
            const bf16x8 b0 = *(const bf16x8*)(sB + (wc * 64 + l31) * 272 + ko);
            const bf16x8 b1 = *(const bf16x8*)(sB + (wc * 64 + 32 + l31) * 272 + ko);
            const bf16x8 bh = *(const bf16x8*)(sH + (wc * 32 + l31) * 272 + ko);
            cb0 = __builtin_amdgcn_mfma_f32_32x32x16_bf16(a, b0, cb0, 0, 0, 0);
            cb1 = __builtin_amdgcn_mfma_f32_32x32x16_bf16(a, b1, cb1, 0, 0, 0);
            yo = __builtin_amdgcn_mfma_f32_32x32x16_bf16(a, bh, yo, 0, 0, 0);
        }
        {
            const int j0 = wc * 64 + l31, j1 = j0 + 32;
            const float fj0 = sCumF[j0], fj1 = sCumF[j1], bj0 = sCumB[j0], bj1 = sCumB[j1];
            const float df0 = sDtF[j0], df1 = sDtF[j1], db0 = sDtB[j0], db1 = sDtB[j1];
            const float* sCe = enterDir == 0 ? sCumF : sCumB;
#pragma unroll
            for (int r = 0; r < 16; ++r) {
                const int i = wr * 32 + rowmap(r, lane); const float fi = sCumF[i], bi = sCumB[i];
                const float e0 = j0 <= i ? __expf(fi - fj0) * df0 : 0.f, g0 = j0 >= i ? __expf(bi - bj0) * db0 : 0.f;
                const float e1 = j1 <= i ? __expf(fi - fj1) * df1 : 0.f, g1 = j1 >= i ? __expf(bi - bj1) * db1 : 0.f;
                float m0 = cb0[r] * (e0 + g0), m1 = cb1[r] * (e1 + g1);
                if (i == j0) m0 += Dh;
                if (i == j1) m1 += Dh;
                cb0[r] = m0; cb1[r] = m1;
                yo[r] *= __expf(sCe[i]);
            }
        }
        __syncthreads();
        {
            const int j0 = wc * 64 + l31;
#pragma unroll
            for (int r = 0; r < 16; ++r) { const int i = wr * 32 + rowmap(r, lane);
                *(bf16_t*)(sB + i * 272 + j0 * 2) = f2bf(cb0[r]); *(bf16_t*)(sB + i * 272 + (j0 + 32) * 2) = f2bf(cb1[r]); }
            if (ALPHA) { *(uint4*)(sC + soff) = rbt0; *(uint4*)(sC + soff + 32 * 272) = rbt1; *(uint4*)(sC + soff + 64 * 272) = rbt2; *(uint4*)(sC + soff + 96 * 272) = rbt3; }
        }
    }
    __syncthreads();
    if (ALPHA) {
        if (scaleB) {
#pragma unroll
            for (int r = 0; r < 16; ++r) accB[r] *= pB;
        }
    }
#pragma unroll
    for (int ks = 0; ks < 8; ++ks) {
        const int ko = ks * 32 + lh * 16;
        if (BETA) {
            const bf16x8 am = *(const bf16x8*)(sB + (wr * 32 + l31) * 272 + ko);
            const bf16x8 bx = *(const bf16x8*)(sX + (wc * 32 + l31) * 272 + ko);
            yo = __builtin_amdgcn_mfma_f32_32x32x16_bf16(am, bx, yo, 0, 0, 0);
        }
        if (ALPHA) {
            const bf16x8 bb = *(const bf16x8*)(sC + (wn * 32 + l31) * 272 + ko);
            const bf16x8 axf = *(const bf16x8*)(sXwF + (wp * 32 + l31) * 272 + ko);
            const bf16x8 axb = *(const bf16x8*)(sXwB + (wp * 32 + l31) * 272 + ko);
            accF = __builtin_amdgcn_mfma_f32_32x32x16_bf16(axf, bb, accF, 0, 0, 0);
            accB = __builtin_amdgcn_mfma_f32_32x32x16_bf16(axb, bb, accB, 0, 0, 0);
        }
    }
    if (BETA) {
        bf16_t* yp = yssd + (size_t)t0 * 2048 + h * 64 + wc * 32 + l31;
#pragma unroll
        for (int r = 0; r < 16; ++r) { const int i = wr * 32 + rowmap(r, lane); yp[(size_t)i * 2048] = f2bf(yo[r]); }
    }
    piF = pF;
    __syncthreads();
}

__device__ __forceinline__ void ssd_prompt_item(const Params& p, int seq, int h, unsigned char* lds) {
    const int lane = tid_opaque() & 63, wid = tid_opaque() >> 6, wp = wid >> 2, wn = wid & 3, l31 = lane & 31;
    const float AnegF = -__expf(p.in[14][h]), AnegB = -__expf(p.in[14][32 + h]), Dh = p.in[15][h];
    const int q0 = seq * 2;
    f32x16 SF1, SB, SF0, zero;
#pragma unroll
    for (int r = 0; r < 16; ++r) { SF1[r] = 0.f; SB[r] = 0.f; SF0[r] = 0.f; zero[r] = 0.f; }
    float piF1 = 1.f, piF0 = 1.f;
    ssd_cstep<true, false>(p, lds, q0 + 1, h, AnegF, AnegB, Dh, zero, 0, false, SF1, SB, piF1);
    ssd_cstep<true, true>(p, lds, q0, h, AnegF, AnegB, Dh, SB, 1, true, SF0, SB, piF0);
    {
        float* dstF = p.out + (size_t)T * 1024 + (size_t)(seq * 32 + h) * 8192;
        float* dstB = dstF + 8388608;
#pragma unroll
        for (int r = 0; r < 16; ++r) { const int o = (wp * 32 + rowmap(r, lane)) * 128 + wn * 32 + l31; dstF[o] = SF0[r] * piF1 + SF1[r]; dstB[o] = SB[r]; }
    }
    ssd_cstep<false, true>(p, lds, q0 + 1, h, AnegF, AnegB, Dh, SF0, 0, false, SF1, SB, piF0);
}

__device__ __forceinline__ void phase_ssd(const Params& p, unsigned char* lds) {
    const int G = gridDim.x, b = blockIdx.x;
    const bool bal = (G == 256);
    if (!bal || b < 128) {
#pragma unroll 1
        for (int v = b; v < 128; v += G) ssd_item(p, 32 + (v >> 6), v & 31, (v >> 5) & 1, lds);
    }
    const int p0 = bal ? (b < 128 ? 896 + b : (b - 128) * 7) : b, pstep = bal ? 1 : G, pend = bal ? (b < 128 ? 897 + b : (b - 128) * 7 + 7) : 1024;
#pragma unroll 1
    for (int pi = p0; pi < pend; pi += pstep) ssd_prompt_item(p, pi >> 5, pi & 31, lds);
}

__device__ __forceinline__ void phase_combine(const Params& p) {
    const int lane = tid_opaque() & 63, wid = tid_opaque() >> 6;
    bf16_t* yssd = (bf16_t*)(p.ws + WS_YSSD);
    const bf16_t* zs = (const bf16_t*)(p.ws + WS_ZS);
    const bf16_t* ysb2 = (const bf16_t*)(p.ws + WS_YSB2);
    const float* g = p.in[16];
    for (int t = blockIdx.x * 8 + wid; t < T; t += gridDim.x * 8) {
        float y[32]; float ss = 0.f;
#pragma unroll
        for (int i = 0; i < 4; ++i) { const int c = i * 512 + lane * 8;
            const uint4 a = *(const uint4*)(yssd + (size_t)t * 2048 + c), b = *(const uint4*)(zs + (size_t)t * 2048 + c);
            uint4 a2 = make_uint4(0u, 0u, 0u, 0u);
            if (t >= TP) a2 = *(const uint4*)(ysb2 + (size_t)(t - TP) * 2048 + c);
            const unsigned aw[4] = {a.x, a.y, a.z, a.w}, bw[4] = {b.x, b.y, b.z, b.w}, cw[4] = {a2.x, a2.y, a2.z, a2.w};
#pragma unroll
            for (int u = 0; u < 4; ++u) { const float y0 = (__uint_as_float(aw[u] << 16) + __uint_as_float(cw[u] << 16)) * siluf(__uint_as_float(bw[u] << 16)), y1 = (__uint_as_float(aw[u] & 0xffff0000u) + __uint_as_float(cw[u] & 0xffff0000u)) * siluf(__uint_as_float(bw[u] & 0xffff0000u));
                y[i * 8 + 2 * u] = y0; y[i * 8 + 2 * u + 1] = y1; ss += y0 * y0 + y1 * y1; } }
#pragma unroll
        for (int o = 32; o > 0; o >>= 1) ss += __shfl_xor(ss, o);
        const float rstd = rsqrtf(ss * (1.f / 2048.f) + 1e-6f);
#pragma unroll
        for (int i = 0; i < 4; ++i) { const int c = i * 512 + lane * 8; const float4 g0 = *(const float4*)(g + c), g1 = *(const float4*)(g + c + 4);
            *(uint4*)(yssd + (size_t)t * 2048 + c) = make_uint4(pk2(y[i * 8] * rstd * g0.x, y[i * 8 + 1] * rstd * g0.y), pk2(y[i * 8 + 2] * rstd * g0.z, y[i * 8 + 3] * rstd * g0.w),
                                                                pk2(y[i * 8 + 4] * rstd * g1.x, y[i * 8 + 5] * rstd * g1.y), pk2(y[i * 8 + 6] * rstd * g1.z, y[i * 8 + 7] * rstd * g1.w)); }
    }
}

__device__ __forceinline__ void phase_merge(const Params& p, unsigned char* lds) {
    const bf16_t* yfm = (const bf16_t*)(p.ws + WS_YFM);
    const bf16_t* ys = (const bf16_t*)(p.ws + WS_YSSD);
    const bf16_t* wf = (const bf16_t*)(p.ws + WS_WF);
    const bf16_t* wso = (const bf16_t*)(p.ws + WS_WSO);
    const bf16_t* gates = (const bf16_t*)((unsigned char*)p.out + DO_GATES);
    bf16_t* m = (bf16_t*)(p.ws + WS_M);
    for_tiles(64, 4, [&](int mt, int nt) {
        f32x16 acc[3][2]; zero_acc<3, 2>(acc);
        gemm_mainloop<3, 64, 2, 2, true>(acc, yfm + (size_t)mt * 192 * 1024, 1024, wf + (size_t)nt * 256 * 1024, 1024, 1024, lds);
        for_each_acc4<3, 2, 2>(acc, mt * 192, nt * 256, [&](int row, int col, float4& v) {
            const float4 g = bf4_to_f4(*(const uint2*)(gates + (size_t)row * 2048 + col));
            *(uint2*)(m + (size_t)row * 1024 + col) = f4_to_bf4(make_float4(v.x * g.x, v.y * g.y, v.z * g.z, v.w * g.w)); });
        zero_acc<3, 2>(acc);
        gemm_mainloop<3, 64, 2, 2, true>(acc, ys + (size_t)mt * 192 * 2048, 2048, wso + (size_t)nt * 256 * 2048, 2048, 2048, lds);
        for_each_acc4<3, 2, 2>(acc, mt * 192, nt * 256, [&](int row, int col, float4& v) {
            const float4 g = bf4_to_f4(*(const uint2*)(gates + (size_t)row * 2048 + 1024 + col));
            uint2* d = (uint2*)(m + (size_t)row * 1024 + col); const float4 o = bf4_to_f4(*d);
            *d = f4_to_bf4(make_float4(o.x + v.x * g.x, o.y + v.y * g.y, o.z + v.z * g.z, o.w + v.w * g.w)); });
    });
}

__device__ __forceinline__ void phase_out(const Params& p, unsigned char* lds) {
    const bf16_t* m = (const bf16_t*)(p.ws + WS_M);
    const bf16_t* wo = (const bf16_t*)(p.ws + WS_WO);
    const float* mod = (const float*)(p.ws + WS_MOD);
    for_tiles(64, 4, [&](int mt, int nt) {
        f32x16 acc[3][2]; zero_acc<3, 2>(acc);
        gemm_mainloop<3, 64, 2, 2, true>(acc, m + (size_t)mt * 192 * 1024, 1024, wo + (size_t)nt * 256 * 1024, 1024, 1024, lds);
        for_each_acc4<3, 2, 2>(acc, mt * 192, nt * 256, [&](int row, int col, float4& v) {
            const float4 x = *(const float4*)(xrow(p, row) + col), g = *(const float4*)(mod + modidx(row) * 6144 + 2048 + col);
            *(float4*)(p.out + (size_t)row * 1024 + col) = make_float4(x.x + g.x * v.x, x.y + g.y * v.y, x.z + g.z * v.z, x.w + g.w * v.w); });
    });
}

__device__ __forceinline__ void phase_ff1(const Params& p, unsigned char* lds) {
    const bf16_t* h2 = (const bf16_t*)(p.ws + WS_H2);
    const bf16_t* w1 = (const bf16_t*)(p.ws + WS_W1);
    bf16_t* f = (bf16_t*)(p.ws + WS_F);
    for_tiles(48, 16, [&](int mt, int nt) {
        f32x16 acc[2][4]; zero_acc<2, 4>(acc);
        gemm_mainloop<2, 64, 4>(acc, h2 + (size_t)mt * 256 * 1024, 1024, w1 + (size_t)nt * 256 * 1024, 1024, 1024, lds);
        for_each_acc<2, 4>(acc, mt * 256, nt * 256, [&](int row, int col, float& v) { const float r = v > 0.f ? v : 0.f; f[(size_t)row * 4096 + col] = f2bf(r * r); });
    });
}

__device__ __forceinline__ void phase_ff2(const Params& p, unsigned char* lds) {
    const bf16_t* f = (const bf16_t*)(p.ws + WS_F);
    const bf16_t* w2 = (const bf16_t*)(p.ws + WS_W2);
    const float* mod = (const float*)(p.ws + WS_MOD);
    for_tiles(64, 4, [&](int mt, int nt) {
        f32x16 acc[3][2]; zero_acc<3, 2>(acc);
        gemm_mainloop<3, 64, 2, 2, true>(acc, f + (size_t)mt * 192 * 4096, 4096, w2 + (size_t)nt * 256 * 4096, 4096, 4096, lds);
        for_each_acc4<3, 2, 2>(acc, mt * 192, nt * 256, [&](int row, int col, float4& v) {
            float4* d = (float4*)(p.out + (size_t)row * 1024 + col); const float4 x = *d, g = *(const float4*)(mod + modidx(row) * 6144 + 5120 + col);
            *d = make_float4(x.x + g.x * v.x, x.y + g.y * v.y, x.z + g.z * v.z, x.w + g.w * v.w); });
    });
}

__global__ void __launch_bounds__(NT) fwd_megakernel(Params p) {
    extern __shared__ __attribute__((aligned(16))) unsigned char lds[];
    cg::grid_group grid = cg::this_grid();
    if (__builtin_amdgcn_workitem_id_x() == 0) *(uint4*)(lds + LDS_ST) = make_uint4(0u, 0u, 0u, 0u);
    __syncthreads();
    XcdBarrier xb = xcd_barrier_post((unsigned*)(p.ws + WS_BAR), (volatile LAS unsigned*)(lds + LDS_ST));
#define RUN(k, call) if (PH_ON(k) && p.ph_lo <= (k) && (k) < p.ph_hi) { call; } if ((k) == REPEAT_PH) { call; } if (p.ph_lo <= (k) && (k) + 1 < p.ph_hi) { if ((k) == 0) grid.sync(); else xcd_barrier(xb); }
    RUN(0, phase_prep(p, lds))
    RUN(1, phase_norm(p, 0))
    RUN(2, phase_inproj(p, lds))
    RUN(3, phase_conv_f1(p, lds))
    RUN(4, phase_f1(p, lds))
    RUN(5, phase_f2(p, lds))
    RUN(6, phase_ssd(p, lds))
    RUN(7, phase_combine(p))
    RUN(8, phase_merge(p, lds))
    RUN(9, phase_out(p, lds))
    RUN(10, phase_norm(p, 1))
    RUN(11, phase_ff1(p, lds))
    RUN(12, phase_ff2(p, lds))
    if (PH_ON(13) && p.ph_lo <= 13 && 13 < p.ph_hi) phase_norm(p, 2);
}

extern "C" void kernel_launch(void* const* d_in, const int* in_sizes, int n_in, void* d_out, int out_size, void* d_ws, size_t ws_size, hipStream_t stream) {
    static int grid_blocks = 0;
    if (grid_blocks == 0) {
        if (n_in != 23 || ws_size < WS_END || out_size != T * 1024 + 2 * 8388608) { fprintf(stderr, "kernel_launch: unexpected shapes (n_in %d, ws %zu, out %d)\n", n_in, ws_size, out_size); grid_blocks = -1; return; }
        int dev = 0, cus = 0, per_cu = 0;
        (void)hipGetDevice(&dev);
        (void)hipDeviceGetAttribute(&cus, hipDeviceAttributeMultiprocessorCount, dev);
        if (hipFuncSetAttribute((const void*)fwd_megakernel, hipFuncAttributeMaxDynamicSharedMemorySize, LDS_BYTES) != hipSuccess) { fprintf(stderr, "kernel_launch: hipFuncSetAttribute failed\n"); grid_blocks = -1; return; }
        if (hipOccupancyMaxActiveBlocksPerMultiprocessor(&per_cu, (const void*)fwd_megakernel, NT, LDS_BYTES) != hipSuccess || per_cu < 1) { fprintf(stderr, "kernel_launch: occupancy query failed (%d)\n", per_cu); grid_blocks = -1; return; }
        grid_blocks = cus * per_cu;
    }
    if (grid_blocks < 0) return;
    Params p{};
    for (int i = 0; i < 23; ++i) p.in[i] = (const float*)d_in[i];
    p.out = (float*)d_out; p.ws = (unsigned char*)d_ws;
    if (hipMemsetAsync((unsigned char*)d_ws + WS_BAR, 0, XCD_BAR_WORDS * 4, stream) != hipSuccess) { fprintf(stderr, "kernel_launch: memset failed\n"); return; }
#if ONE_LAUNCH
    p.ph_lo = 0; p.ph_hi = NPH + 1;
    void* args[] = {&p};
    hipError_t e = hipLaunchCooperativeKernel((const void*)fwd_megakernel, dim3(grid_blocks), dim3(NT), args, LDS_BYTES, stream);
    if (e != hipSuccess) fprintf(stderr, "cooperative launch failed: %s (grid %d)\n", hipGetErrorString(e), grid_blocks);
#else
    for (int ph = 0; ph <= NPH; ++ph) {
        p.ph_lo = ph; p.ph_hi = ph + 1;
        hipLaunchKernelGGL(fwd_megakernel, dim3(grid_blocks), dim3(NT), LDS_BYTES, stream, p);
    }
#endif
}
```

```cpp
#include <hip/hip_runtime.h>
#include <hip/hip_cooperative_groups.h>
#include <cstdio>
#include <cstdint>
namespace cg = cooperative_groups;

#ifndef PHMASK
#define PHMASK 0xFFFF
#endif
#define PH_ON(n) ((PHMASK >> (n)) & 1)
#ifndef REPEAT_PH
#define REPEAT_PH -1
#endif
#ifndef ONE_LAUNCH
#define ONE_LAUNCH 1
#endif

typedef unsigned short bf16_t;
typedef short bf16x8 __attribute__((ext_vector_type(8)));
typedef float f32x16 __attribute__((ext_vector_type(16)));

#define NT 512
constexpr int T = 12288, TP = 8192;
constexpr int NPH = 13;
constexpr size_t MiB = 1048576;
constexpr size_t WS_WF = 0, WS_WSO = 2 * MiB, WS_WO = 6 * MiB, WS_W1 = 8 * MiB, WS_W2 = 16 * MiB;
constexpr size_t WS_CSC = 24 * MiB, WS_A256 = 24 * MiB + 262144, WS_MOD = 24 * MiB + 524288, WS_DTB = 25 * MiB;
constexpr size_t WS_WIN = 28 * MiB;
constexpr size_t WS_YSB2 = 28 * MiB;
constexpr size_t WS_ZS = 45 * MiB;
constexpr size_t WS_XBC = 93 * MiB;
constexpr size_t WS_Z1P = 93 * MiB;
constexpr size_t WS_Z1S = 125 * MiB;
constexpr size_t WS_YFM = 141 * MiB;
constexpr size_t WS_YSSD = 93 * MiB;
constexpr size_t WS_XT = 165 * MiB;
constexpr size_t WS_CM = 213 * MiB, WS_BM = 225 * MiB, WS_BT = 237 * MiB;
constexpr size_t WS_M = 165 * MiB;
constexpr size_t WS_H2 = 189 * MiB;
constexpr size_t WS_F = 45 * MiB;
constexpr size_t WS_BAR = 249 * MiB;
constexpr size_t WS_END = 250 * MiB;
constexpr size_t DO_GATES = 0, DO_H1 = 48 * MiB, DO_UF = 72 * MiB, DO_APOS = 96 * MiB;
constexpr int LDS_ST = 147456;
constexpr int LDS_BYTES = 147472;

struct Params {
    const float* in[23];
    float* out;
    unsigned char* ws;
    int ph_lo, ph_hi;
};

__device__ __forceinline__ int tid_opaque() { int t = (int)__builtin_amdgcn_workitem_id_x(); asm volatile("" : "+v"(t)); return t; }
typedef __bf16 bf16x2v __attribute__((ext_vector_type(2)));
typedef float f32x2v __attribute__((ext_vector_type(2)));
__device__ __forceinline__ unsigned pk2(float lo, float hi) { f32x2v v = {lo, hi}; bf16x2v b = __builtin_convertvector(v, bf16x2v); return __builtin_bit_cast(unsigned, b); }
__device__ __forceinline__ bf16_t f2bf(float f) { return (bf16_t)(pk2(f, f) & 0xffffu); }
__device__ __forceinline__ float bf2f(bf16_t h) { return __uint_as_float(((unsigned)h) << 16); }
__device__ __forceinline__ float sigmf(float v) { return __builtin_amdgcn_rcpf(1.f + __expf(-v)); }
__device__ __forceinline__ float siluf(float v) { return v * sigmf(v); }
__device__ __forceinline__ int rowmap(int reg, int lane) { return (reg & 3) + 8 * (reg >> 2) + 4 * (lane >> 5); }


#define XB_TMO      128
#define XB_XCNT(j)  (256  + 64 * (j))
#define XB_XSUB(j)  (1280 + 64 * (j))
#define XB_XGEN(j)  (2304 + 64 * (j))
#define XB_TOP      3328
#define XB_TOPGEN   3392
#define XCD_BAR_WORDS 3456
#define XB_SPIN_CAP (1u << 18)
#define LAS __attribute__((address_space(3)))
__device__ __forceinline__ unsigned xb_ld(unsigned* p)              { return __hip_atomic_load(p, __ATOMIC_RELAXED, __HIP_MEMORY_SCOPE_AGENT); }
__device__ __forceinline__ unsigned xb_add(unsigned* p, unsigned v) { return __hip_atomic_fetch_add(p, v, __ATOMIC_RELAXED, __HIP_MEMORY_SCOPE_AGENT); }
__device__ __forceinline__ unsigned xb_xcc_id() { return (unsigned)__builtin_amdgcn_s_getreg((3 << 11) | 20) & 0xFu; }
#define XB_SPIN(cond, bar) do { unsigned _sp = 0; while (cond) { __builtin_amdgcn_s_sleep(1); \
    if ((++_sp & 255u) == 0u) { if (xb_ld(&(bar)[XB_TMO])) break; if (_sp > XB_SPIN_CAP) { atomicAdd(&(bar)[XB_TMO], 1u); break; } } } } while (0)
struct XcdBarrier { unsigned* bar; unsigned x; volatile LAS unsigned* st; };
__device__ __forceinline__ XcdBarrier xcd_barrier_post(unsigned* bar, volatile LAS unsigned* st) {
    XcdBarrier b; b.bar = bar; b.x = xb_xcc_id(); b.st = st;
    if (__builtin_amdgcn_workitem_id_x() == 0) (void)xb_add(&bar[XB_XCNT(b.x)], 1u);
    return b;
}
__device__ __forceinline__ void xcd_barrier_complete(unsigned* bar, unsigned x, unsigned& nloc, unsigned& nx) {
    const unsigned G = gridDim.x * gridDim.y * gridDim.z;
    unsigned sum, cnt, mine, sp = 0u;
    for (;;) {
        sum = 0u; cnt = 0u; mine = 0u;
#pragma unroll
        for (unsigned j = 0; j < 16; ++j) { const unsigned c = xb_ld(&bar[XB_XCNT(j)]); sum += c; cnt += (c > 0u) ? 1u : 0u; mine = (j == x) ? c : mine; }
        if (sum == G) break;
        __builtin_amdgcn_s_sleep(1);
        if ((++sp & 255u) == 0u) { if (xb_ld(&bar[XB_TMO])) break; if (sp > XB_SPIN_CAP) { atomicAdd(&bar[XB_TMO], 1u); break; } }
    }
    nloc = mine > 0u ? mine : 1u; nx = cnt > 0u ? cnt : 1u;
}
__device__ __forceinline__ void xcd_barrier(const XcdBarrier& b) {
    asm volatile("s_waitcnt vmcnt(0)" ::: "memory");
    __syncthreads();
    if (__builtin_amdgcn_workitem_id_x() == 0) {
        unsigned* bar = b.bar;
        __builtin_amdgcn_s_waitcnt(0);
        unsigned nloc = b.st[0], nx = b.st[1];
        if (nloc == 0u) { xcd_barrier_complete(bar, b.x, nloc, nx); b.st[0] = nloc; b.st[1] = nx; }
        const unsigned old = xb_add(&bar[XB_XSUB(b.x)], 1u);
        const unsigned gen = old / nloc;
        if (old + 1u == (gen + 1u) * nloc) {
            __builtin_amdgcn_fence(__ATOMIC_RELEASE, "agent");
            asm volatile("s_waitcnt vmcnt(0)" ::: "memory");
            const unsigned og = xb_add(&bar[XB_TOP], 1u);
            const unsigned tg = og / nx;
            if (og + 1u == (tg + 1u) * nx) xb_add(&bar[XB_TOPGEN], 1u);
            else XB_SPIN(xb_ld(&bar[XB_TOPGEN]) == tg, bar);
            __builtin_amdgcn_fence(__ATOMIC_ACQUIRE, "agent");
            xb_add(&bar[XB_XGEN(b.x)], 1u);
            asm volatile("s_waitcnt vmcnt(0)" ::: "memory");
        } else {
            XB_SPIN(xb_ld(&bar[XB_XGEN(b.x)]) == gen, bar);
            __builtin_amdgcn_fence(__ATOMIC_ACQUIRE, "agent");
            asm volatile("s_waitcnt vmcnt(0)" ::: "memory");
        }
    }
    __syncthreads();
}

namespace pg8 {
#define PG8_LAS __attribute__((address_space(3)))
typedef unsigned short bf16_t;
typedef short bf16x8 __attribute__((ext_vector_type(8)));
typedef float f32x4 __attribute__((ext_vector_type(4)));
typedef unsigned u32x4 __attribute__((ext_vector_type(4)));
constexpr int BM = 256, BK = 64, HALF = 128, HTB = HALF * BK * 2  , STAGE_BYTES = 8 * HTB, NXCD = 8, WGM = 8;

__host__ __device__ __forceinline__ int lds_byte(int r, int c) { const int st = (r >> 4) * 2 + (c >> 5), rr = r & 15, cc = c & 31, ob = rr * 64 + cc * 2; return st * 1024 + (ob ^ (((ob >> 9) & 1) << 5)); }
__host__ __device__ __forceinline__ void stage_rc(int b, int& R, int& C) { const int st = b / 1024, sb = b % 1024, swz = sb ^ (((sb >> 9) & 1) << 5); R = (st >> 1) * 16 + swz / 64; C = (st & 1) * 32 + (swz % 64) / 2; }
__host__ __device__ __forceinline__ int perm32(int rho) { const int n = rho >> 4, i = rho & 15; return 8 * (i >> 2) + 4 * n + (i & 3); }

struct Unit { int pm, pn; };
struct Gemm { const bf16_t* A; const bf16_t* Bt; int M, N, K; };

struct StaticOrder {
    int nM, nN, nwg, G, c;
    __host__ __device__ void init(int M, int N, int G_, int c_) { nM = M / BM; nN = N / BM; nwg = nM * nN; G = G_; c = c_; }
    __host__ __device__ bool next(int i, Unit& u) const {
        const long L = (long)i * G + c; if (L >= nwg) return false;
        int wgid = (int)L; { const int q = nwg / NXCD, r = nwg % NXCD, xcd = wgid % NXCD, off = wgid / NXCD; wgid = (xcd < r ? xcd * (q + 1) : r * (q + 1) + (xcd - r) * q) + off; }
        const int nig = WGM * nN, gid = wgid / nig, fm = gid * WGM, gsz = (nM - fm) < WGM ? (nM - fm) : WGM;
        u.pm = fm + ((wgid % nig) % gsz); u.pn = (wgid % nig) / gsz; return true;
    }
    __device__ __forceinline__ void a_ready(const Unit&) const {}
    __device__ __forceinline__ void done(const Unit&) const {}
};
template <class Epi, class Sched, bool STAMP = false>
__device__ __forceinline__ void gemm_phase(PG8_LAS unsigned char* lds, const Gemm g, const Sched& S, const Epi& E, unsigned long long* stamps) {
    const int tid = threadIdx.x, wid = __builtin_amdgcn_readfirstlane(tid >> 6), lane = tid & 63, wr = wid >> 2, wc = wid & 3, fr = lane & 15, fq = lane >> 4;
    const int K = g.K, nt = K / BK;
    int ts_lo = 0, ts_hi = 0, nts = 0; const unsigned long long rt_entry = STAMP ? (unsigned long long)wall_clock64() : 0ull;
#define PG8_STAMP() do { if (STAMP && wid == 0 && nts < 64) { const unsigned long long _c = (unsigned long long)clock64(); \
        ts_lo = (lane == nts) ? (int)(unsigned)_c : ts_lo; ts_hi = (lane == nts) ? (int)(unsigned)(_c >> 32) : ts_hi; ++nts; } } while (0)
    PG8_STAMP();
    unsigned voffA[2], voffB[2];
#pragma unroll
    for (int i = 0; i < 2; ++i) { int R, C; stage_rc(tid * 16 + i * 8192, R, C); const int Rb = Epi::PERM ? ((R & ~31) + perm32(R & 31)) : R;
        voffA[i] = (unsigned)(R * K + C) * 2u; voffB[i] = (unsigned)(Rb * K + C) * 2u; }
    const size_t kstep = (size_t)(BK * 2);
    const size_t hstep = (size_t)HALF * K * 2;
    const size_t tstep = 2 * hstep;
    const unsigned ldsw = (unsigned)wid * 1024u;
    const int aoff = lds_byte(wr * 64 + fr, fq * 8), boff = lds_byte(wc * 32 + fr, fq * 8);
#define PG8_SA(b, h) (((b) * 2 + (h)) * HTB)
#define PG8_SB(b, h) ((4 + (b) * 2 + (h)) * HTB)
#define PG8_STAGE(bufoff, gbase, voff) do { _Pragma("unroll") for (int _i = 0; _i < 2; ++_i) \
        __builtin_amdgcn_global_load_lds((const unsigned*)((const char*)(gbase) + (voff)[_i]), (PG8_LAS unsigned*)(lds + (bufoff) + ldsw + _i * 8192), 16, 0, 0); } while (0)
#define PG8_LDA(dst, b, h) do { _Pragma("unroll") for (int m = 0; m < 4; ++m) _Pragma("unroll") for (int k = 0; k < 2; ++k) dst[m][k] = *(const PG8_LAS bf16x8*)(lds + PG8_SA(b, h) + aoff + m * 2048 + k * 1024); } while (0)
#define PG8_LDB(dst, b, h) do { _Pragma("unroll") for (int n = 0; n < 2; ++n) _Pragma("unroll") for (int k = 0; k < 2; ++k) dst[n][k] = *(const PG8_LAS bf16x8*)(lds + PG8_SB(b, h) + boff + n * 2048 + k * 1024); } while (0)
#define PG8_MMA(ai, bj, At, Bt) do { __builtin_amdgcn_s_setprio(1); _Pragma("unroll") for (int m = 0; m < 4; ++m) _Pragma("unroll") for (int n = 0; n < 2; ++n) _Pragma("unroll") for (int k = 0; k < 2; ++k) \
        acc[ai][bj][m][n] = __builtin_amdgcn_mfma_f32_16x16x32_bf16(Bt[n][k], At[m][k], acc[ai][bj][m][n], 0, 0, 0); __builtin_amdgcn_s_setprio(0); } while (0)
#define PG8_WAIT_V(n) asm volatile("s_waitcnt vmcnt(" #n ")" ::: "memory")
#define PG8_WAIT_L(n) asm volatile("s_waitcnt lgkmcnt(" #n ")" ::: "memory")
#define PG8_BAR __builtin_amdgcn_s_barrier()
#define PG8_SCHED __builtin_amdgcn_sched_barrier(0)
    Unit cur, nxt; int ui = 0;
    if (!S.next(0, cur)) return;
    f32x4 acc[2][2][4][2];
#pragma unroll
    for (int a = 0; a < 2; ++a)
#pragma unroll
        for (int b = 0; b < 2; ++b)
#pragma unroll
            for (int m = 0; m < 4; ++m)
#pragma unroll
                for (int n = 0; n < 2; ++n) acc[a][b][m][n] = (f32x4){0.f, 0.f, 0.f, 0.f};
    bf16x8 At[4][2], B0[2][2], B1[2][2];
    const char* cA = (const char*)g.A + (size_t)cur.pm * tstep; const char* cB = (const char*)g.Bt + (size_t)cur.pn * tstep;
    S.a_ready(cur);
    PG8_STAGE(PG8_SB(0, 0), cB, voffB); PG8_STAGE(PG8_SA(0, 0), cA, voffA); PG8_STAGE(PG8_SB(0, 1), cB + hstep, voffB); PG8_STAGE(PG8_SA(0, 1), cA + hstep, voffA);
    if (wr == 1) PG8_BAR;
    PG8_WAIT_V(4); PG8_BAR;
    PG8_STAGE(PG8_SB(1, 0), cB + kstep, voffB); PG8_STAGE(PG8_SA(1, 0), cA + kstep, voffA); PG8_STAGE(PG8_SB(1, 1), cB + hstep + kstep, voffB);
    PG8_WAIT_V(6); PG8_BAR;
    PG8_STAMP();
    for (;;) {
        const bool has_next = S.next(ui + 1, nxt);
        const char* nA = has_next ? (const char*)g.A + (size_t)nxt.pm * tstep : cA; const char* nB = has_next ? (const char*)g.Bt + (size_t)nxt.pn * tstep : cB;
        for (int t = 0; t < nt; t += 2) {
            const bool last = (t == nt - 2);
            const char* a1 = cA + (size_t)(t + 1) * kstep;
            const char* a2 = last ? nA : cA + (size_t)(t + 2) * kstep; const char* b2 = last ? nB : cB + (size_t)(t + 2) * kstep;
            const char* a3 = a2 + kstep; const char* b3 = b2 + kstep;
            if (last && has_next) S.a_ready(nxt);
            PG8_LDB(B0, 0, 0); PG8_SCHED; PG8_LDA(At, 0, 0); PG8_STAGE(PG8_SA(1, 1), a1 + hstep, voffA);
            PG8_WAIT_L(8); PG8_BAR; PG8_WAIT_L(0); PG8_MMA(0, 0, At, B0); PG8_BAR; PG8_SCHED;
            PG8_LDB(B1, 0, 1); PG8_STAGE(PG8_SB(0, 0), b2, voffB);
            PG8_BAR; PG8_WAIT_L(0); PG8_MMA(0, 1, At, B1); PG8_BAR;
            PG8_LDA(At, 0, 1); PG8_STAGE(PG8_SA(0, 0), a2, voffA);
            PG8_BAR; PG8_WAIT_L(0); PG8_MMA(1, 0, At, B0); PG8_BAR; PG8_SCHED;
            PG8_STAGE(PG8_SB(0, 1), b2 + hstep, voffB);
            PG8_WAIT_V(6); PG8_BAR; PG8_MMA(1, 1, At, B1); PG8_BAR;
            PG8_LDB(B0, 1, 0); PG8_SCHED; PG8_LDA(At, 1, 0); PG8_STAGE(PG8_SA(0, 1), a2 + hstep, voffA);
            PG8_WAIT_L(8); PG8_BAR; PG8_WAIT_L(0); PG8_MMA(0, 0, At, B0); PG8_BAR; PG8_SCHED;
            PG8_LDB(B1, 1, 1); PG8_STAGE(PG8_SB(1, 0), b3, voffB);
            PG8_BAR; PG8_WAIT_L(0); PG8_MMA(0, 1, At, B1); PG8_BAR;
            PG8_LDA(At, 1, 1); PG8_STAGE(PG8_SA(1, 0), a3, voffA);
            PG8_BAR; PG8_WAIT_L(0); PG8_MMA(1, 0, At, B0); PG8_BAR; PG8_SCHED;
            PG8_STAGE(PG8_SB(1, 1), b3 + hstep, voffB);
            PG8_WAIT_V(6); PG8_BAR; PG8_MMA(1, 1, At, B1); PG8_BAR;
        }
        PG8_STAMP();
        if constexpr (!Epi::AFTER_DRAIN) { E(acc, cur, wr, wc, fr, fq); S.done(cur); }
        PG8_STAMP();
        if (!has_next) break;
#pragma unroll
        for (int a = 0; a < 2; ++a)
#pragma unroll
            for (int b = 0; b < 2; ++b)
#pragma unroll
                for (int m = 0; m < 4; ++m)
#pragma unroll
                    for (int n = 0; n < 2; ++n) acc[a][b][m][n] = (f32x4){0.f, 0.f, 0.f, 0.f};
        cur = nxt; cA = nA; cB = nB; ++ui;
    }
    PG8_WAIT_V(0);
    if (wr == 0) PG8_BAR;
    PG8_BAR;
    if constexpr (Epi::AFTER_DRAIN) { E.fused(acc, cur, wr, wc, fr, fq, lds, wid, lane); S.done(cur); }
    PG8_STAMP();
    if (STAMP && wid == 0) { stamps[lane] = lane < nts ? (((unsigned long long)(unsigned)ts_hi << 32) | (unsigned)ts_lo) : 0ull;
        if (lane == 62) stamps[62] = rt_entry; if (lane == 63) stamps[63] = (unsigned long long)wall_clock64(); }
#undef PG8_STAMP
#undef PG8_SA
#undef PG8_SB
#undef PG8_STAGE
#undef PG8_LDA
#undef PG8_LDB
#undef PG8_MMA
#undef PG8_WAIT_V
#undef PG8_WAIT_L
#undef PG8_BAR
#undef PG8_SCHED
}
}

template <int MI, int BK = 64, int NI = 2, int WR = 4, bool TR = false>
__device__ __forceinline__ void gemm_mainloop(f32x16 (&acc)[MI][NI], const bf16_t* __restrict__ A, int lda, const bf16_t* __restrict__ Bt, int ldb, int K, unsigned char* lds) {
    constexpr int WC = 8 / WR;
    constexpr int BM = 32 * MI * WR, BN = 32 * NI * WC;
    constexpr int RS = (BK + 8) * 2;
    constexpr int VPR = BK / 8;
    constexpr int RPP = NT / VPR;
    constexpr int NA = BM / RPP, NB = BN / RPP;
    constexpr int ABYTES = BM * RS, BBYTES = BN * RS, STAGE = ABYTES + BBYTES;
    static_assert(NA >= 2 && NA <= 4 && NB >= 2 && NB <= 4 && BM % RPP == 0 && BN % RPP == 0, "tile config");
    const int tid = tid_opaque(), lane = tid & 63, wid = tid >> 6, wr = wid / WC, wc = wid % WC;
    const int lr = tid / VPR, lk = tid % VPR;
    uint4 ra0, ra1, ra2, ra3, rb0, rb1, rb2, rb3;
    const bf16_t* Ap = A + (size_t)lr * lda + lk * 8;
    const bf16_t* Bp = Bt + (size_t)lr * ldb + lk * 8;
    const int nk = K / BK;
    const int wo = lr * RS + lk * 16;
#define G_LOAD(k0) { ra0 = *(const uint4*)(Ap + (k0)); ra1 = *(const uint4*)(Ap + (size_t)RPP * lda + (k0)); \
        if (NA >= 3) ra2 = *(const uint4*)(Ap + (size_t)(2 * RPP) * lda + (k0)); \
        if (NA >= 4) ra3 = *(const uint4*)(Ap + (size_t)(3 * RPP) * lda + (k0)); \
        rb0 = *(const uint4*)(Bp + (k0)); rb1 = *(const uint4*)(Bp + (size_t)RPP * ldb + (k0)); \
        if (NB >= 3) rb2 = *(const uint4*)(Bp + (size_t)(2 * RPP) * ldb + (k0)); \
        if (NB >= 4) rb3 = *(const uint4*)(Bp + (size_t)(3 * RPP) * ldb + (k0)); }
#define S_STORE(buf) { *(uint4*)((buf) + wo) = ra0; *(uint4*)((buf) + wo + RPP * RS) = ra1; \
        if (NA >= 3) *(uint4*)((buf) + wo + 2 * RPP * RS) = ra2; \
        if (NA >= 4) *(uint4*)((buf) + wo + 3 * RPP * RS) = ra3; \
        *(uint4*)((buf) + ABYTES + wo) = rb0; *(uint4*)((buf) + ABYTES + wo + RPP * RS) = rb1; \
        if (NB >= 3) *(uint4*)((buf) + ABYTES + wo + 2 * RPP * RS) = rb2; \
        if (NB >= 4) *(uint4*)((buf) + ABYTES + wo + 3 * RPP * RS) = rb3; }
    ra2 = ra3 = rb2 = rb3 = make_uint4(0, 0, 0, 0);
    __syncthreads();
    G_LOAD(0)
    S_STORE(lds)
    __syncthreads();
    const int aoff = (wr * 32 * MI + (lane & 31)) * RS + (lane >> 5) * 16;
    const int boff = ABYTES + (wc * 32 * NI + (lane & 31)) * RS + (lane >> 5) * 16;
#pragma unroll 1
    for (int kt = 0; kt < nk; ++kt) {
        unsigned char* cur = lds + (kt & 1) * STAGE;
        unsigned char* nxt = lds + ((kt + 1) & 1) * STAGE;
        const bool more = (kt + 1 < nk);
        if (more) { const int k0 = (kt + 1) * BK; G_LOAD(k0) }
#pragma unroll
        for (int ks = 0; ks < BK / 16; ++ks) {
            bf16x8 af[MI], bfr[NI];
#pragma unroll
            for (int mi = 0; mi < MI; ++mi) af[mi] = *(const bf16x8*)(cur + aoff + mi * 32 * RS + ks * 32);
#pragma unroll
            for (int ni = 0; ni < NI; ++ni) bfr[ni] = *(const bf16x8*)(cur + boff + ni * 32 * RS + ks * 32);
#pragma unroll
            for (int mi = 0; mi < MI; ++mi)
#pragma unroll
                for (int ni = 0; ni < NI; ++ni)
                    acc[mi][ni] = TR ? __builtin_amdgcn_mfma_f32_32x32x16_bf16(bfr[ni], af[mi], acc[mi][ni], 0, 0, 0)
                                     : __builtin_amdgcn_mfma_f32_32x32x16_bf16(af[mi], bfr[ni], acc[mi][ni], 0, 0, 0);
        }
        if (more) S_STORE(nxt)
        __syncthreads();
    }
#undef G_LOAD
#undef S_STORE
}

template <int MI, int NI = 2>
__device__ __forceinline__ void zero_acc(f32x16 (&acc)[MI][NI]) {
#pragma unroll
    for (int mi = 0; mi < MI; ++mi)
#pragma unroll
        for (int ni = 0; ni < NI; ++ni)
#pragma unroll
            for (int r = 0; r < 16; ++r) acc[mi][ni][r] = 0.f;
}

template <int MI, int NI = 2, int WR = 4, class F>
__device__ __forceinline__ void for_each_acc(f32x16 (&acc)[MI][NI], int row0, int col0, F f) {
    constexpr int WC = 8 / WR;
    const int lane = tid_opaque() & 63, wid = tid_opaque() >> 6, wr = wid / WC, wc = wid % WC;
#pragma unroll
    for (int mi = 0; mi < MI; ++mi)
#pragma unroll
        for (int ni = 0; ni < NI; ++ni) {
            const int col = col0 + wc * 32 * NI + ni * 32 + (lane & 31);
            const int rb = row0 + wr * 32 * MI + mi * 32 + 4 * (lane >> 5);
#pragma unroll
            for (int r = 0; r < 16; ++r) { float v = acc[mi][ni][r]; f(rb + (r & 3) + 8 * (r >> 2), col, v); acc[mi][ni][r] = v; }
        }
}

template <int MI, int NI = 2, int WR = 4, class F>
__device__ __forceinline__ void for_each_acc4(f32x16 (&acc)[MI][NI], int row0, int col0, F f) {
    constexpr int WC = 8 / WR;
    const int lane = tid_opaque() & 63, wid = tid_opaque() >> 6, wr = wid / WC, wc = wid % WC;
#pragma unroll
    for (int mi = 0; mi < MI; ++mi)
#pragma unroll
        for (int ni = 0; ni < NI; ++ni) {
            const int row = row0 + wr * 32 * MI + mi * 32 + (lane & 31);
            const int cb = col0 + wc * 32 * NI + ni * 32 + 4 * (lane >> 5);
#pragma unroll
            for (int g = 0; g < 4; ++g) {
                float4 v = make_float4(acc[mi][ni][4 * g], acc[mi][ni][4 * g + 1], acc[mi][ni][4 * g + 2], acc[mi][ni][4 * g + 3]);
                f(row, cb + 8 * g, v);
                acc[mi][ni][4 * g] = v.x; acc[mi][ni][4 * g + 1] = v.y; acc[mi][ni][4 * g + 2] = v.z; acc[mi][ni][4 * g + 3] = v.w;
            }
        }
}
__device__ __forceinline__ float4 bf4_to_f4(uint2 u) { return make_float4(__uint_as_float(u.x << 16), __uint_as_float(u.x & 0xffff0000u), __uint_as_float(u.y << 16), __uint_as_float(u.y & 0xffff0000u)); }
__device__ __forceinline__ uint2 f4_to_bf4(float4 v) { return make_uint2(pk2(v.x, v.y), pk2(v.z, v.w)); }

template <class F>
__device__ __forceinline__ void for_tiles(int n_mt, int n_nt, F f) {
    const int G = gridDim.x, b = blockIdx.x;
    const bool ok = ((G & 7) == 0) && ((n_mt & 7) == 0);
    const int xcd = ok ? (b & 7) : 0, mul = ok ? 8 : 1, mpx = ok ? (n_mt >> 3) : n_mt;
    const int t0 = ok ? (b >> 3) : b, tstep = ok ? (G >> 3) : G, ntot = mpx * n_nt;
#pragma unroll 1
    for (int t = t0; t < ntot; t += tstep) f(xcd + mul * (t % mpx), t / mpx);
}

__device__ __forceinline__ const float* xrow(const Params& p, int t) { return t < TP ? p.in[0] + (size_t)t * 1024 : p.in[1] + (size_t)(t - TP) * 1024; }
__device__ __forceinline__ int modidx(int t) { return t < TP ? 0 : 1 + ((t - TP) >> 11); }

__device__ __forceinline__ void transpose_tile(const Params& p, int tI, unsigned char* lds) {
    const int tid = tid_opaque();
    const float* src; bf16_t* dst; int K, N;
    if (tI < 2064) { src = p.in[9]; dst = (bf16_t*)(p.ws + WS_WIN); K = 1024; N = 8256; }
    else if (tI < 2320) { tI -= 2064; src = p.in[10]; dst = (bf16_t*)(p.ws + WS_WF); K = 1024; N = 1024; }
    else if (tI < 2832) { tI -= 2320; src = p.in[17]; dst = (bf16_t*)(p.ws + WS_WSO); K = 2048; N = 1024; }
    else if (tI < 3088) { tI -= 2832; src = p.in[18]; dst = (bf16_t*)(p.ws + WS_WO); K = 1024; N = 1024; }
    else if (tI < 4112) { tI -= 3088; src = p.in[20]; dst = (bf16_t*)(p.ws + WS_W1); K = 1024; N = 4096; }
    else { tI -= 4112; src = p.in[21]; dst = (bf16_t*)(p.ws + WS_W2); K = 4096; N = 1024; }
    const int nkt = K >> 6; const int k0 = (tI % nkt) * 64, n0 = (tI / nkt) * 64;
    bf16_t* ts = (bf16_t*)lds;
    __syncthreads();
#pragma unroll
    for (int i = 0; i < 2; ++i) { const int idx = tid + i * NT, kr = idx >> 4, nv = idx & 15;
        const float4 v = *(const float4*)(src + (size_t)(k0 + kr) * N + n0 + nv * 4);
        ts[(nv * 4 + 0) * 72 + kr] = f2bf(v.x); ts[(nv * 4 + 1) * 72 + kr] = f2bf(v.y); ts[(nv * 4 + 2) * 72 + kr] = f2bf(v.z); ts[(nv * 4 + 3) * 72 + kr] = f2bf(v.w); }
    __syncthreads();
    { const int n = tid >> 3, kv = tid & 7; *(uint4*)(dst + (size_t)(n0 + n) * K + k0 + kv * 8) = *(const uint4*)(ts + n * 72 + kv * 8); }
}

__device__ __forceinline__ void phase_prep(const Params& p, unsigned char* lds) {
    const int tid = tid_opaque();
    float* mod = (float*)(p.ws + WS_MOD);
    const bool defer = (gridDim.x == 256);
    constexpr int N_GEMV = 192, N_TR = 5136, N_ZERO = 1, N_TAB = 32 + 32 + 2048;
    constexpr int NITEMS = N_GEMV + N_TR + N_ZERO + N_TAB;
    for (int item = blockIdx.x; item < NITEMS; item += gridDim.x) {
        if (item < N_GEMV) {
            float* sv = (float*)lds;
            float* part = sv + 3072;
            __syncthreads();
            for (int i = tid; i < 3072; i += NT) { const int r = i >> 10, k = i & 1023; const float v = (r == 0) ? p.in[5][k] : p.in[4][(r - 1) * 1024 + k]; sv[i] = siluf(v); }
            __syncthreads();
            const int col = tid & 31, kq = tid >> 5, col0 = item * 32;
            const float* w = p.in[6] + (size_t)(kq * 64) * 6144 + col0 + col;
            float a0 = 0.f, a1 = 0.f, a2 = 0.f;
#pragma unroll 16
            for (int k = 0; k < 64; ++k) { const float wv = w[(size_t)k * 6144]; const int kk = kq * 64 + k; a0 += sv[kk] * wv; a1 += sv[1024 + kk] * wv; a2 += sv[2048 + kk] * wv; }
            part[(kq * 3 + 0) * 32 + col] = a0; part[(kq * 3 + 1) * 32 + col] = a1; part[(kq * 3 + 2) * 32 + col] = a2;
            __syncthreads();
            if (tid < 96) { const int r = tid >> 5, c = tid & 31; float s = p.in[7][col0 + c];
                for (int q = 0; q < 16; ++q) s += part[(q * 3 + r) * 32 + c];
                mod[r * 6144 + col0 + c] = s; }
        } else if (item < N_GEMV + N_TR) {
            const int tI = item - N_GEMV;
            if (defer && tI >= 2832) continue;
            transpose_tile(p, tI, lds);
        } else if (item < N_GEMV + N_TR + N_ZERO) {
            uint4* d = (uint4*)(p.ws + WS_WIN + (size_t)8256 * 1024 * 2);
            for (int i = tid; i < 64 * 1024 * 2 / 16; i += NT) d[i] = make_uint4(0, 0, 0, 0);
        } else {
            const int tb = item - (N_GEMV + N_TR + N_ZERO);
            unsigned pk[4];
            bf16_t* dst; size_t e0;
            if (tb < 32) { dst = (bf16_t*)(p.ws + WS_CSC); e0 = (size_t)tb * 4096 + tid * 8;
#pragma unroll
                for (int j = 0; j < 8; j += 2) { float v[2];
                    for (int u = 0; u < 2; ++u) { const int e = (int)e0 + j + u, m = e >> 8, k = e & 255, cs = m >> 8, chp = m & 255; const float ang = (float)((chp * k) & 255) * (1.f / 128.f);
                        v[u] = (cs == 0 ? cospif(ang) : sinpif(ang)) * 0.0625f; }
                    pk[j >> 1] = pk2(v[0], v[1]); }
            } else if (tb < 64) { dst = (bf16_t*)(p.ws + WS_A256); e0 = (size_t)(tb - 32) * 4096 + tid * 8;
#pragma unroll
                for (int j = 0; j < 8; j += 2) { float v[2];
                    for (int u = 0; u < 2; ++u) { const int e = (int)e0 + j + u, lp = e >> 9, kk = e & 511, cs = kk >> 8, l = kk & 255; const float ang = (float)((lp * l) & 255) * (1.f / 128.f);
                        v[u] = (cs == 0 ? cospif(ang) : -sinpif(ang)) * 0.0625f; }
                    pk[j >> 1] = pk2(v[0], v[1]); }
            } else { dst = (bf16_t*)((unsigned char*)p.out + DO_APOS); e0 = (size_t)(tb - 64) * 4096 + tid * 8;
#pragma unroll
                for (int j = 0; j < 8; j += 2) { float v[2];
                    for (int u = 0; u < 2; ++u) { const int e = (int)e0 + j + u, lp = e >> 12, kk = e & 4095, cs = kk >> 11, l = kk & 2047;
                        const int r = l >> 6, c = l & 63, rp = lp >> 6, cp = lp & 63; const float ang = (float)((2 * r * rp + c * cp) & 63) * (1.f / 32.f);
                        v[u] = (cs == 0 ? cospif(ang) : -sinpif(ang)) * 0.02209708691f; }
                    pk[j >> 1] = pk2(v[0], v[1]); }
            }
            *(uint4*)(dst + e0) = make_uint4(pk[0], pk[1], pk[2], pk[3]);
        }
    }
}

__device__ __forceinline__ void phase_norm(const Params& p, int which) {
    const int lane = tid_opaque() & 63, wid = tid_opaque() >> 6;
    const float* mod = (const float*)(p.ws + WS_MOD);
    const float* g = which == 0 ? p.in[8] : (which == 1 ? p.in[19] : p.in[22]);
    bf16_t* dst = which == 0 ? (bf16_t*)((unsigned char*)p.out + DO_H1) : (bf16_t*)(p.ws + WS_H2);
    for (int t0 = (blockIdx.x * 8 + wid) * 2; t0 < T; t0 += gridDim.x * 16) {
        float4 v[2][4]; float ss[2] = {0.f, 0.f};
#pragma unroll
        for (int u = 0; u < 2; ++u) { const int t = t0 + u; const float* src = which == 0 ? xrow(p, t) : p.out + (size_t)t * 1024;
#pragma unroll
            for (int i = 0; i < 4; ++i) v[u][i] = *(const float4*)(src + i * 256 + lane * 4); }
#pragma unroll
        for (int u = 0; u < 2; ++u) {
#pragma unroll
            for (int i = 0; i < 4; ++i) ss[u] += v[u][i].x * v[u][i].x + v[u][i].y * v[u][i].y + v[u][i].z * v[u][i].z + v[u][i].w * v[u][i].w;
#pragma unroll
            for (int o = 32; o > 0; o >>= 1) ss[u] += __shfl_xor(ss[u], o);
        }
#pragma unroll
        for (int u = 0; u < 2; ++u) {
            const int t = t0 + u;
            const float rstd = rsqrtf(ss[u] * (1.f / 1024.f) + 1e-6f);
            if (which == 2) {
#pragma unroll
                for (int i = 0; i < 4; ++i) { const int c = i * 256 + lane * 4; const float4 gg = *(const float4*)(g + c);
                    float4 o; o.x = v[u][i].x * rstd * gg.x; o.y = v[u][i].y * rstd * gg.y; o.z = v[u][i].z * rstd * gg.z; o.w = v[u][i].w * rstd * gg.w;
                    *(float4*)(p.out + (size_t)t * 1024 + c) = o; }
            } else {
                const float* mrow = mod + modidx(t) * 6144 + (which == 0 ? 0 : 3072);
#pragma unroll
                for (int i = 0; i < 4; ++i) { const int c = i * 256 + lane * 4; const float4 gg = *(const float4*)(g + c);
                    const float4 sh = *(const float4*)(mrow + c), sc = *(const float4*)(mrow + 1024 + c);
                    const float o0 = v[u][i].x * rstd * gg.x * (1.f + sc.x) + sh.x, o1 = v[u][i].y * rstd * gg.y * (1.f + sc.y) + sh.y;
                    const float o2 = v[u][i].z * rstd * gg.z * (1.f + sc.z) + sh.z, o3 = v[u][i].w * rstd * gg.w * (1.f + sc.w) + sh.w;
                    *(uint2*)(dst + (size_t)t * 1024 + c) = make_uint2(pk2(o0, o1), pk2(o2, o3)); }
            }
        }
    }
}

struct EpiInProj {
    static constexpr bool PERM = true, AFTER_DRAIN = false;
    bf16_t* uf; bf16_t* zs; bf16_t* xbc; float* dtb; bf16_t* gates; const float* dt_bias;
    __device__ __forceinline__ void operator()(const pg8::f32x4 (&acc)[2][2][4][2], const pg8::Unit& u, int wr, int wc, int fr, int fq) const {
#pragma unroll
        for (int bj = 0; bj < 2; ++bj) {
            const int cb = __builtin_amdgcn_readfirstlane(u.pn * 256 + bj * 128 + wc * 32);
            const int rbase = u.pm * 256 + wr * 64 + fr;
            if (cb >= 6144 && cb < 6208) {
                const int j = cb - 6144 + 8 * fq;
                const float4 b0 = *(const float4*)(dt_bias + j), b1 = *(const float4*)(dt_bias + j + 4);
#pragma unroll
                for (int ai = 0; ai < 2; ++ai)
#pragma unroll
                    for (int m = 0; m < 4; ++m) {
                        const pg8::f32x4 v0 = acc[ai][bj][m][0], v1 = acc[ai][bj][m][1];
                        float x[8] = {v0[0] + b0.x, v0[1] + b0.y, v0[2] + b0.z, v0[3] + b0.w, v1[0] + b1.x, v1[1] + b1.y, v1[2] + b1.z, v1[3] + b1.w};
#pragma unroll
                        for (int e = 0; e < 8; ++e) x[e] = x[e] > 20.f ? x[e] : log1pf(__expf(x[e]));
                        float* d = dtb + (size_t)(rbase + ai * 128 + m * 16) * 64 + j;
                        *(float4*)d = make_float4(x[0], x[1], x[2], x[3]); *(float4*)(d + 4) = make_float4(x[4], x[5], x[6], x[7]);
                    }
            } else {
                bf16_t* dst; int ld, c0; bool sg = false;
                if (cb < 1024) { dst = uf; ld = 1024; c0 = cb; }
                else if (cb < 3072) { dst = zs; ld = 2048; c0 = cb - 1024; }
                else if (cb < 6144) { dst = xbc; ld = 3072; c0 = cb - 3072; }
                else { dst = gates; ld = 2048; c0 = cb - 6208; sg = true; }
                bf16_t* dp = dst + (size_t)rbase * ld + c0 + 8 * fq;
                if (sg) {
#pragma unroll
                    for (int ai = 0; ai < 2; ++ai)
#pragma unroll
                        for (int m = 0; m < 4; ++m) { const pg8::f32x4 v0 = acc[ai][bj][m][0], v1 = acc[ai][bj][m][1];
                            *(uint4*)(dp + (size_t)(ai * 128 + m * 16) * ld) = make_uint4(pk2(sigmf(v0[0]), sigmf(v0[1])), pk2(sigmf(v0[2]), sigmf(v0[3])), pk2(sigmf(v1[0]), sigmf(v1[1])), pk2(sigmf(v1[2]), sigmf(v1[3]))); }
                } else {
#pragma unroll
                    for (int ai = 0; ai < 2; ++ai)
#pragma unroll
                        for (int m = 0; m < 4; ++m) { const pg8::f32x4 v0 = acc[ai][bj][m][0], v1 = acc[ai][bj][m][1];
                            *(uint4*)(dp + (size_t)(ai * 128 + m * 16) * ld) = make_uint4(pk2(v0[0], v0[1]), pk2(v0[2], v0[3]), pk2(v1[0], v1[1]), pk2(v1[2], v1[3])); }
                }
            }
        }
    }
};

__device__ __forceinline__ void phase_inproj(const Params& p, unsigned char* lds) {
    const bf16_t* h1 = (const bf16_t*)((unsigned char*)p.out + DO_H1);
    const bf16_t* W = (const bf16_t*)(p.ws + WS_WIN);
    bf16_t* uf = (bf16_t*)((unsigned char*)p.out + DO_UF);
    bf16_t* zs = (bf16_t*)(p.ws + WS_ZS);
    bf16_t* xbc = (bf16_t*)(p.ws + WS_XBC);
    float* dtb = (float*)(p.ws + WS_DTB);
    bf16_t* gates = (bf16_t*)((unsigned char*)p.out + DO_GATES);
    const float* dt_bias = p.in[13];
    auto epi = [&](const f32x16& a, int rb, int cb, int lane) {
        if (cb >= 8256) return;
        if (cb >= 6144 && cb < 6208) {
            const int j = cb - 6144 + (lane & 31); const float bias = dt_bias[j];
#pragma unroll
            for (int r = 0; r < 16; ++r) { const float x = a[r] + bias; dtb[(size_t)(rb + (r & 3) + 8 * (r >> 2)) * 64 + j] = x > 20.f ? x : log1pf(__expf(x)); }
        } else {
            bf16_t* dst; int ld, c0; bool sg = false;
            if (cb < 1024) { dst = uf; ld = 1024; c0 = cb; }
            else if (cb < 3072) { dst = zs; ld = 2048; c0 = cb - 1024; }
            else if (cb < 6144) { dst = xbc; ld = 3072; c0 = cb - 3072; }
            else { dst = gates; ld = 2048; c0 = cb - 6208; sg = true; }
            bf16_t* dp = dst + (size_t)rb * ld + c0 + (lane & 31);
            if (sg) {
#pragma unroll
                for (int r = 0; r < 16; ++r) dp[(size_t)((r & 3) + 8 * (r >> 2)) * ld] = f2bf(sigmf(a[r]));
            } else {
#pragma unroll
                for (int r = 0; r < 16; ++r) dp[(size_t)((r & 3) + 8 * (r >> 2)) * ld] = f2bf(a[r]);
            }
        }
    };
    {
        pg8::Gemm g{h1, W, T, 8192, 1024};
        pg8::StaticOrder S; S.init(T, 8192, (int)gridDim.x, (int)blockIdx.x);
        EpiInProj E{uf, zs, xbc, dtb, gates, dt_bias};
        pg8::gemm_phase<EpiInProj, pg8::StaticOrder, false>((PG8_LAS unsigned char*)lds, g, S, E, nullptr);
    }
    for (int mt = (int)gridDim.x - 1 - (int)blockIdx.x; mt < 48; mt += gridDim.x) {
        f32x16 acc[2][2]; zero_acc<2>(acc);
        gemm_mainloop<2>(acc, h1 + (size_t)mt * 256 * 1024, 1024, W + (size_t)8192 * 1024, 1024, 1024, lds);
        const int lane = tid_opaque() & 63, wid = tid_opaque() >> 6, wr = wid >> 1, wc = wid & 1;
#pragma unroll
        for (int mi = 0; mi < 2; ++mi)
#pragma unroll
            for (int ni = 0; ni < 2; ++ni)
                epi(acc[mi][ni], mt * 256 + wr * 64 + mi * 32 + 4 * (lane >> 5), __builtin_amdgcn_readfirstlane(8192 + wc * 64 + ni * 32), lane);
    }
}

struct ConvPre { uint4 v0, v1, v2; float w; };
__device__ __forceinline__ void conv_prefetch(const Params& p, int item, int tid, ConvPre& r) {
    const int q = item / 48, sl = item % 48;
    const int sstart = q < 64 ? (q >> 1) * 256 : TP + ((q - 64) >> 4) * 2048;
    const int send = sstart + (q < 64 ? 256 : 2048);
    const int t0 = q * 128;
    const bf16_t* xbc = (const bf16_t*)(p.ws + WS_XBC);
    r.v0 = r.v1 = r.v2 = make_uint4(0, 0, 0, 0); r.w = 0.f;
    { const int idx = tid, row = idx >> 3, v = idx & 7; const int t = t0 - 2 + row; if (t >= sstart && t < send) r.v0 = *(const uint4*)(xbc + (size_t)t * 3072 + sl * 64 + v * 8); }
    { const int idx = tid + NT, row = idx >> 3, v = idx & 7; const int t = t0 - 2 + row; if (t >= sstart && t < send) r.v1 = *(const uint4*)(xbc + (size_t)t * 3072 + sl * 64 + v * 8); }
    { const int idx = tid + 2 * NT, row = idx >> 3, v = idx & 7; const int t = t0 - 2 + row; if (idx < 132 * 8 && t >= sstart && t < send) r.v2 = *(const uint4*)(xbc + (size_t)t * 3072 + sl * 64 + v * 8); }
    if (tid < 320) r.w = p.in[11][(tid >> 6) * 3072 + sl * 64 + (tid & 63)];
    else if (tid < 384) r.w = p.in[12][sl * 64 + (tid - 320)];
}

__device__ __forceinline__ void conv_item(const Params& p, int item, int next_item, ConvPre& pre, unsigned char* lds) {
    const int tid = tid_opaque();
    const int q = item / 48, sl = item % 48;
    bf16_t* sIn = (bf16_t*)lds;
    bf16_t* sOut = (bf16_t*)(lds + 132 * 144);
    float* sW = (float*)(lds + 132 * 144 + 128 * 144);
    __syncthreads();
    { const int idx = tid; *(uint4*)(sIn + (idx >> 3) * 72 + (idx & 7) * 8) = pre.v0; }
    { const int idx = tid + NT; *(uint4*)(sIn + (idx >> 3) * 72 + (idx & 7) * 8) = pre.v1; }
    { const int idx = tid + 2 * NT; if (idx < 132 * 8) *(uint4*)(sIn + (idx >> 3) * 72 + (idx & 7) * 8) = pre.v2; }
    if (tid < 384) sW[tid] = pre.w;
    if (next_item >= 0) conv_prefetch(p, next_item, tid, pre);
    __syncthreads();
    {
        const int j = tid >> 2, c0 = (tid & 3) * 16;
        float o[16];
#pragma unroll
        for (int c = 0; c < 16; ++c) o[c] = sW[320 + c0 + c];
#pragma unroll
        for (int k = 0; k < 5; ++k) {
            const uint4 a = *(const uint4*)(sIn + (j + k) * 72 + c0), b = *(const uint4*)(sIn + (j + k) * 72 + c0 + 8);
            const unsigned w[8] = {a.x, a.y, a.z, a.w, b.x, b.y, b.z, b.w};
#pragma unroll
            for (int u = 0; u < 8; ++u) { o[2 * u] += sW[k * 64 + c0 + 2 * u] * __uint_as_float(w[u] << 16); o[2 * u + 1] += sW[k * 64 + c0 + 2 * u + 1] * __uint_as_float(w[u] & 0xffff0000u); }
        }
        unsigned pk[8];
#pragma unroll
        for (int u = 0; u < 8; ++u) pk[u] = pk2(siluf(o[2 * u]), siluf(o[2 * u + 1]));
        *(uint4*)(sOut + j * 72 + c0) = make_uint4(pk[0], pk[1], pk[2], pk[3]);
        *(uint4*)(sOut + j * 72 + c0 + 8) = make_uint4(pk[4], pk[5], pk[6], pk[7]);
    }
    __syncthreads();
    if (sl >= 32) {
        const int s2 = sl - 32, isC = s2 >= 8, g = (s2 & 7) >> 1, nh = s2 & 1;
        bf16_t* dst = (bf16_t*)(p.ws + (isC ? WS_CM : WS_BM)) + (size_t)(q * 4 + g) * 128 * 128 + nh * 64;
#pragma unroll
        for (int i = 0; i < 2; ++i) { const int idx = tid + i * NT, j = idx >> 3, v = idx & 7; *(uint4*)(dst + (size_t)j * 128 + v * 8) = *(const uint4*)(sOut + j * 72 + v * 8); }
    }
    if (sl < 40) {
        bf16_t* dst;
        if (sl < 32) dst = (bf16_t*)(p.ws + WS_XT) + (size_t)(q * 32 + sl) * 64 * 128;
        else { const int s2 = sl - 32; dst = (bf16_t*)(p.ws + WS_BT) + (size_t)(q * 4 + (s2 >> 1)) * 128 * 128 + (size_t)(s2 & 1) * 64 * 128; }
        const int ch = tid >> 3, jv = tid & 7;
#pragma unroll
        for (int i = 0; i < 2; ++i) { const int j0 = jv * 8 + i * 64; unsigned pk[4];
#pragma unroll
            for (int u = 0; u < 4; ++u) pk[u] = (unsigned)sOut[(j0 + 2 * u) * 72 + ch] | ((unsigned)sOut[(j0 + 2 * u + 1) * 72 + ch] << 16);
            *(uint4*)(dst + (size_t)ch * 128 + j0) = make_uint4(pk[0], pk[1], pk[2], pk[3]); }
    }
}

__device__ __forceinline__ void phase_conv_f1(const Params& p, unsigned char* lds) {
    const bf16_t* csc = (const bf16_t*)(p.ws + WS_CSC);
    const bf16_t* uf = (const bf16_t*)((unsigned char*)p.out + DO_UF);
    (void)csc; (void)uf;
    ConvPre pre;
    int item = blockIdx.x;
    if (item < 96 * 48) conv_prefetch(p, item, tid_opaque(), pre);
#pragma unroll 1
    for (; item < 96 * 48; item += gridDim.x) {
        const int nxt = item + (int)gridDim.x;
        conv_item(p, item, nxt < 96 * 48 ? nxt : -1, pre, lds);
    }
}

__device__ __forceinline__ void phase_f1(const Params& p, unsigned char* lds) {
    const bf16_t* csc = (const bf16_t*)(p.ws + WS_CSC);
    const bf16_t* uf = (const bf16_t*)((unsigned char*)p.out + DO_UF);
    bf16_t* z1p = (bf16_t*)(p.ws + WS_Z1P);
    bf16_t* z1s = (bf16_t*)(p.ws + WS_Z1S);
    for (int id = blockIdx.x; id < 768; id += gridDim.x) {
        const int g = id / 192, rem = id % 192, mt = rem / 96, nt = rem % 96;
        f32x16 acc[2][2]; zero_acc<2>(acc);
        gemm_mainloop<2>(acc, csc + (size_t)mt * 256 * 256, 256, uf + (size_t)nt * 128 * 1024 + g * 256, 1024, 256, lds);
        for_each_acc<2>(acc, 0, nt * 128, [&](int chp, int t, float& v) {
            if (t < TP) { const int b = t >> 8, l = t & 255; z1p[((size_t)(b * 4 + g) * 256 + chp) * 512 + mt * 256 + l] = f2bf(v); }
            else { const int ts = t - TP, b = ts >> 11, l = ts & 2047; z1s[((size_t)(b * 4 + g) * 256 + chp) * 4096 + mt * 2048 + l] = f2bf(v); }
        });
    }
}

__device__ __forceinline__ void phase_f2(const Params& p, unsigned char* lds) {
    const bf16_t* a256 = (const bf16_t*)(p.ws + WS_A256);
    const bf16_t* apos = (const bf16_t*)((unsigned char*)p.out + DO_APOS);
    const bf16_t* z1p = (const bf16_t*)(p.ws + WS_Z1P);
    const bf16_t* z1s = (const bf16_t*)(p.ws + WS_Z1S);
    bf16_t* yfm = (bf16_t*)(p.ws + WS_YFM);
    for (int id = blockIdx.x; id < 512; id += gridDim.x) {
        if (id < 256) {
            const int bg = id >> 5, rem = id & 31, mt = rem >> 1, nt = rem & 1;
            f32x16 acc[1][2]; zero_acc<1>(acc);
            gemm_mainloop<1, 128>(acc, apos + (size_t)mt * 128 * 4096, 4096, z1s + (size_t)(bg * 256 + nt * 128) * 4096, 4096, 4096, lds);
            const int b = bg >> 2, g = bg & 3;
            for_each_acc<1>(acc, mt * 128, nt * 128, [&](int lp, int chp, float& v) { yfm[(size_t)(TP + b * 2048 + lp) * 1024 + g * 256 + chp] = f2bf(v); });
        } else {
            const int i2 = id - 256, bg = i2 >> 1, nt = i2 & 1;
            f32x16 acc[2][2]; zero_acc<2>(acc);
            gemm_mainloop<2>(acc, a256, 512, z1p + (size_t)(bg * 256 + nt * 128) * 512, 512, 512, lds);
            const int b = bg >> 2, g = bg & 3;
            for_each_acc<2>(acc, 0, nt * 128, [&](int lp, int chp, float& v) { yfm[(size_t)(b * 256 + lp) * 1024 + g * 256 + chp] = f2bf(v); });
        }
    }
}

__device__ __forceinline__ void ssd_item(const Params& p, int seq, int h, int mode, unsigned char* lds) {
    const int tid = tid_opaque(), lane = tid & 63, wid = tid >> 6;
    const bool samp = seq >= 32;
    const int nc = samp ? 16 : 2;
    const int q0 = samp ? 64 + (seq - 32) * 16 : seq * 2;
    const int g = h >> 3;
    unsigned char* sC = lds;
    unsigned char* sB = lds + 34816;
    unsigned char* sX = lds + 69632;
    unsigned char* sH = lds + 87040;
    unsigned char* sXw = lds + 104448;
    float* sCum = (float*)(lds + 121856);
    float* sDt = sCum + 128;
    const bf16_t* gXT = (const bf16_t*)(p.ws + WS_XT);
    const bf16_t* gCM = (const bf16_t*)(p.ws + WS_CM);
    const bf16_t* gBM = (const bf16_t*)(p.ws + WS_BM);
    const bf16_t* gBT = (const bf16_t*)(p.ws + WS_BT);
    const float* dtb = (const float*)(p.ws + WS_DTB);
    bf16_t* yssd = (mode == 1) ? (bf16_t*)(p.ws + WS_YSB2) - (size_t)TP * 2048 : (bf16_t*)(p.ws + WS_YSSD);
    const float Dh = p.in[15][h];
    const int npass = mode == 2 ? 2 : 1;
    const int wr = wid >> 1, wc = wid & 1;
    const int wp = wid >> 2, wn = wid & 3;
    const int l31o = lane & 31;

#pragma unroll 1
    for (int pass = 0; pass < npass; ++pass) {
        const int dir = mode == 2 ? 1 - pass : mode;
        const bool rmw = (mode == 2 && pass == 1);
        const float Aneg = -__expf(p.in[14][dir * 32 + h]);
        f32x16 hacc;
        if (samp) {
            const float* st = p.in[2 + dir] + (size_t)((seq - 32) * 32 + h) * 8192;
#pragma unroll
            for (int r = 0; r < 16; ++r) hacc[r] = st[(wp * 32 + rowmap(r, lane)) * 128 + wn * 32 + l31o];
        } else {
#pragma unroll
            for (int r = 0; r < 16; ++r) hacc[r] = 0.f;
        }
#pragma unroll 1
        for (int step = 0; step < nc; ++step) {
            int ln = lane; asm volatile("" : "+v"(ln));
            const int l31 = ln & 31, lh = ln >> 5;
            const int c = dir == 0 ? step : nc - 1 - step;
            const int q = q0 + c, t0 = q * 128;
            if (wid == 0) {
                const float d0 = dtb[(size_t)(t0 + 2 * lane) * 64 + dir * 32 + h], d1 = dtb[(size_t)(t0 + 2 * lane + 1) * 64 + dir * 32 + h];
                const float a0 = d0 * Aneg, a1 = d1 * Aneg, s = a0 + a1;
                float sc = s;
#pragma unroll
                for (int o = 1; o < 64; o <<= 1) { const float n = __shfl_up(sc, o); if (lane >= o) sc += n; }
                const float tot = __shfl(sc, 63);
                const float ex = sc - s;
                float c0 = ex + a0, c1 = ex + a0 + a1;
                if (dir == 1) { c0 = tot - c0 + a0; c1 = tot - c1 + a1; }
                sCum[2 * lane] = c0; sCum[2 * lane + 1] = c1; sDt[2 * lane] = d0; sDt[2 * lane + 1] = d1;
            }
            const bf16_t* srcC = gCM + (size_t)(q * 4 + g) * 16384;
            const bf16_t* srcB = gBM + (size_t)(q * 4 + g) * 16384;
            const bf16_t* srcBT = gBT + (size_t)(q * 4 + g) * 16384;
            const bf16_t* srcX = gXT + (size_t)(q * 32 + h) * 8192;
            const int lrow = tid >> 4, lv = tid & 15;
            const int goff = lrow * 128 + lv * 8, soff = lrow * 272 + lv * 16;
#pragma unroll
            for (int i = 0; i < 4; ++i) {
                *(uint4*)(sC + soff + i * 32 * 272) = *(const uint4*)(srcC + goff + i * 32 * 128);
                *(uint4*)(sB + soff + i * 32 * 272) = *(const uint4*)(srcB + goff + i * 32 * 128); }
            const uint4 rbt0 = *(const uint4*)(srcBT + goff), rbt1 = *(const uint4*)(srcBT + goff + 32 * 128);
            const uint4 rbt2 = *(const uint4*)(srcBT + goff + 64 * 128), rbt3 = *(const uint4*)(srcBT + goff + 96 * 128);
            bf16_t* yp = yssd + (size_t)t0 * 2048 + h * 64 + wc * 32 + l31;
            f32x16 yprev;
#pragma unroll
            for (int r = 0; r < 16; ++r) yprev[r] = 0.f;
            if (rmw) {
#pragma unroll
                for (int r = 0; r < 16; ++r) yprev[r] = bf2f(yp[(size_t)(wr * 32 + rowmap(r, ln)) * 2048]);
            }
            const uint4 rx0 = *(const uint4*)(srcX + goff), rx1 = *(const uint4*)(srcX + goff + 32 * 128);
            *(uint4*)(sX + soff) = rx0; *(uint4*)(sX + soff + 32 * 272) = rx1;
#pragma unroll
            for (int r = 0; r < 16; ++r) *(bf16_t*)(sH + (wp * 32 + rowmap(r, ln)) * 272 + (wn * 32 + l31) * 2) = f2bf(hacc[r]);
            __syncthreads();
            const float cend = dir == 0 ? sCum[127] : sCum[0];
            {
                float wj[8];
#pragma unroll
                for (int u = 0; u < 8; ++u) wj[u] = __expf(cend - sCum[lv * 8 + u]) * sDt[lv * 8 + u];
#define XW(w, a, b) pk2(__uint_as_float((w) << 16) * wj[a], __uint_as_float((w) & 0xffff0000u) * wj[b])
                *(uint4*)(sXw + soff) = make_uint4(XW(rx0.x, 0, 1), XW(rx0.y, 2, 3), XW(rx0.z, 4, 5), XW(rx0.w, 6, 7));
                *(uint4*)(sXw + soff + 32 * 272) = make_uint4(XW(rx1.x, 0, 1), XW(rx1.y, 2, 3), XW(rx1.z, 4, 5), XW(rx1.w, 6, 7));
#undef XW
            }
            f32x16 cb0, cb1, yo;
#pragma unroll
            for (int r = 0; r < 16; ++r) { cb0[r] = 0.f; cb1[r] = 0.f; yo[r] = 0.f; }
#pragma unroll 2
            for (int ks = 0; ks < 8; ++ks) {
                const int ko = ks * 32 + lh * 16;
                const bf16x8 a = *(const bf16x8*)(sC + (wr * 32 + l31) * 272 + ko);
                const bf16x8 b0 = *(const bf16x8*)(sB + (wc * 64 + l31) * 272 + ko);
                const bf16x8 b1 = *(const bf16x8*)(sB + (wc * 64 + 32 + l31) * 272 + ko);
                const bf16x8 bh = *(const bf16x8*)(sH + (wc * 32 + l31) * 272 + ko);
                cb0 = __builtin_amdgcn_mfma_f32_32x32x16_bf16(a, b0, cb0, 0, 0, 0);
                cb1 = __builtin_amdgcn_mfma_f32_32x32x16_bf16(a, b1, cb1, 0, 0, 0);
                yo = __builtin_amdgcn_mfma_f32_32x32x16_bf16(a, bh, yo, 0, 0, 0);
            }
            {
                const int j0 = wc * 64 + l31, j1 = j0 + 32;
                const float cj0 = sCum[j0], cj1 = sCum[j1], dj0 = sDt[j0], dj1 = sDt[j1];
#pragma unroll
                for (int r = 0; r < 16; ++r) {
                    const int i = wr * 32 + rowmap(r, ln); const float ci = sCum[i];
                    const bool v0 = dir == 0 ? (j0 <= i) : (j0 >= i), v1 = dir == 0 ? (j1 <= i) : (j1 >= i);
                    float m0 = v0 ? cb0[r] * __expf(ci - cj0) * dj0 : 0.f;
                    float m1 = v1 ? cb1[r] * __expf(ci - cj1) * dj1 : 0.f;
                    if (dir == 0) { if (i == j0) m0 += Dh; if (i == j1) m1 += Dh; }
                    cb0[r] = m0; cb1[r] = m1;
                    yo[r] *= __expf(ci);
                }
            }
            __syncthreads();
            {
                const int j0 = wc * 64 + l31;
#pragma unroll
                for (int r = 0; r < 16; ++r) { const int i = wr * 32 + rowmap(r, ln);
                    *(bf16_t*)(sB + i * 272 + j0 * 2) = f2bf(cb0[r]); *(bf16_t*)(sB + i * 272 + (j0 + 32) * 2) = f2bf(cb1[r]); }
                *(uint4*)(sC + soff) = rbt0; *(uint4*)(sC + soff + 32 * 272) = rbt1; *(uint4*)(sC + soff + 64 * 272) = rbt2; *(uint4*)(sC + soff + 96 * 272) = rbt3;
            }
            __syncthreads();
            const float cdec = __expf(cend);
#pragma unroll
            for (int r = 0; r < 16; ++r) hacc[r] *= cdec;
#pragma unroll 2
            for (int ks = 0; ks < 8; ++ks) {
                const int ko = ks * 32 + lh * 16;
                const bf16x8 am = *(const bf16x8*)(sB + (wr * 32 + l31) * 272 + ko);
                const bf16x8 bx = *(const bf16x8*)(sX + (wc * 32 + l31) * 272 + ko);
                yo = __builtin_amdgcn_mfma_f32_32x32x16_bf16(am, bx, yo, 0, 0, 0);
                const bf16x8 ax = *(const bf16x8*)(sXw + (wp * 32 + l31) * 272 + ko);
                const bf16x8 bb = *(const bf16x8*)(sC + (wn * 32 + l31) * 272 + ko);
                hacc = __builtin_amdgcn_mfma_f32_32x32x16_bf16(ax, bb, hacc, 0, 0, 0);
            }
            {
#pragma unroll
                for (int r = 0; r < 16; ++r) { const int i = wr * 32 + rowmap(r, ln); yp[(size_t)i * 2048] = f2bf(yo[r] + yprev[r]); }
            }
            __syncthreads();
        }
        if (!samp) {
            float* dst = p.out + (size_t)T * 1024 + (size_t)dir * 8388608 + (size_t)(seq * 32 + h) * 8192;
#pragma unroll
            for (int r = 0; r < 16; ++r) dst[(wp * 32 + rowmap(r, lane)) * 128 + wn * 32 + l31o] = hacc[r];
        }
    }
}

template <bool ALPHA, bool BETA>
__device__ __forceinline__ void ssd_cstep(const Params& p, unsigned char* lds, int q, int h, float AnegF, float AnegB, float Dh,
                                          const f32x16& enter, int enterDir, bool scaleB, f32x16& accF, f32x16& accB, float& piF) {
    const int tid = tid_opaque(), lane = tid & 63, wid = tid >> 6;
    const int g = h >> 3, t0 = q * 128;
    unsigned char* sC = lds;
    unsigned char* sB = lds + 34816;
    unsigned char* sX = lds + 69632;
    unsigned char* sH = lds + 87040;
    unsigned char* sXwF = lds + 104448;
    unsigned char* sXwB = lds + 121856;
    float* sCumF = (float*)(lds + 139264);
    float* sCumB = sCumF + 128;
    float* sDtF = sCumF + 256;
    float* sDtB = sCumF + 384;
    const bf16_t* srcC = (const bf16_t*)(p.ws + WS_CM) + (size_t)(q * 4 + g) * 16384;
    const bf16_t* srcB = (const bf16_t*)(p.ws + WS_BM) + (size_t)(q * 4 + g) * 16384;
    const bf16_t* srcBT = (const bf16_t*)(p.ws + WS_BT) + (size_t)(q * 4 + g) * 16384;
    const bf16_t* srcX = (const bf16_t*)(p.ws + WS_XT) + (size_t)(q * 32 + h) * 8192;
    const float* dtb = (const float*)(p.ws + WS_DTB);
    bf16_t* yssd = (bf16_t*)(p.ws + WS_YSSD);
    const int wr = wid >> 1, wc = wid & 1, wp = wid >> 2, wn = wid & 3;
    const int l31 = lane & 31, lh = lane >> 5;
    if (wid == 0) {
        const float f0 = dtb[(size_t)(t0 + 2 * lane) * 64 + h], f1 = dtb[(size_t)(t0 + 2 * lane + 1) * 64 + h];
        const float b0 = dtb[(size_t)(t0 + 2 * lane) * 64 + 32 + h], b1 = dtb[(size_t)(t0 + 2 * lane + 1) * 64 + 32 + h];
        const float af0 = f0 * AnegF, af1 = f1 * AnegF, ab0 = b0 * AnegB, ab1 = b1 * AnegB;
        float sf = af0 + af1, sb = ab0 + ab1;
        const float sf0 = sf, sb0 = sb;
#pragma unroll
        for (int o = 1; o < 64; o <<= 1) { const float nf = __shfl_up(sf, o), nb = __shfl_up(sb, o); if (lane >= o) { sf += nf; sb += nb; } }
        const float totb = __shfl(sb, 63);
        const float exf = sf - sf0, exb = sb - sb0;
        sCumF[2 * lane] = exf + af0; sCumF[2 * lane + 1] = exf + af0 + af1;
        sCumB[2 * lane] = totb - exb; sCumB[2 * lane + 1] = totb - exb - ab0;
        sDtF[2 * lane] = f0; sDtF[2 * lane + 1] = f1; sDtB[2 * lane] = b0; sDtB[2 * lane + 1] = b1;
    }
    const int lrow = tid >> 4, lv = tid & 15;
    const int goff = lrow * 128 + lv * 8, soff = lrow * 272 + lv * 16;
    if (BETA) {
#pragma unroll
        for (int i = 0; i < 4; ++i) {
            *(uint4*)(sC + soff + i * 32 * 272) = *(const uint4*)(srcC + goff + i * 32 * 128);
            *(uint4*)(sB + soff + i * 32 * 272) = *(const uint4*)(srcB + goff + i * 32 * 128); }
    }
    uint4 rbt0 = make_uint4(0, 0, 0, 0), rbt1 = rbt0, rbt2 = rbt0, rbt3 = rbt0;
    if (ALPHA) {
        rbt0 = *(const uint4*)(srcBT + goff); rbt1 = *(const uint4*)(srcBT + goff + 32 * 128);
        rbt2 = *(const uint4*)(srcBT + goff + 64 * 128); rbt3 = *(const uint4*)(srcBT + goff + 96 * 128);
        if (!BETA) { *(uint4*)(sC + soff) = rbt0; *(uint4*)(sC + soff + 32 * 272) = rbt1; *(uint4*)(sC + soff + 64 * 272) = rbt2; *(uint4*)(sC + soff + 96 * 272) = rbt3; }
    }
    const uint4 rx0 = *(const uint4*)(srcX + goff), rx1 = *(const uint4*)(srcX + goff + 32 * 128);
    if (BETA) {
        *(uint4*)(sX + soff) = rx0; *(uint4*)(sX + soff + 32 * 272) = rx1;
#pragma unroll
        for (int r = 0; r < 16; ++r) *(bf16_t*)(sH + (wp * 32 + rowmap(r, lane)) * 272 + (wn * 32 + l31) * 2) = f2bf(enter[r]);
    }
    __syncthreads();
    const float pF = __expf(sCumF[127]), pB = __expf(sCumB[0]);
    if (ALPHA) {
        float wf[8], wb[8];
#pragma unroll
        for (int u = 0; u < 8; ++u) { wf[u] = __expf(sCumF[127] - sCumF[lv * 8 + u]) * sDtF[lv * 8 + u]; wb[u] = __expf(sCumB[0] - sCumB[lv * 8 + u]) * sDtB[lv * 8 + u]; }
#define XWF(w, a, b) pk2(__uint_as_float((w) << 16) * wf[a], __uint_as_float((w) & 0xffff0000u) * wf[b])
#define XWB(w, a, b) pk2(__uint_as_float((w) << 16) * wb[a], __uint_as_float((w) & 0xffff0000u) * wb[b])
        *(uint4*)(sXwF + soff) = make_uint4(XWF(rx0.x, 0, 1), XWF(rx0.y, 2, 3), XWF(rx0.z, 4, 5), XWF(rx0.w, 6, 7));
        *(uint4*)(sXwF + soff + 32 * 272) = make_uint4(XWF(rx1.x, 0, 1), XWF(rx1.y, 2, 3), XWF(rx1.z, 4, 5), XWF(rx1.w, 6, 7));
        *(uint4*)(sXwB + soff) = make_uint4(XWB(rx0.x, 0, 1), XWB(rx0.y, 2, 3), XWB(rx0.z, 4, 5), XWB(rx0.w, 6, 7));
        *(uint4*)(sXwB + soff + 32 * 272) = make_uint4(XWB(rx1.x, 0, 1), XWB(rx1.y, 2, 3), XWB(rx1.z, 4, 5), XWB(rx1.w, 6, 7));
#undef XWF
#undef XWB
    }
    f32x16 yo;
#pragma unroll
    for (int r = 0; r < 16; ++r) yo[r] = 0.f;
    if (BETA) {
        f32x16 cb0, cb1;
#pragma unroll
        for (int r = 0; r < 16; ++r) { cb0[r] = 0.f; cb1[r] = 0.f; }
#pragma unroll 2
        for (int ks = 0; ks < 8; ++ks) {
            const int ko = ks * 32 + lh * 16;
            const bf16x8 a = *(const bf16x8*)(sC + (wr * 32 + l31) * 272 + ko);
            const bf16x8 b0 = *(const bf16x8*)(sB + (wc * 64 + l31) * 272 + ko);
            const bf16x8 b1 = *(const bf16x8*)(sB + (wc * 64 + 32 + l31) * 272 + ko);
            const bf16x8 bh = *(const bf16x8*)(sH + (wc * 32 + l31) * 272 + ko);
            cb0 = __builtin_amdgcn_mfma_f32_32x32x16_bf16(a, b0, cb0, 0, 0, 0);
            cb1 = __builtin_amdgcn_mfma_f32_32x32x16_bf16(a, b1, cb1, 0, 0, 0);
            yo = __builtin_amdgcn_mfma_f32_32x32x16_bf16(a, bh, yo, 0, 0, 0);
        }
        {
            const int j0 = wc * 64 + l31, j1 = j0 + 32;
            const float fj0 = sCumF[j0], fj1 = sCumF[j1], bj0 = sCumB[j0], bj1 = sCumB[j1];
            const float df0 = sDtF[j0], df1 = sDtF[j1], db0 = sDtB[j0], db1 = sDtB[j1];
            const float* sCe = enterDir == 0 ? sCumF : sCumB;
#pragma unroll
            for (int r = 0; r < 16; ++r) {
                const int i = wr * 32 + rowmap(r, lane); const float fi = sCumF[i], bi = sCumB[i];
                const float e0 = j0 <= i ? __expf(fi - fj0) * df0 : 0.f, g0 = j0 >= i ? __expf(bi - bj0) * db0 : 0.f;
                const float e1 = j1 <= i ? __expf(fi - fj1) * df1 : 0.f, g1 = j1 >= i ? __expf(bi - bj1) * db1 : 0.f;
                float m0 = cb0[r] * (e0 + g0), m1 = cb1[r] * (e1 + g1);
                if (i == j0) m0 += Dh;
                if (i == j1) m1 += Dh;
                cb0[r] = m0; cb1[r] = m1;
                yo[r] *= __expf(sCe[i]);
            }
        }
        __syncthreads();
        {
            const int j0 = wc * 64 + l31;
#pragma unroll
            for (int r = 0; r < 16; ++r) { const int i = wr * 32 + rowmap(r, lane);
                *(bf16_t*)(sB + i * 272 + j0 * 2) = f2bf(cb0[r]); *(bf16_t*)(sB + i * 272 + (j0 + 32) * 2) = f2bf(cb1[r]); }
            if (ALPHA) { *(uint4*)(sC + soff) = rbt0; *(uint4*)(sC + soff + 32 * 272) = rbt1; *(uint4*)(sC + soff + 64 * 272) = rbt2; *(uint4*)(sC + soff + 96 * 272) = rbt3; }
        }
    }
    __syncthreads();
    if (ALPHA) {
        if (scaleB) {
#pragma unroll
            for (int r = 0; r < 16; ++r) accB[r] *= pB;
        }
    }
#pragma unroll 2
    for (int ks = 0; ks < 8; ++ks) {
        const int ko = ks * 32 + lh * 16;
        if (BETA) {
            const bf16x8 am = *(const bf16x8*)(sB + (wr * 32 + l31) * 272 + ko);
            const bf16x8 bx = *(const bf16x8*)(sX + (wc * 32 + l31) * 272 + ko);
            yo = __builtin_amdgcn_mfma_f32_32x32x16_bf16(am, bx, yo, 0, 0, 0);
        }
        if (ALPHA) {
            const bf16x8 bb = *(const bf16x8*)(sC + (wn * 32 + l31) * 272 + ko);
            const bf16x8 axf = *(const bf16x8*)(sXwF + (wp * 32 + l31) * 272 + ko);
            const bf16x8 axb = *(const bf16x8*)(sXwB + (wp * 32 + l31) * 272 + ko);
            accF = __builtin_amdgcn_mfma_f32_32x32x16_bf16(axf, bb, accF, 0, 0, 0);
            accB = __builtin_amdgcn_mfma_f32_32x32x16_bf16(axb, bb, accB, 0, 0, 0);
        }
    }
    if (BETA) {
        bf16_t* yp = yssd + (size_t)t0 * 2048 + h * 64 + wc * 32 + l31;
#pragma unroll
        for (int r = 0; r < 16; ++r) { const int i = wr * 32 + rowmap(r, lane); yp[(size_t)i * 2048] = f2bf(yo[r]); }
    }
    piF = pF;
    __syncthreads();
}

__device__ __forceinline__ void ssd_prompt_item(const Params& p, int seq, int h, unsigned char* lds) {
    const int lane = tid_opaque() & 63, wid = tid_opaque() >> 6, wp = wid >> 2, wn = wid & 3, l31 = lane & 31;
    const float AnegF = -__expf(p.in[14][h]), AnegB = -__expf(p.in[14][32 + h]), Dh = p.in[15][h];
    const int q0 = seq * 2;
    f32x16 SF1, SB, SF0, zero;
#pragma unroll
    for (int r = 0; r < 16; ++r) { SF1[r] = 0.f; SB[r] = 0.f; SF0[r] = 0.f; zero[r] = 0.f; }
    float piF1 = 1.f, piF0 = 1.f;
    ssd_cstep<true, false>(p, lds, q0 + 1, h, AnegF, AnegB, Dh, zero, 0, false, SF1, SB, piF1);
    ssd_cstep<true, true>(p, lds, q0, h, AnegF, AnegB, Dh, SB, 1, true, SF0, SB, piF0);
    {
        float* dstF = p.out + (size_t)T * 1024 + (size_t)(seq * 32 + h) * 8192;
        float* dstB = dstF + 8388608;
#pragma unroll
        for (int r = 0; r < 16; ++r) { const int o = (wp * 32 + rowmap(r, lane)) * 128 + wn * 32 + l31; dstF[o] = SF0[r] * piF1 + SF1[r]; dstB[o] = SB[r]; }
    }
    ssd_cstep<false, true>(p, lds, q0 + 1, h, AnegF, AnegB, Dh, SF0, 0, false, SF1, SB, piF0);
}

__device__ __forceinline__ void phase_ssd(const Params& p, unsigned char* lds) {
    const int G = gridDim.x, b = blockIdx.x;
    const bool bal = (G == 256);
    if (!bal || b < 128) {
#pragma unroll 1
        for (int v = b; v < 128; v += G) ssd_item(p, 32 + (v >> 6), v & 31, (v >> 5) & 1, lds);
    }
    const int p0 = bal ? (b < 128 ? 896 + b : (b - 128) * 7) : b, pstep = bal ? 1 : G, pend = bal ? (b < 128 ? 897 + b : (b - 128) * 7 + 7) : 1024;
#pragma unroll 1
    for (int pi = p0; pi < pend; pi += pstep) ssd_prompt_item(p, pi >> 5, pi & 31, lds);
}

__device__ __forceinline__ void phase_combine(const Params& p) {
    const int lane = tid_opaque() & 63, wid = tid_opaque() >> 6;
    bf16_t* yssd = (bf16_t*)(p.ws + WS_YSSD);
    const bf16_t* zs = (const bf16_t*)(p.ws + WS_ZS);
    const bf16_t* ysb2 = (const bf16_t*)(p.ws + WS_YSB2);
    const float* g = p.in[16];
    for (int t = blockIdx.x * 8 + wid; t < T; t += gridDim.x * 8) {
        float y[32]; float ss = 0.f;
#pragma unroll
        for (int i = 0; i < 4; ++i) { const int c = i * 512 + lane * 8;
            const uint4 a = *(const uint4*)(yssd + (size_t)t * 2048 + c), b = *(const uint4*)(zs + (size_t)t * 2048 + c);
            uint4 a2 = make_uint4(0u, 0u, 0u, 0u);
            if (t >= TP) a2 = *(const uint4*)(ysb2 + (size_t)(t - TP) * 2048 + c);
            const unsigned aw[4] = {a.x, a.y, a.z, a.w}, bw[4] = {b.x, b.y, b.z, b.w}, cw[4] = {a2.x, a2.y, a2.z, a2.w};
#pragma unroll
            for (int u = 0; u < 4; ++u) { const float y0 = (__uint_as_float(aw[u] << 16) + __uint_as_float(cw[u] << 16)) * siluf(__uint_as_float(bw[u] << 16)), y1 = (__uint_as_float(aw[u] & 0xffff0000u) + __uint_as_float(cw[u] & 0xffff0000u)) * siluf(__uint_as_float(bw[u] & 0xffff0000u));
                y[i * 8 + 2 * u] = y0; y[i * 8 + 2 * u + 1] = y1; ss += y0 * y0 + y1 * y1; } }
#pragma unroll
        for (int o = 32; o > 0; o >>= 1) ss += __shfl_xor(ss, o);
        const float rstd = rsqrtf(ss * (1.f / 2048.f) + 1e-6f);
#pragma unroll
        for (int i = 0; i < 4; ++i) { const int c = i * 512 + lane * 8; const float4 g0 = *(const float4*)(g + c), g1 = *(const float4*)(g + c + 4);
            *(uint4*)(yssd + (size_t)t * 2048 + c) = make_uint4(pk2(y[i * 8] * rstd * g0.x, y[i * 8 + 1] * rstd * g0.y), pk2(y[i * 8 + 2] * rstd * g0.z, y[i * 8 + 3] * rstd * g0.w),
                                                                pk2(y[i * 8 + 4] * rstd * g1.x, y[i * 8 + 5] * rstd * g1.y), pk2(y[i * 8 + 6] * rstd * g1.z, y[i * 8 + 7] * rstd * g1.w)); }
    }
}

struct EpiMerge {
    static constexpr bool PERM = true, AFTER_DRAIN = false;
    bf16_t* m; const bf16_t* gates; int second;
    __device__ __forceinline__ void operator()(const pg8::f32x4 (&acc)[2][2][4][2], const pg8::Unit& u, int wr, int wc, int fr, int fq) const {
#pragma unroll
        for (int ai = 0; ai < 2; ++ai)
#pragma unroll
            for (int mm = 0; mm < 4; ++mm) {
                const int row = u.pm * 256 + ai * 128 + wr * 64 + mm * 16 + fr;
#pragma unroll
                for (int bj = 0; bj < 2; ++bj) {
                    const int col = u.pn * 256 + bj * 128 + wc * 32 + 8 * fq;
                    const pg8::f32x4 v0 = acc[ai][bj][mm][0], v1 = acc[ai][bj][mm][1];
                    const uint4 gq = *(const uint4*)(gates + (size_t)row * 2048 + (second ? 1024 : 0) + col);
                    const float4 g0 = bf4_to_f4(make_uint2(gq.x, gq.y)), g1 = bf4_to_f4(make_uint2(gq.z, gq.w));
                    uint4* d = (uint4*)(m + (size_t)row * 1024 + col);
                    float4 o0 = make_float4(0.f, 0.f, 0.f, 0.f), o1 = o0;
                    if (second) { const uint4 oq = *d; o0 = bf4_to_f4(make_uint2(oq.x, oq.y)); o1 = bf4_to_f4(make_uint2(oq.z, oq.w)); }
                    *d = make_uint4(pk2(o0.x + v0[0] * g0.x, o0.y + v0[1] * g0.y), pk2(o0.z + v0[2] * g0.z, o0.w + v0[3] * g0.w),
                                    pk2(o1.x + v1[0] * g1.x, o1.y + v1[1] * g1.y), pk2(o1.z + v1[2] * g1.z, o1.w + v1[3] * g1.w));
                }
            }
    }
};

struct EpiResid {
    static constexpr bool PERM = false, AFTER_DRAIN = false;
    float* out; const float* xp; const float* xs; const float* mod; int gate_off; int inplace;
    __device__ __forceinline__ void operator()(const pg8::f32x4 (&acc)[2][2][4][2], const pg8::Unit& u, int wr, int wc, int fr, int fq) const {
#pragma unroll
        for (int ai = 0; ai < 2; ++ai)
#pragma unroll
            for (int mm = 0; mm < 4; ++mm) {
                const int row = u.pm * 256 + ai * 128 + wr * 64 + mm * 16 + fr;
                const float* gp = mod + modidx(row) * 6144 + gate_off;
                float* orow = out + (size_t)row * 1024;
                const float* brow = inplace ? orow : (row < TP ? xp + (size_t)row * 1024 : xs + (size_t)(row - TP) * 1024);
#pragma unroll
                for (int bj = 0; bj < 2; ++bj)
#pragma unroll
                    for (int n = 0; n < 2; ++n) {
                        const int col = u.pn * 256 + bj * 128 + wc * 32 + 16 * n + 4 * fq;
                        const pg8::f32x4 v = acc[ai][bj][mm][n];
                        const float4 x = *(const float4*)(brow + col), g = *(const float4*)(gp + col);
                        *(float4*)(orow + col) = make_float4(x.x + g.x * v[0], x.y + g.y * v[1], x.z + g.z * v[2], x.w + g.w * v[3]);
                    }
            }
    }
};

__device__ __forceinline__ void phase_merge(const Params& p, unsigned char* lds) {
    const bf16_t* gates = (const bf16_t*)((unsigned char*)p.out + DO_GATES);
    bf16_t* m = (bf16_t*)(p.ws + WS_M);
    pg8::StaticOrder S; S.init(T, 1024, (int)gridDim.x, (int)blockIdx.x);
    if (gridDim.x == 256 && blockIdx.x >= 192) {
#pragma unroll 1
        for (int tI = 2832 + ((int)blockIdx.x - 192); tI < 5136; tI += 64) transpose_tile(p, tI, lds);
        return;
    }
    {
        pg8::Gemm g{(const bf16_t*)(p.ws + WS_YFM), (const bf16_t*)(p.ws + WS_WF), T, 1024, 1024};
        EpiMerge E{m, gates, 0};
        pg8::gemm_phase<EpiMerge, pg8::StaticOrder, false>((PG8_LAS unsigned char*)lds, g, S, E, nullptr);
    }
    {
        pg8::Gemm g{(const bf16_t*)(p.ws + WS_YSSD), (const bf16_t*)(p.ws + WS_WSO), T, 1024, 2048};
        EpiMerge E{m, gates, 1};
        pg8::gemm_phase<EpiMerge, pg8::StaticOrder, false>((PG8_LAS unsigned char*)lds, g, S, E, nullptr);
    }
}

__device__ __forceinline__ void phase_out(const Params& p, unsigned char* lds) {
    pg8::Gemm g{(const bf16_t*)(p.ws + WS_M), (const bf16_t*)(p.ws + WS_WO), T, 1024, 1024};
    pg8::StaticOrder S; S.init(T, 1024, (int)gridDim.x, (int)blockIdx.x);
    EpiResid E{p.out, p.in[0], p.in[1], (const float*)(p.ws + WS_MOD), 2048, 0};
    pg8::gemm_phase<EpiResid, pg8::StaticOrder, false>((PG8_LAS unsigned char*)lds, g, S, E, nullptr);
}

struct EpiFF1 {
    static constexpr bool PERM = true, AFTER_DRAIN = false;
    bf16_t* f;
    __device__ __forceinline__ void operator()(const pg8::f32x4 (&acc)[2][2][4][2], const pg8::Unit& u, int wr, int wc, int fr, int fq) const {
#pragma unroll
        for (int ai = 0; ai < 2; ++ai)
#pragma unroll
            for (int m = 0; m < 4; ++m) {
                bf16_t* rowp = f + (size_t)(u.pm * 256 + ai * 128 + wr * 64 + m * 16 + fr) * 4096 + u.pn * 256 + wc * 32 + 8 * fq;
#pragma unroll
                for (int bj = 0; bj < 2; ++bj) {
                    const pg8::f32x4 v0 = acc[ai][bj][m][0], v1 = acc[ai][bj][m][1];
                    const float r0 = fmaxf(v0[0], 0.f), r1 = fmaxf(v0[1], 0.f), r2 = fmaxf(v0[2], 0.f), r3 = fmaxf(v0[3], 0.f);
                    const float r4 = fmaxf(v1[0], 0.f), r5 = fmaxf(v1[1], 0.f), r6 = fmaxf(v1[2], 0.f), r7 = fmaxf(v1[3], 0.f);
                    *(uint4*)(rowp + bj * 128) = make_uint4(pk2(r0 * r0, r1 * r1), pk2(r2 * r2, r3 * r3), pk2(r4 * r4, r5 * r5), pk2(r6 * r6, r7 * r7));
                }
            }
    }
};

__device__ __forceinline__ void phase_ff1(const Params& p, unsigned char* lds) {
    pg8::Gemm g{(const bf16_t*)(p.ws + WS_H2), (const bf16_t*)(p.ws + WS_W1), T, 4096, 1024};
    pg8::StaticOrder S; S.init(T, 4096, (int)gridDim.x, (int)blockIdx.x);
    EpiFF1 E{(bf16_t*)(p.ws + WS_F)};
    pg8::gemm_phase<EpiFF1, pg8::StaticOrder, false>((PG8_LAS unsigned char*)lds, g, S, E, nullptr);
}

__device__ __forceinline__ void phase_ff2(const Params& p, unsigned char* lds) {
    pg8::Gemm g{(const bf16_t*)(p.ws + WS_F), (const bf16_t*)(p.ws + WS_W2), T, 1024, 4096};
    pg8::StaticOrder S; S.init(T, 1024, (int)gridDim.x, (int)blockIdx.x);
    EpiResid E{p.out, p.in[0], p.in[1], (const float*)(p.ws + WS_MOD), 5120, 1};
    pg8::gemm_phase<EpiResid, pg8::StaticOrder, false>((PG8_LAS unsigned char*)lds, g, S, E, nullptr);
}

__global__ void __launch_bounds__(NT) fwd_megakernel(Params p) {
    extern __shared__ __attribute__((aligned(16))) unsigned char lds[];
    cg::grid_group grid = cg::this_grid();
    if (__builtin_amdgcn_workitem_id_x() == 0) *(uint4*)(lds + LDS_ST) = make_uint4(0u, 0u, 0u, 0u);
    __syncthreads();
    XcdBarrier xb = xcd_barrier_post((unsigned*)(p.ws + WS_BAR), (volatile LAS unsigned*)(lds + LDS_ST));
#define RUN(k, call) if (PH_ON(k) && p.ph_lo <= (k) && (k) < p.ph_hi) { call; } if ((k) == REPEAT_PH) { call; } if (p.ph_lo <= (k) && (k) + 1 < p.ph_hi) { if ((k) == 0) grid.sync(); else xcd_barrier(xb); }
    RUN(0, phase_prep(p, lds))
    RUN(1, phase_norm(p, 0))
    RUN(2, phase_inproj(p, lds))
    RUN(3, phase_conv_f1(p, lds))
    RUN(4, phase_f1(p, lds))
    RUN(5, phase_f2(p, lds))
    RUN(6, phase_ssd(p, lds))
    RUN(7, phase_combine(p))
    RUN(8, phase_merge(p, lds))
    RUN(9, phase_out(p, lds))
    RUN(10, phase_norm(p, 1))
    RUN(11, phase_ff1(p, lds))
    RUN(12, phase_ff2(p, lds))
    if (PH_ON(13) && p.ph_lo <= 13 && 13 < p.ph_hi) phase_norm(p, 2);
}

extern "C" void kernel_launch(void* const* d_in, const int* in_sizes, int n_in, void* d_out, int out_size, void* d_ws, size_t ws_size, hipStream_t stream) {
    static int grid_blocks = 0;
    if (grid_blocks == 0) {
        if (n_in != 23 || ws_size < WS_END || out_size != T * 1024 + 2 * 8388608) { fprintf(stderr, "kernel_launch: unexpected shapes (n_in %d, ws %zu, out %d)\n", n_in, ws_size, out_size); grid_blocks = -1; return; }
        int dev = 0, cus = 0, per_cu = 0;
        (void)hipGetDevice(&dev);
        (void)hipDeviceGetAttribute(&cus, hipDeviceAttributeMultiprocessorCount, dev);
        if (hipFuncSetAttribute((const void*)fwd_megakernel, hipFuncAttributeMaxDynamicSharedMemorySize, LDS_BYTES) != hipSuccess) { fprintf(stderr, "kernel_launch: hipFuncSetAttribute failed\n"); grid_blocks = -1; return; }
        if (hipOccupancyMaxActiveBlocksPerMultiprocessor(&per_cu, (const void*)fwd_megakernel, NT, LDS_BYTES) != hipSuccess || per_cu < 1) { fprintf(stderr, "kernel_launch: occupancy query failed (%d)\n", per_cu); grid_blocks = -1; return; }
        grid_blocks = cus * per_cu;
    }
    if (grid_blocks < 0) return;
    Params p{};
    for (int i = 0; i < 23; ++i) p.in[i] = (const float*)d_in[i];
    p.out = (float*)d_out; p.ws = (unsigned char*)d_ws;
    if (hipMemsetAsync((unsigned char*)d_ws + WS_BAR, 0, XCD_BAR_WORDS * 4, stream) != hipSuccess) { fprintf(stderr, "kernel_launch: memset failed\n"); return; }
#if ONE_LAUNCH
    p.ph_lo = 0; p.ph_hi = NPH + 1;
    void* args[] = {&p};
    hipError_t e = hipLaunchCooperativeKernel((const void*)fwd_megakernel, dim3(grid_blocks), dim3(NT), args, LDS_BYTES, stream);
    if (e != hipSuccess) fprintf(stderr, "cooperative launch failed: %s (grid %d)\n", hipGetErrorString(e), grid_blocks);
#else
    for (int ph = 0; ph <= NPH; ++ph) {
        p.ph_lo = ph; p.ph_hi = ph + 1;
        hipLaunchKernelGGL(fwd_megakernel, dim3(grid_blocks), dim3(NT), LDS_BYTES, stream, p);
    }
#endif
}
```

```cpp
#include <hip/hip_runtime.h>
#include <hip/hip_cooperative_groups.h>
#include <cstdio>
#include <cstdint>
namespace cg = cooperative_groups;

#ifndef PHMASK
#define PHMASK 0xFFFF
#endif
#define PH_ON(n) ((PHMASK >> (n)) & 1)
#ifndef REPEAT_PH
#define REPEAT_PH -1
#endif
#ifndef ONE_LAUNCH
#define ONE_LAUNCH 1
#endif

typedef unsigned short bf16_t;
typedef short bf16x8 __attribute__((ext_vector_type(8)));
typedef float f32x16 __attribute__((ext_vector_type(16)));

#define NT 512
constexpr int T = 12288, TP = 8192;
constexpr int NPH = 13;
constexpr size_t MiB = 1048576;
constexpr size_t WS_WF = 0, WS_WSO = 2 * MiB, WS_WO = 6 * MiB, WS_W1 = 8 * MiB, WS_W2 = 16 * MiB;
constexpr size_t WS_CSC = 24 * MiB, WS_A256 = 24 * MiB + 262144, WS_MOD = 24 * MiB + 524288, WS_DTB = 25 * MiB;
constexpr size_t WS_WIN = 28 * MiB;
constexpr size_t WS_YSB2 = 28 * MiB;
constexpr size_t WS_ZS = 45 * MiB;
constexpr size_t WS_XBC = 93 * MiB;
constexpr size_t WS_Z1P = 93 * MiB;
constexpr size_t WS_Z1S = 125 * MiB;
constexpr size_t WS_YFM = 141 * MiB;
constexpr size_t WS_YSSD = 93 * MiB;
constexpr size_t WS_XT = 165 * MiB;
constexpr size_t WS_CM = 213 * MiB, WS_BM = 225 * MiB, WS_BT = 237 * MiB;
constexpr size_t WS_M = 165 * MiB;
constexpr size_t WS_H2 = 189 * MiB;
constexpr size_t WS_F = 45 * MiB;
constexpr size_t WS_BAR = 249 * MiB;
constexpr size_t WS_END = 250 * MiB;
constexpr size_t DO_GATES = 0, DO_H1 = 48 * MiB, DO_UF = 72 * MiB, DO_APOS = 96 * MiB;
constexpr int LDS_ST = 147456;
constexpr int LDS_BYTES = 147472;

struct Params {
    const float* in[23];
    float* out;
    unsigned char* ws;
    int ph_lo, ph_hi;
};

__device__ __forceinline__ int tid_opaque() { int t = (int)__builtin_amdgcn_workitem_id_x(); asm volatile("" : "+v"(t)); return t; }
typedef __bf16 bf16x2v __attribute__((ext_vector_type(2)));
typedef float f32x2v __attribute__((ext_vector_type(2)));
__device__ __forceinline__ unsigned pk2(float lo, float hi) { f32x2v v = {lo, hi}; bf16x2v b = __builtin_convertvector(v, bf16x2v); return __builtin_bit_cast(unsigned, b); }
__device__ __forceinline__ bf16_t f2bf(float f) { return (bf16_t)(pk2(f, f) & 0xffffu); }
__device__ __forceinline__ float bf2f(bf16_t h) { return __uint_as_float(((unsigned)h) << 16); }
__device__ __forceinline__ float sigmf(float v) { return __builtin_amdgcn_rcpf(1.f + __expf(-v)); }
__device__ __forceinline__ float siluf(float v) { return v * sigmf(v); }
__device__ __forceinline__ int rowmap(int reg, int lane) { return (reg & 3) + 8 * (reg >> 2) + 4 * (lane >> 5); }


#define XB_TMO      128
#define XB_XCNT(j)  (256  + 64 * (j))
#define XB_XSUB(j)  (1280 + 64 * (j))
#define XB_XGEN(j)  (2304 + 64 * (j))
#define XB_TOP      3328
#define XB_TOPGEN   3392
#define XCD_BAR_WORDS 3456
#define XB_SPIN_CAP (1u << 18)
#define LAS __attribute__((address_space(3)))
__device__ __forceinline__ unsigned xb_ld(unsigned* p)              { return __hip_atomic_load(p, __ATOMIC_RELAXED, __HIP_MEMORY_SCOPE_AGENT); }
__device__ __forceinline__ unsigned xb_add(unsigned* p, unsigned v) { return __hip_atomic_fetch_add(p, v, __ATOMIC_RELAXED, __HIP_MEMORY_SCOPE_AGENT); }
__device__ __forceinline__ unsigned xb_xcc_id() { return (unsigned)__builtin_amdgcn_s_getreg((3 << 11) | 20) & 0xFu; }
#define XB_SPIN(cond, bar) do { unsigned _sp = 0; while (cond) { __builtin_amdgcn_s_sleep(1); \
    if ((++_sp & 255u) == 0u) { if (xb_ld(&(bar)[XB_TMO])) break; if (_sp > XB_SPIN_CAP) { atomicAdd(&(bar)[XB_TMO], 1u); break; } } } } while (0)
struct XcdBarrier { unsigned* bar; unsigned x; volatile LAS unsigned* st; };
__device__ __forceinline__ XcdBarrier xcd_barrier_post(unsigned* bar, volatile LAS unsigned* st) {
    XcdBarrier b; b.bar = bar; b.x = xb_xcc_id(); b.st = st;
    if (__builtin_amdgcn_workitem_id_x() == 0) (void)xb_add(&bar[XB_XCNT(b.x)], 1u);
    return b;
}
__device__ __forceinline__ void xcd_barrier_complete(unsigned* bar, unsigned x, unsigned& nloc, unsigned& nx) {
    const unsigned G = gridDim.x * gridDim.y * gridDim.z;
    unsigned sum, cnt, mine, sp = 0u;
    for (;;) {
        sum = 0u; cnt = 0u; mine = 0u;
#pragma unroll
        for (unsigned j = 0; j < 16; ++j) { const unsigned c = xb_ld(&bar[XB_XCNT(j)]); sum += c; cnt += (c > 0u) ? 1u : 0u; mine = (j == x) ? c : mine; }
        if (sum == G) break;
        __builtin_amdgcn_s_sleep(1);
        if ((++sp & 255u) == 0u) { if (xb_ld(&bar[XB_TMO])) break; if (sp > XB_SPIN_CAP) { atomicAdd(&bar[XB_TMO], 1u); break; } }
    }
    nloc = mine > 0u ? mine : 1u; nx = cnt > 0u ? cnt : 1u;
}
__device__ __forceinline__ void xcd_barrier(const XcdBarrier& b) {
    asm volatile("s_waitcnt vmcnt(0)" ::: "memory");
    __syncthreads();
    if (__builtin_amdgcn_workitem_id_x() == 0) {
        unsigned* bar = b.bar;
        __builtin_amdgcn_s_waitcnt(0);
        unsigned nloc = b.st[0], nx = b.st[1];
        if (nloc == 0u) { xcd_barrier_complete(bar, b.x, nloc, nx); b.st[0] = nloc; b.st[1] = nx; }
        const unsigned old = xb_add(&bar[XB_XSUB(b.x)], 1u);
        const unsigned gen = old / nloc;
        if (old + 1u == (gen + 1u) * nloc) {
            __builtin_amdgcn_fence(__ATOMIC_RELEASE, "agent");
            asm volatile("s_waitcnt vmcnt(0)" ::: "memory");
            const unsigned og = xb_add(&bar[XB_TOP], 1u);
            const unsigned tg = og / nx;
            if (og + 1u == (tg + 1u) * nx) xb_add(&bar[XB_TOPGEN], 1u);
            else XB_SPIN(xb_ld(&bar[XB_TOPGEN]) == tg, bar);
            __builtin_amdgcn_fence(__ATOMIC_ACQUIRE, "agent");
            xb_add(&bar[XB_XGEN(b.x)], 1u);
            asm volatile("s_waitcnt vmcnt(0)" ::: "memory");
        } else {
            XB_SPIN(xb_ld(&bar[XB_XGEN(b.x)]) == gen, bar);
            __builtin_amdgcn_fence(__ATOMIC_ACQUIRE, "agent");
            asm volatile("s_waitcnt vmcnt(0)" ::: "memory");
        }
    }
    __syncthreads();
}

namespace pg8 {
#define PG8_LAS __attribute__((address_space(3)))
typedef unsigned short bf16_t;
typedef short bf16x8 __attribute__((ext_vector_type(8)));
typedef float f32x4 __attribute__((ext_vector_type(4)));
typedef unsigned u32x4 __attribute__((ext_vector_type(4)));
constexpr int BM = 256, BK = 64, HALF = 128, HTB = HALF * BK * 2  , STAGE_BYTES = 8 * HTB, NXCD = 8, WGM = 8;

__host__ __device__ __forceinline__ int lds_byte(int r, int c) { const int st = (r >> 4) * 2 + (c >> 5), rr = r & 15, cc = c & 31, ob = rr * 64 + cc * 2; return st * 1024 + (ob ^ (((ob >> 9) & 1) << 5)); }
__host__ __device__ __forceinline__ void stage_rc(int b, int& R, int& C) { const int st = b / 1024, sb = b % 1024, swz = sb ^ (((sb >> 9) & 1) << 5); R = (st >> 1) * 16 + swz / 64; C = (st & 1) * 32 + (swz % 64) / 2; }
__host__ __device__ __forceinline__ int perm32(int rho) { const int n = rho >> 4, i = rho & 15; return 8 * (i >> 2) + 4 * n + (i & 3); }

struct Unit { int pm, pn; };
struct Gemm { const bf16_t* A; const bf16_t* Bt; int M, N, K; };

struct StaticOrder {
    int nM, nN, nwg, G, c;
    __host__ __device__ void init(int M, int N, int G_, int c_) { nM = M / BM; nN = N / BM; nwg = nM * nN; G = G_; c = c_; }
    __host__ __device__ bool next(int i, Unit& u) const {
        const long L = (long)i * G + c; if (L >= nwg) return false;
        int wgid = (int)L; { const int q = nwg / NXCD, r = nwg % NXCD, xcd = wgid % NXCD, off = wgid / NXCD; wgid = (xcd < r ? xcd * (q + 1) : r * (q + 1) + (xcd - r) * q) + off; }
        const int nig = WGM * nN, gid = wgid / nig, fm = gid * WGM, gsz = (nM - fm) < WGM ? (nM - fm) : WGM;
        u.pm = fm + ((wgid % nig) % gsz); u.pn = (wgid % nig) / gsz; return true;
    }
    __device__ __forceinline__ void a_ready(const Unit&) const {}
    __device__ __forceinline__ void done(const Unit&) const {}
};
template <class Epi, class Sched, bool STAMP = false>
__device__ __forceinline__ void gemm_phase(PG8_LAS unsigned char* lds, const Gemm g, const Sched& S, const Epi& E, unsigned long long* stamps) {
    const int tid = threadIdx.x, wid = __builtin_amdgcn_readfirstlane(tid >> 6), lane = tid & 63, wr = wid >> 2, wc = wid & 3, fr = lane & 15, fq = lane >> 4;
    const int K = g.K, nt = K / BK;
    int ts_lo = 0, ts_hi = 0, nts = 0; const unsigned long long rt_entry = STAMP ? (unsigned long long)wall_clock64() : 0ull;
#define PG8_STAMP() do { if (STAMP && wid == 0 && nts < 64) { const unsigned long long _c = (unsigned long long)clock64(); \
        ts_lo = (lane == nts) ? (int)(unsigned)_c : ts_lo; ts_hi = (lane == nts) ? (int)(unsigned)(_c >> 32) : ts_hi; ++nts; } } while (0)
    PG8_STAMP();
    unsigned voffA[2], voffB[2];
#pragma unroll
    for (int i = 0; i < 2; ++i) { int R, C; stage_rc(tid * 16 + i * 8192, R, C); const int Rb = Epi::PERM ? ((R & ~31) + perm32(R & 31)) : R;
        voffA[i] = (unsigned)(R * K + C) * 2u; voffB[i] = (unsigned)(Rb * K + C) * 2u; }
    const size_t kstep = (size_t)(BK * 2);
    const size_t hstep = (size_t)HALF * K * 2;
    const size_t tstep = 2 * hstep;
    const unsigned ldsw = (unsigned)wid * 1024u;
    const int aoff = lds_byte(wr * 64 + fr, fq * 8), boff = lds_byte(wc * 32 + fr, fq * 8);
#define PG8_SA(b, h) (((b) * 2 + (h)) * HTB)
#define PG8_SB(b, h) ((4 + (b) * 2 + (h)) * HTB)
#define PG8_STAGE(bufoff, gbase, voff) do { _Pragma("unroll") for (int _i = 0; _i < 2; ++_i) \
        __builtin_amdgcn_global_load_lds((const unsigned*)((const char*)(gbase) + (voff)[_i]), (PG8_LAS unsigned*)(lds + (bufoff) + ldsw + _i * 8192), 16, 0, 0); } while (0)
#define PG8_LDA(dst, b, h) do { _Pragma("unroll") for (int m = 0; m < 4; ++m) _Pragma("unroll") for (int k = 0; k < 2; ++k) dst[m][k] = *(const PG8_LAS bf16x8*)(lds + PG8_SA(b, h) + aoff + m * 2048 + k * 1024); } while (0)
#define PG8_LDB(dst, b, h) do { _Pragma("unroll") for (int n = 0; n < 2; ++n) _Pragma("unroll") for (int k = 0; k < 2; ++k) dst[n][k] = *(const PG8_LAS bf16x8*)(lds + PG8_SB(b, h) + boff + n * 2048 + k * 1024); } while (0)
#define PG8_MMA(ai, bj, At, Bt) do { __builtin_amdgcn_s_setprio(1); _Pragma("unroll") for (int m = 0; m < 4; ++m) _Pragma("unroll") for (int n = 0; n < 2; ++n) _Pragma("unroll") for (int k = 0; k < 2; ++k) \
        acc[ai][bj][m][n] = __builtin_amdgcn_mfma_f32_16x16x32_bf16(Bt[n][k], At[m][k], acc[ai][bj][m][n], 0, 0, 0); __builtin_amdgcn_s_setprio(0); } while (0)
#define PG8_WAIT_V(n) asm volatile("s_waitcnt vmcnt(" #n ")" ::: "memory")
#define PG8_WAIT_L(n) asm volatile("s_waitcnt lgkmcnt(" #n ")" ::: "memory")
#define PG8_BAR __builtin_amdgcn_s_barrier()
#define PG8_SCHED __builtin_amdgcn_sched_barrier(0)
    Unit cur, nxt; int ui = 0;
    if (!S.next(0, cur)) return;
    f32x4 acc[2][2][4][2];
#pragma unroll
    for (int a = 0; a < 2; ++a)
#pragma unroll
        for (int b = 0; b < 2; ++b)
#pragma unroll
            for (int m = 0; m < 4; ++m)
#pragma unroll
                for (int n = 0; n < 2; ++n) acc[a][b][m][n] = (f32x4){0.f, 0.f, 0.f, 0.f};
    bf16x8 At[4][2], B0[2][2], B1[2][2];
    const char* cA = (const char*)g.A + (size_t)cur.pm * tstep; const char* cB = (const char*)g.Bt + (size_t)cur.pn * tstep;
    S.a_ready(cur);
    PG8_STAGE(PG8_SB(0, 0), cB, voffB); PG8_STAGE(PG8_SA(0, 0), cA, voffA); PG8_STAGE(PG8_SB(0, 1), cB + hstep, voffB); PG8_STAGE(PG8_SA(0, 1), cA + hstep, voffA);
    if (wr == 1) PG8_BAR;
    PG8_WAIT_V(4); PG8_BAR;
    PG8_STAGE(PG8_SB(1, 0), cB + kstep, voffB); PG8_STAGE(PG8_SA(1, 0), cA + kstep, voffA); PG8_STAGE(PG8_SB(1, 1), cB + hstep + kstep, voffB);
    PG8_WAIT_V(6); PG8_BAR;
    PG8_STAMP();
    for (;;) {
        const bool has_next = S.next(ui + 1, nxt);
        const char* nA = has_next ? (const char*)g.A + (size_t)nxt.pm * tstep : cA; const char* nB = has_next ? (const char*)g.Bt + (size_t)nxt.pn * tstep : cB;
        for (int t = 0; t < nt; t += 2) {
            const bool last = (t == nt - 2);
            const char* a1 = cA + (size_t)(t + 1) * kstep;
            const char* a2 = last ? nA : cA + (size_t)(t + 2) * kstep; const char* b2 = last ? nB : cB + (size_t)(t + 2) * kstep;
            const char* a3 = a2 + kstep; const char* b3 = b2 + kstep;
            if (last && has_next) S.a_ready(nxt);
            PG8_LDB(B0, 0, 0); PG8_SCHED; PG8_LDA(At, 0, 0); PG8_STAGE(PG8_SA(1, 1), a1 + hstep, voffA);
            PG8_WAIT_L(8); PG8_BAR; PG8_WAIT_L(0); PG8_MMA(0, 0, At, B0); PG8_BAR; PG8_SCHED;
            PG8_LDB(B1, 0, 1); PG8_STAGE(PG8_SB(0, 0), b2, voffB);
            PG8_BAR; PG8_WAIT_L(0); PG8_MMA(0, 1, At, B1); PG8_BAR;
            PG8_LDA(At, 0, 1); PG8_STAGE(PG8_SA(0, 0), a2, voffA);
            PG8_BAR; PG8_WAIT_L(0); PG8_MMA(1, 0, At, B0); PG8_BAR; PG8_SCHED;
            PG8_STAGE(PG8_SB(0, 1), b2 + hstep, voffB);
            PG8_WAIT_V(6); PG8_BAR; PG8_MMA(1, 1, At, B1); PG8_BAR;
            PG8_LDB(B0, 1, 0); PG8_SCHED; PG8_LDA(At, 1, 0); PG8_STAGE(PG8_SA(0, 1), a2 + hstep, voffA);
            PG8_WAIT_L(8); PG8_BAR; PG8_WAIT_L(0); PG8_MMA(0, 0, At, B0); PG8_BAR; PG8_SCHED;
            PG8_LDB(B1, 1, 1); PG8_STAGE(PG8_SB(1, 0), b3, voffB);
            PG8_BAR; PG8_WAIT_L(0); PG8_MMA(0, 1, At, B1); PG8_BAR;
            PG8_LDA(At, 1, 1); PG8_STAGE(PG8_SA(1, 0), a3, voffA);
            PG8_BAR; PG8_WAIT_L(0); PG8_MMA(1, 0, At, B0); PG8_BAR; PG8_SCHED;
            PG8_STAGE(PG8_SB(1, 1), b3 + hstep, voffB);
            PG8_WAIT_V(6); PG8_BAR; PG8_MMA(1, 1, At, B1); PG8_BAR;
        }
        PG8_STAMP();
        if constexpr (!Epi::AFTER_DRAIN) { E(acc, cur, wr, wc, fr, fq); S.done(cur); }
        PG8_STAMP();
        if (!has_next) break;
#pragma unroll
        for (int a = 0; a < 2; ++a)
#pragma unroll
            for (int b = 0; b < 2; ++b)
#pragma unroll
                for (int m = 0; m < 4; ++m)
#pragma unroll
                    for (int n = 0; n < 2; ++n) acc[a][b][m][n] = (f32x4){0.f, 0.f, 0.f, 0.f};
        cur = nxt; cA = nA; cB = nB; ++ui;
    }
    PG8_WAIT_V(0);
    if (wr == 0) PG8_BAR;
    PG8_BAR;
    if constexpr (Epi::AFTER_DRAIN) { E.fused(acc, cur, wr, wc, fr, fq, lds, wid, lane); S.done(cur); }
    PG8_STAMP();
    if (STAMP && wid == 0) { stamps[lane] = lane < nts ? (((unsigned long long)(unsigned)ts_hi << 32) | (unsigned)ts_lo) : 0ull;
        if (lane == 62) stamps[62] = rt_entry; if (lane == 63) stamps[63] = (unsigned long long)wall_clock64(); }
#undef PG8_STAMP
#undef PG8_SA
#undef PG8_SB
#undef PG8_STAGE
#undef PG8_LDA
#undef PG8_LDB
#undef PG8_MMA
#undef PG8_WAIT_V
#undef PG8_WAIT_L
#undef PG8_BAR
#undef PG8_SCHED
}
}

template <int MI, int BK = 64, int NI = 2, int WR = 4, bool TR = false>
__device__ __forceinline__ void gemm_mainloop(f32x16 (&acc)[MI][NI], const bf16_t* __restrict__ A, int lda, const bf16_t* __restrict__ Bt, int ldb, int K, unsigned char* lds) {
    constexpr int WC = 8 / WR;
    constexpr int BM = 32 * MI * WR, BN = 32 * NI * WC;
    constexpr int RS = (BK + 8) * 2;
    constexpr int VPR = BK / 8;
    constexpr int RPP = NT / VPR;
    constexpr int NA = BM / RPP, NB = BN / RPP;
    constexpr int ABYTES = BM * RS, BBYTES = BN * RS, STAGE = ABYTES + BBYTES;
    static_assert(NA >= 2 && NA <= 4 && NB >= 2 && NB <= 4 && BM % RPP == 0 && BN % RPP == 0, "tile config");
    const int tid = tid_opaque(), lane = tid & 63, wid = tid >> 6, wr = wid / WC, wc = wid % WC;
    const int lr = tid / VPR, lk = tid % VPR;
    uint4 ra0, ra1, ra2, ra3, rb0, rb1, rb2, rb3;
    const bf16_t* Ap = A + (size_t)lr * lda + lk * 8;
    const bf16_t* Bp = Bt + (size_t)lr * ldb + lk * 8;
    const int nk = K / BK;
    const int wo = lr * RS + lk * 16;
#define G_LOAD(k0) { ra0 = *(const uint4*)(Ap + (k0)); ra1 = *(const uint4*)(Ap + (size_t)RPP * lda + (k0)); \
        if (NA >= 3) ra2 = *(const uint4*)(Ap + (size_t)(2 * RPP) * lda + (k0)); \
        if (NA >= 4) ra3 = *(const uint4*)(Ap + (size_t)(3 * RPP) * lda + (k0)); \
        rb0 = *(const uint4*)(Bp + (k0)); rb1 = *(const uint4*)(Bp + (size_t)RPP * ldb + (k0)); \
        if (NB >= 3) rb2 = *(const uint4*)(Bp + (size_t)(2 * RPP) * ldb + (k0)); \
        if (NB >= 4) rb3 = *(const uint4*)(Bp + (size_t)(3 * RPP) * ldb + (k0)); }
#define S_STORE(buf) { *(uint4*)((buf) + wo) = ra0; *(uint4*)((buf) + wo + RPP * RS) = ra1; \
        if (NA >= 3) *(uint4*)((buf) + wo + 2 * RPP * RS) = ra2; \
        if (NA >= 4) *(uint4*)((buf) + wo + 3 * RPP * RS) = ra3; \
        *(uint4*)((buf) + ABYTES + wo) = rb0; *(uint4*)((buf) + ABYTES + wo + RPP * RS) = rb1; \
        if (NB >= 3) *(uint4*)((buf) + ABYTES + wo + 2 * RPP * RS) = rb2; \
        if (NB >= 4) *(uint4*)((buf) + ABYTES + wo + 3 * RPP * RS) = rb3; }
    ra2 = ra3 = rb2 = rb3 = make_uint4(0, 0, 0, 0);
    __syncthreads();
    G_LOAD(0)
    S_STORE(lds)
    __syncthreads();
    const int aoff = (wr * 32 * MI + (lane & 31)) * RS + (lane >> 5) * 16;
    const int boff = ABYTES + (wc * 32 * NI + (lane & 31)) * RS + (lane >> 5) * 16;
#pragma unroll 1
    for (int kt = 0; kt < nk; ++kt) {
        unsigned char* cur = lds + (kt & 1) * STAGE;
        unsigned char* nxt = lds + ((kt + 1) & 1) * STAGE;
        const bool more = (kt + 1 < nk);
        if (more) { const int k0 = (kt + 1) * BK; G_LOAD(k0) }
#pragma unroll
        for (int ks = 0; ks < BK / 16; ++ks) {
            bf16x8 af[MI], bfr[NI];
#pragma unroll
            for (int mi = 0; mi < MI; ++mi) af[mi] = *(const bf16x8*)(cur + aoff + mi * 32 * RS + ks * 32);
#pragma unroll
            for (int ni = 0; ni < NI; ++ni) bfr[ni] = *(const bf16x8*)(cur + boff + ni * 32 * RS + ks * 32);
#pragma unroll
            for (int mi = 0; mi < MI; ++mi)
#pragma unroll
                for (int ni = 0; ni < NI; ++ni)
                    acc[mi][ni] = TR ? __builtin_amdgcn_mfma_f32_32x32x16_bf16(bfr[ni], af[mi], acc[mi][ni], 0, 0, 0)
                                     : __builtin_amdgcn_mfma_f32_32x32x16_bf16(af[mi], bfr[ni], acc[mi][ni], 0, 0, 0);
        }
        if (more) S_STORE(nxt)
        __syncthreads();
    }
#undef G_LOAD
#undef S_STORE
}

template <int MI, int NI = 2>
__device__ __forceinline__ void zero_acc(f32x16 (&acc)[MI][NI]) {
#pragma unroll
    for (int mi = 0; mi < MI; ++mi)
#pragma unroll
        for (int ni = 0; ni < NI; ++ni)
#pragma unroll
            for (int r = 0; r < 16; ++r) acc[mi][ni][r] = 0.f;
}

template <int MI, int NI = 2, int WR = 4, class F>
__device__ __forceinline__ void for_each_acc(f32x16 (&acc)[MI][NI], int row0, int col0, F f) {
    constexpr int WC = 8 / WR;
    const int lane = tid_opaque() & 63, wid = tid_opaque() >> 6, wr = wid / WC, wc = wid % WC;
#pragma unroll
    for (int mi = 0; mi < MI; ++mi)
#pragma unroll
        for (int ni = 0; ni < NI; ++ni) {
            const int col = col0 + wc * 32 * NI + ni * 32 + (lane & 31);
            const int rb = row0 + wr * 32 * MI + mi * 32 + 4 * (lane >> 5);
#pragma unroll
            for (int r = 0; r < 16; ++r) { float v = acc[mi][ni][r]; f(rb + (r & 3) + 8 * (r >> 2), col, v); acc[mi][ni][r] = v; }
        }
}

template <int MI, int NI = 2, int WR = 4, class F>
__device__ __forceinline__ void for_each_acc4(f32x16 (&acc)[MI][NI], int row0, int col0, F f) {
    constexpr int WC = 8 / WR;
    const int lane = tid_opaque() & 63, wid = tid_opaque() >> 6, wr = wid / WC, wc = wid % WC;
#pragma unroll
    for (int mi = 0; mi < MI; ++mi)
#pragma unroll
        for (int ni = 0; ni < NI; ++ni) {
            const int row = row0 + wr * 32 * MI + mi * 32 + (lane & 31);
            const int cb = col0 + wc * 32 * NI + ni * 32 + 4 * (lane >> 5);
#pragma unroll
            for (int g = 0; g < 4; ++g) {
                float4 v = make_float4(acc[mi][ni][4 * g], acc[mi][ni][4 * g + 1], acc[mi][ni][4 * g + 2], acc[mi][ni][4 * g + 3]);
                f(row, cb + 8 * g, v);
                acc[mi][ni][4 * g] = v.x; acc[mi][ni][4 * g + 1] = v.y; acc[mi][ni][4 * g + 2] = v.z; acc[mi][ni][4 * g + 3] = v.w;
            }
        }
}
__device__ __forceinline__ float4 bf4_to_f4(uint2 u) { return make_float4(__uint_as_float(u.x << 16), __uint_as_float(u.x & 0xffff0000u), __uint_as_float(u.y << 16), __uint_as_float(u.y & 0xffff0000u)); }
__device__ __forceinline__ uint2 f4_to_bf4(float4 v) { return make_uint2(pk2(v.x, v.y), pk2(v.z, v.w)); }

template <class F>
__device__ __forceinline__ void for_tiles(int n_mt, int n_nt, F f) {
    const int G = gridDim.x, b = blockIdx.x;
    const bool ok = ((G & 7) == 0) && ((n_mt & 7) == 0);
    const int xcd = ok ? (b & 7) : 0, mul = ok ? 8 : 1, mpx = ok ? (n_mt >> 3) : n_mt;
    const int t0 = ok ? (b >> 3) : b, tstep = ok ? (G >> 3) : G, ntot = mpx * n_nt;
#pragma unroll 1
    for (int t = t0; t < ntot; t += tstep) f(xcd + mul * (t % mpx), t / mpx);
}

__device__ __forceinline__ const float* xrow(const Params& p, int t) { return t < TP ? p.in[0] + (size_t)t * 1024 : p.in[1] + (size_t)(t - TP) * 1024; }
__device__ __forceinline__ int modidx(int t) { return t < TP ? 0 : 1 + ((t - TP) >> 11); }

__device__ __forceinline__ void transpose_tile(const Params& p, int tI, unsigned char* lds) {
    const int tid = tid_opaque();
    const float* src; bf16_t* dst; int K, N;
    if (tI < 2064) { src = p.in[9]; dst = (bf16_t*)(p.ws + WS_WIN); K = 1024; N = 8256; }
    else if (tI < 2320) { tI -= 2064; src = p.in[10]; dst = (bf16_t*)(p.ws + WS_WF); K = 1024; N = 1024; }
    else if (tI < 2832) { tI -= 2320; src = p.in[17]; dst = (bf16_t*)(p.ws + WS_WSO); K = 2048; N = 1024; }
    else if (tI < 3088) { tI -= 2832; src = p.in[18]; dst = (bf16_t*)(p.ws + WS_WO); K = 1024; N = 1024; }
    else if (tI < 4112) { tI -= 3088; src = p.in[20]; dst = (bf16_t*)(p.ws + WS_W1); K = 1024; N = 4096; }
    else { tI -= 4112; src = p.in[21]; dst = (bf16_t*)(p.ws + WS_W2); K = 4096; N = 1024; }
    const int nkt = K >> 6; const int k0 = (tI % nkt) * 64, n0 = (tI / nkt) * 64;
    bf16_t* ts = (bf16_t*)lds;
    __syncthreads();
#pragma unroll
    for (int i = 0; i < 2; ++i) { const int idx = tid + i * NT, kr = idx >> 4, nv = idx & 15;
        const float4 v = *(const float4*)(src + (size_t)(k0 + kr) * N + n0 + nv * 4);
        ts[(nv * 4 + 0) * 72 + kr] = f2bf(v.x); ts[(nv * 4 + 1) * 72 + kr] = f2bf(v.y); ts[(nv * 4 + 2) * 72 + kr] = f2bf(v.z); ts[(nv * 4 + 3) * 72 + kr] = f2bf(v.w); }
    __syncthreads();
    { const int n = tid >> 3, kv = tid & 7; *(uint4*)(dst + (size_t)(n0 + n) * K + k0 + kv * 8) = *(const uint4*)(ts + n * 72 + kv * 8); }
}

__device__ __forceinline__ void phase_prep(const Params& p, unsigned char* lds) {
    const int tid = tid_opaque();
    float* mod = (float*)(p.ws + WS_MOD);
    const bool defer = (gridDim.x == 256);
    constexpr int N_GEMV = 192, N_TR = 5136, N_ZERO = 1, N_TAB = 32 + 32 + 2048;
    constexpr int NITEMS = N_GEMV + N_TR + N_ZERO + N_TAB;
    for (int item = blockIdx.x; item < NITEMS; item += gridDim.x) {
        if (item < N_GEMV) {
            float* sv = (float*)lds;
            float* part = sv + 3072;
            __syncthreads();
            for (int i = tid; i < 3072; i += NT) { const int r = i >> 10, k = i & 1023; const float v = (r == 0) ? p.in[5][k] : p.in[4][(r - 1) * 1024 + k]; sv[i] = siluf(v); }
            __syncthreads();
            const int col = tid & 31, kq = tid >> 5, col0 = item * 32;
            const float* w = p.in[6] + (size_t)(kq * 64) * 6144 + col0 + col;
            float a0 = 0.f, a1 = 0.f, a2 = 0.f;
#pragma unroll 16
            for (int k = 0; k < 64; ++k) { const float wv = w[(size_t)k * 6144]; const int kk = kq * 64 + k; a0 += sv[kk] * wv; a1 += sv[1024 + kk] * wv; a2 += sv[2048 + kk] * wv; }
            part[(kq * 3 + 0) * 32 + col] = a0; part[(kq * 3 + 1) * 32 + col] = a1; part[(kq * 3 + 2) * 32 + col] = a2;
            __syncthreads();
            if (tid < 96) { const int r = tid >> 5, c = tid & 31; float s = p.in[7][col0 + c];
                for (int q = 0; q < 16; ++q) s += part[(q * 3 + r) * 32 + c];
                mod[r * 6144 + col0 + c] = s; }
        } else if (item < N_GEMV + N_TR) {
            const int tI = item - N_GEMV;
            if (defer && tI >= 2832) continue;
            transpose_tile(p, tI, lds);
        } else if (item < N_GEMV + N_TR + N_ZERO) {
            uint4* d = (uint4*)(p.ws + WS_WIN + (size_t)8256 * 1024 * 2);
            for (int i = tid; i < 64 * 1024 * 2 / 16; i += NT) d[i] = make_uint4(0, 0, 0, 0);
        } else {
            const int tb = item - (N_GEMV + N_TR + N_ZERO);
            unsigned pk[4];
            bf16_t* dst; size_t e0;
            if (tb < 32) { dst = (bf16_t*)(p.ws + WS_CSC); e0 = (size_t)tb * 4096 + tid * 8;
#pragma unroll
                for (int j = 0; j < 8; j += 2) { float v[2];
                    for (int u = 0; u < 2; ++u) { const int e = (int)e0 + j + u, m = e >> 8, k = e & 255, cs = m >> 8, chp = m & 255; const float ang = (float)((chp * k) & 255) * (1.f / 128.f);
                        v[u] = (cs == 0 ? cospif(ang) : sinpif(ang)) * 0.0625f; }
                    pk[j >> 1] = pk2(v[0], v[1]); }
            } else if (tb < 64) { dst = (bf16_t*)(p.ws + WS_A256); e0 = (size_t)(tb - 32) * 4096 + tid * 8;
#pragma unroll
                for (int j = 0; j < 8; j += 2) { float v[2];
                    for (int u = 0; u < 2; ++u) { const int e = (int)e0 + j + u, lp = e >> 9, kk = e & 511, cs = kk >> 8, l = kk & 255; const float ang = (float)((lp * l) & 255) * (1.f / 128.f);
                        v[u] = (cs == 0 ? cospif(ang) : -sinpif(ang)) * 0.0625f; }
                    pk[j >> 1] = pk2(v[0], v[1]); }
            } else { dst = (bf16_t*)((unsigned char*)p.out + DO_APOS); e0 = (size_t)(tb - 64) * 4096 + tid * 8;
#pragma unroll
                for (int j = 0; j < 8; j += 2) { float v[2];
                    for (int u = 0; u < 2; ++u) { const int e = (int)e0 + j + u, lp = e >> 12, kk = e & 4095, cs = kk >> 11, l = kk & 2047;
                        const int r = l >> 6, c = l & 63, rp = lp >> 6, cp = lp & 63; const float ang = (float)((2 * r * rp + c * cp) & 63) * (1.f / 32.f);
                        v[u] = (cs == 0 ? cospif(ang) : -sinpif(ang)) * 0.02209708691f; }
                    pk[j >> 1] = pk2(v[0], v[1]); }
            }
            *(uint4*)(dst + e0) = make_uint4(pk[0], pk[1], pk[2], pk[3]);
        }
    }
}

__device__ __forceinline__ void phase_norm(const Params& p, int which) {
    const int lane = tid_opaque() & 63, wid = tid_opaque() >> 6;
    const float* mod = (const float*)(p.ws + WS_MOD);
    const float* g = which == 0 ? p.in[8] : (which == 1 ? p.in[19] : p.in[22]);
    bf16_t* dst = which == 0 ? (bf16_t*)((unsigned char*)p.out + DO_H1) : (bf16_t*)(p.ws + WS_H2);
    for (int t0 = (blockIdx.x * 8 + wid) * 2; t0 < T; t0 += gridDim.x * 16) {
        float4 v[2][4]; float ss[2] = {0.f, 0.f};
#pragma unroll
        for (int u = 0; u < 2; ++u) { const int t = t0 + u; const float* src = which == 0 ? xrow(p, t) : p.out + (size_t)t * 1024;
#pragma unroll
            for (int i = 0; i < 4; ++i) v[u][i] = *(const float4*)(src + i * 256 + lane * 4); }
#pragma unroll
        for (int u = 0; u < 2; ++u) {
#pragma unroll
            for (int i = 0; i < 4; ++i) ss[u] += v[u][i].x * v[u][i].x + v[u][i].y * v[u][i].y + v[u][i].z * v[u][i].z + v[u][i].w * v[u][i].w;
#pragma unroll
            for (int o = 32; o > 0; o >>= 1) ss[u] += __shfl_xor(ss[u], o);
        }
#pragma unroll
        for (int u = 0; u < 2; ++u) {
            const int t = t0 + u;
            const float rstd = rsqrtf(ss[u] * (1.f / 1024.f) + 1e-6f);
            if (which == 2) {
#pragma unroll
                for (int i = 0; i < 4; ++i) { const int c = i * 256 + lane * 4; const float4 gg = *(const float4*)(g + c);
                    float4 o; o.x = v[u][i].x * rstd * gg.x; o.y = v[u][i].y * rstd * gg.y; o.z = v[u][i].z * rstd * gg.z; o.w = v[u][i].w * rstd * gg.w;
                    *(float4*)(p.out + (size_t)t * 1024 + c) = o; }
            } else {
                const float* mrow = mod + modidx(t) * 6144 + (which == 0 ? 0 : 3072);
#pragma unroll
                for (int i = 0; i < 4; ++i) { const int c = i * 256 + lane * 4; const float4 gg = *(const float4*)(g + c);
                    const float4 sh = *(const float4*)(mrow + c), sc = *(const float4*)(mrow + 1024 + c);
                    const float o0 = v[u][i].x * rstd * gg.x * (1.f + sc.x) + sh.x, o1 = v[u][i].y * rstd * gg.y * (1.f + sc.y) + sh.y;
                    const float o2 = v[u][i].z * rstd * gg.z * (1.f + sc.z) + sh.z, o3 = v[u][i].w * rstd * gg.w * (1.f + sc.w) + sh.w;
                    *(uint2*)(dst + (size_t)t * 1024 + c) = make_uint2(pk2(o0, o1), pk2(o2, o3)); }
            }
        }
    }
}

struct EpiInProj {
    static constexpr bool PERM = true, AFTER_DRAIN = false;
    bf16_t* uf; bf16_t* zs; bf16_t* xbc; float* dtb; bf16_t* gates; const float* dt_bias;
    __device__ __forceinline__ void operator()(const pg8::f32x4 (&acc)[2][2][4][2], const pg8::Unit& u, int wr, int wc, int fr, int fq) const {
#pragma unroll
        for (int bj = 0; bj < 2; ++bj) {
            const int cb = __builtin_amdgcn_readfirstlane(u.pn * 256 + bj * 128 + wc * 32);
            const int rbase = u.pm * 256 + wr * 64 + fr;
            if (cb >= 6144 && cb < 6208) {
                const int j = cb - 6144 + 8 * fq;
                const float4 b0 = *(const float4*)(dt_bias + j), b1 = *(const float4*)(dt_bias + j + 4);
#pragma unroll
                for (int ai = 0; ai < 2; ++ai)
#pragma unroll
                    for (int m = 0; m < 4; ++m) {
                        const pg8::f32x4 v0 = acc[ai][bj][m][0], v1 = acc[ai][bj][m][1];
                        float x[8] = {v0[0] + b0.x, v0[1] + b0.y, v0[2] + b0.z, v0[3] + b0.w, v1[0] + b1.x, v1[1] + b1.y, v1[2] + b1.z, v1[3] + b1.w};
#pragma unroll
                        for (int e = 0; e < 8; ++e) x[e] = x[e] > 20.f ? x[e] : log1pf(__expf(x[e]));
                        float* d = dtb + (size_t)(rbase + ai * 128 + m * 16) * 64 + j;
                        *(float4*)d = make_float4(x[0], x[1], x[2], x[3]); *(float4*)(d + 4) = make_float4(x[4], x[5], x[6], x[7]);
                    }
            } else {
                bf16_t* dst; int ld, c0; bool sg = false;
                if (cb < 1024) { dst = uf + (size_t)(cb >> 8) * T * 256; ld = 256; c0 = cb & 255; }
                else if (cb < 3072) { dst = zs; ld = 2048; c0 = cb - 1024; }
                else if (cb < 6144) { dst = xbc; ld = 3072; c0 = cb - 3072; }
                else { dst = gates; ld = 2048; c0 = cb - 6208; sg = true; }
                bf16_t* dp = dst + (size_t)rbase * ld + c0 + 8 * fq;
                if (sg) {
#pragma unroll
                    for (int ai = 0; ai < 2; ++ai)
#pragma unroll
                        for (int m = 0; m < 4; ++m) { const pg8::f32x4 v0 = acc[ai][bj][m][0], v1 = acc[ai][bj][m][1];
                            *(uint4*)(dp + (size_t)(ai * 128 + m * 16) * ld) = make_uint4(pk2(sigmf(v0[0]), sigmf(v0[1])), pk2(sigmf(v0[2]), sigmf(v0[3])), pk2(sigmf(v1[0]), sigmf(v1[1])), pk2(sigmf(v1[2]), sigmf(v1[3]))); }
                } else {
#pragma unroll
                    for (int ai = 0; ai < 2; ++ai)
#pragma unroll
                        for (int m = 0; m < 4; ++m) { const pg8::f32x4 v0 = acc[ai][bj][m][0], v1 = acc[ai][bj][m][1];
                            *(uint4*)(dp + (size_t)(ai * 128 + m * 16) * ld) = make_uint4(pk2(v0[0], v0[1]), pk2(v0[2], v0[3]), pk2(v1[0], v1[1]), pk2(v1[2], v1[3])); }
                }
            }
        }
    }
};

__device__ __forceinline__ void phase_inproj(const Params& p, unsigned char* lds) {
    const bf16_t* h1 = (const bf16_t*)((unsigned char*)p.out + DO_H1);
    const bf16_t* W = (const bf16_t*)(p.ws + WS_WIN);
    bf16_t* uf = (bf16_t*)((unsigned char*)p.out + DO_UF);
    bf16_t* zs = (bf16_t*)(p.ws + WS_ZS);
    bf16_t* xbc = (bf16_t*)(p.ws + WS_XBC);
    float* dtb = (float*)(p.ws + WS_DTB);
    bf16_t* gates = (bf16_t*)((unsigned char*)p.out + DO_GATES);
    const float* dt_bias = p.in[13];
    auto epi = [&](const f32x16& a, int rb, int cb, int lane) {
        if (cb >= 8256) return;
        if (cb >= 6144 && cb < 6208) {
            const int j = cb - 6144 + (lane & 31); const float bias = dt_bias[j];
#pragma unroll
            for (int r = 0; r < 16; ++r) { const float x = a[r] + bias; dtb[(size_t)(rb + (r & 3) + 8 * (r >> 2)) * 64 + j] = x > 20.f ? x : log1pf(__expf(x)); }
        } else {
            bf16_t* dst; int ld, c0; bool sg = false;
            if (cb < 1024) { dst = uf; ld = 1024; c0 = cb; }
            else if (cb < 3072) { dst = zs; ld = 2048; c0 = cb - 1024; }
            else if (cb < 6144) { dst = xbc; ld = 3072; c0 = cb - 3072; }
            else { dst = gates; ld = 2048; c0 = cb - 6208; sg = true; }
            bf16_t* dp = dst + (size_t)rb * ld + c0 + (lane & 31);
            if (sg) {
#pragma unroll
                for (int r = 0; r < 16; ++r) dp[(size_t)((r & 3) + 8 * (r >> 2)) * ld] = f2bf(sigmf(a[r]));
            } else {
#pragma unroll
                for (int r = 0; r < 16; ++r) dp[(size_t)((r & 3) + 8 * (r >> 2)) * ld] = f2bf(a[r]);
            }
        }
    };
    {
        pg8::Gemm g{h1, W, T, 8192, 1024};
        pg8::StaticOrder S; S.init(T, 8192, (int)gridDim.x, (int)blockIdx.x);
        EpiInProj E{uf, zs, xbc, dtb, gates, dt_bias};
        pg8::gemm_phase<EpiInProj, pg8::StaticOrder, false>((PG8_LAS unsigned char*)lds, g, S, E, nullptr);
    }
    for (int mt = (int)gridDim.x - 1 - (int)blockIdx.x; mt < 48; mt += gridDim.x) {
        f32x16 acc[2][2]; zero_acc<2>(acc);
        gemm_mainloop<2>(acc, h1 + (size_t)mt * 256 * 1024, 1024, W + (size_t)8192 * 1024, 1024, 1024, lds);
        const int lane = tid_opaque() & 63, wid = tid_opaque() >> 6, wr = wid >> 1, wc = wid & 1;
#pragma unroll
        for (int mi = 0; mi < 2; ++mi)
#pragma unroll
            for (int ni = 0; ni < 2; ++ni)
                epi(acc[mi][ni], mt * 256 + wr * 64 + mi * 32 + 4 * (lane >> 5), __builtin_amdgcn_readfirstlane(8192 + wc * 64 + ni * 32), lane);
    }
}

struct ConvPre { uint4 v0, v1, v2; float w; };
__device__ __forceinline__ void conv_prefetch(const Params& p, int item, int tid, ConvPre& r) {
    const int q = item / 48, sl = item % 48;
    const int sstart = q < 64 ? (q >> 1) * 256 : TP + ((q - 64) >> 4) * 2048;
    const int send = sstart + (q < 64 ? 256 : 2048);
    const int t0 = q * 128;
    const bf16_t* xbc = (const bf16_t*)(p.ws + WS_XBC);
    r.v0 = r.v1 = r.v2 = make_uint4(0, 0, 0, 0); r.w = 0.f;
    { const int idx = tid, row = idx >> 3, v = idx & 7; const int t = t0 - 2 + row; if (t >= sstart && t < send) r.v0 = *(const uint4*)(xbc + (size_t)t * 3072 + sl * 64 + v * 8); }
    { const int idx = tid + NT, row = idx >> 3, v = idx & 7; const int t = t0 - 2 + row; if (t >= sstart && t < send) r.v1 = *(const uint4*)(xbc + (size_t)t * 3072 + sl * 64 + v * 8); }
    { const int idx = tid + 2 * NT, row = idx >> 3, v = idx & 7; const int t = t0 - 2 + row; if (idx < 132 * 8 && t >= sstart && t < send) r.v2 = *(const uint4*)(xbc + (size_t)t * 3072 + sl * 64 + v * 8); }
    if (tid < 320) r.w = p.in[11][(tid >> 6) * 3072 + sl * 64 + (tid & 63)];
    else if (tid < 384) r.w = p.in[12][sl * 64 + (tid - 320)];
}

__device__ __forceinline__ void conv_item(const Params& p, int item, int next_item, ConvPre& pre, unsigned char* lds) {
    const int tid = tid_opaque();
    const int q = item / 48, sl = item % 48;
    bf16_t* sIn = (bf16_t*)lds;
    bf16_t* sOut = (bf16_t*)(lds + 132 * 144);
    float* sW = (float*)(lds + 132 * 144 + 128 * 144);
    __syncthreads();
    { const int idx = tid; *(uint4*)(sIn + (idx >> 3) * 72 + (idx & 7) * 8) = pre.v0; }
    { const int idx = tid + NT; *(uint4*)(sIn + (idx >> 3) * 72 + (idx & 7) * 8) = pre.v1; }
    { const int idx = tid + 2 * NT; if (idx < 132 * 8) *(uint4*)(sIn + (idx >> 3) * 72 + (idx & 7) * 8) = pre.v2; }
    if (tid < 384) sW[tid] = pre.w;
    if (next_item >= 0) conv_prefetch(p, next_item, tid, pre);
    __syncthreads();
    {
        const int j = tid >> 2, c0 = (tid & 3) * 16;
        float o[16];
#pragma unroll
        for (int c = 0; c < 16; ++c) o[c] = sW[320 + c0 + c];
#pragma unroll
        for (int k = 0; k < 5; ++k) {
            const uint4 a = *(const uint4*)(sIn + (j + k) * 72 + c0), b = *(const uint4*)(sIn + (j + k) * 72 + c0 + 8);
            const unsigned w[8] = {a.x, a.y, a.z, a.w, b.x, b.y, b.z, b.w};
#pragma unroll
            for (int u = 0; u < 8; ++u) { o[2 * u] += sW[k * 64 + c0 + 2 * u] * __uint_as_float(w[u] << 16); o[2 * u + 1] += sW[k * 64 + c0 + 2 * u + 1] * __uint_as_float(w[u] & 0xffff0000u); }
        }
        unsigned pk[8];
#pragma unroll
        for (int u = 0; u < 8; ++u) pk[u] = pk2(siluf(o[2 * u]), siluf(o[2 * u + 1]));
        *(uint4*)(sOut + j * 72 + c0) = make_uint4(pk[0], pk[1], pk[2], pk[3]);
        *(uint4*)(sOut + j * 72 + c0 + 8) = make_uint4(pk[4], pk[5], pk[6], pk[7]);
    }
    __syncthreads();
    if (sl >= 32) {
        const int s2 = sl - 32, isC = s2 >= 8, g = (s2 & 7) >> 1, nh = s2 & 1;
        bf16_t* dst = (bf16_t*)(p.ws + (isC ? WS_CM : WS_BM)) + (size_t)(q * 4 + g) * 128 * 128 + nh * 64;
#pragma unroll
        for (int i = 0; i < 2; ++i) { const int idx = tid + i * NT, j = idx >> 3, v = idx & 7; *(uint4*)(dst + (size_t)j * 128 + v * 8) = *(const uint4*)(sOut + j * 72 + v * 8); }
    }
    if (sl < 40) {
        bf16_t* dst;
        if (sl < 32) dst = (bf16_t*)(p.ws + WS_XT) + (size_t)(q * 32 + sl) * 64 * 128;
        else { const int s2 = sl - 32; dst = (bf16_t*)(p.ws + WS_BT) + (size_t)(q * 4 + (s2 >> 1)) * 128 * 128 + (size_t)(s2 & 1) * 64 * 128; }
        const int ch = tid >> 3, jv = tid & 7;
#pragma unroll
        for (int i = 0; i < 2; ++i) { const int j0 = jv * 8 + i * 64; unsigned pk[4];
#pragma unroll
            for (int u = 0; u < 4; ++u) pk[u] = (unsigned)sOut[(j0 + 2 * u) * 72 + ch] | ((unsigned)sOut[(j0 + 2 * u + 1) * 72 + ch] << 16);
            *(uint4*)(dst + (size_t)ch * 128 + j0) = make_uint4(pk[0], pk[1], pk[2], pk[3]); }
    }
}

__device__ __forceinline__ void phase_conv_f1(const Params& p, unsigned char* lds) {
    const bf16_t* csc = (const bf16_t*)(p.ws + WS_CSC);
    const bf16_t* uf = (const bf16_t*)((unsigned char*)p.out + DO_UF);
    (void)csc; (void)uf;
    ConvPre pre;
    int item = blockIdx.x;
    if (item < 96 * 48) conv_prefetch(p, item, tid_opaque(), pre);
#pragma unroll 1
    for (; item < 96 * 48; item += gridDim.x) {
        const int nxt = item + (int)gridDim.x;
        conv_item(p, item, nxt < 96 * 48 ? nxt : -1, pre, lds);
    }
}

struct EpiF1 {
    static constexpr bool PERM = true, AFTER_DRAIN = false;
    bf16_t* z1p; bf16_t* z1s;
    __device__ __forceinline__ void operator()(const pg8::f32x4 (&acc)[2][2][4][2], const pg8::Unit& u, int wr, int wc, int fr, int fq) const {
        const int cs = u.pm;
        const int g = u.pn / 48, tu = u.pn % 48;
        const bool samp = tu >= 32;
        bf16_t* zb = samp ? z1s : z1p;
        const int ldz = samp ? 4096 : 512;
        int off;
        if (!samp) { const int t = tu * 256 + wc * 32 + 8 * fq; off = (((t >> 8) * 4 + g) * 256 + wr * 64 + fr) * 512 + cs * 256 + (t & 255); }
        else { const int ts = (tu - 32) * 256 + wc * 32 + 8 * fq; off = (((ts >> 11) * 4 + g) * 256 + wr * 64 + fr) * 4096 + cs * 2048 + (ts & 2047); }
#pragma unroll
        for (int bj = 0; bj < 2; ++bj)
#pragma unroll
            for (int ai = 0; ai < 2; ++ai)
#pragma unroll
                for (int mm = 0; mm < 4; ++mm) {
                    const pg8::f32x4 v0 = acc[ai][bj][mm][0], v1 = acc[ai][bj][mm][1];
                    *(uint4*)(zb + off + bj * 128 + (ai * 128 + mm * 16) * ldz) = make_uint4(pk2(v0[0], v0[1]), pk2(v0[2], v0[3]), pk2(v1[0], v1[1]), pk2(v1[2], v1[3]));
                }
    }
};

__device__ __forceinline__ void phase_f1(const Params& p, unsigned char* lds) {
    pg8::Gemm g{(const bf16_t*)(p.ws + WS_CSC), (const bf16_t*)((unsigned char*)p.out + DO_UF), 512, 4 * T, 256};
    pg8::StaticOrder S; S.init(512, 4 * T, (int)gridDim.x, (int)blockIdx.x);
    EpiF1 E{(bf16_t*)(p.ws + WS_Z1P), (bf16_t*)(p.ws + WS_Z1S)};
    pg8::gemm_phase<EpiF1, pg8::StaticOrder, false>((PG8_LAS unsigned char*)lds, g, S, E, nullptr);
}

__device__ __forceinline__ void phase_f2(const Params& p, unsigned char* lds) {
    const bf16_t* a256 = (const bf16_t*)(p.ws + WS_A256);
    const bf16_t* apos = (const bf16_t*)((unsigned char*)p.out + DO_APOS);
    const bf16_t* z1p = (const bf16_t*)(p.ws + WS_Z1P);
    const bf16_t* z1s = (const bf16_t*)(p.ws + WS_Z1S);
    bf16_t* yfm = (bf16_t*)(p.ws + WS_YFM);
    for (int id = blockIdx.x; id < 512; id += gridDim.x) {
        if (id < 256) {
            const int bg = id >> 5, rem = id & 31, mt = rem >> 1, nt = rem & 1;
            f32x16 acc[1][2]; zero_acc<1>(acc);
            gemm_mainloop<1, 128>(acc, apos + (size_t)mt * 128 * 4096, 4096, z1s + (size_t)(bg * 256 + nt * 128) * 4096, 4096, 4096, lds);
            const int b = bg >> 2, g = bg & 3;
            for_each_acc<1>(acc, mt * 128, nt * 128, [&](int lp, int chp, float& v) { yfm[(size_t)(TP + b * 2048 + lp) * 1024 + g * 256 + chp] = f2bf(v); });
        } else {
            const int i2 = id - 256, bg = i2 >> 1, nt = i2 & 1;
            f32x16 acc[2][2]; zero_acc<2>(acc);
            gemm_mainloop<2>(acc, a256, 512, z1p + (size_t)(bg * 256 + nt * 128) * 512, 512, 512, lds);
            const int b = bg >> 2, g = bg & 3;
            for_each_acc<2>(acc, 0, nt * 128, [&](int lp, int chp, float& v) { yfm[(size_t)(b * 256 + lp) * 1024 + g * 256 + chp] = f2bf(v); });
        }
    }
}

__device__ __forceinline__ void ssd_item(const Params& p, int seq, int h, int mode, unsigned char* lds) {
    const int tid = tid_opaque(), lane = tid & 63, wid = tid >> 6;
    const bool samp = seq >= 32;
    const int nc = samp ? 16 : 2;
    const int q0 = samp ? 64 + (seq - 32) * 16 : seq * 2;
    const int g = h >> 3;
    unsigned char* sC = lds;
    unsigned char* sB = lds + 34816;
    unsigned char* sX = lds + 69632;
    unsigned char* sH = lds + 87040;
    unsigned char* sXw = lds + 104448;
    float* sCum = (float*)(lds + 121856);
    float* sDt = sCum + 128;
    const bf16_t* gXT = (const bf16_t*)(p.ws + WS_XT);
    const bf16_t* gCM = (const bf16_t*)(p.ws + WS_CM);
    const bf16_t* gBM = (const bf16_t*)(p.ws + WS_BM);
    const bf16_t* gBT = (const bf16_t*)(p.ws + WS_BT);
    const float* dtb = (const float*)(p.ws + WS_DTB);
    bf16_t* yssd = (mode == 1) ? (bf16_t*)(p.ws + WS_YSB2) - (size_t)TP * 2048 : (bf16_t*)(p.ws + WS_YSSD);
    const float Dh = p.in[15][h];
    const int npass = mode == 2 ? 2 : 1;
    const int wr = wid >> 1, wc = wid & 1;
    const int wp = wid >> 2, wn = wid & 3;
    const int l31o = lane & 31;

#pragma unroll 1
    for (int pass = 0; pass < npass; ++pass) {
        const int dir = mode == 2 ? 1 - pass : mode;
        const bool rmw = (mode == 2 && pass == 1);
        const float Aneg = -__expf(p.in[14][dir * 32 + h]);
        f32x16 hacc;
        if (samp) {
            const float* st = p.in[2 + dir] + (size_t)((seq - 32) * 32 + h) * 8192;
#pragma unroll
            for (int r = 0; r < 16; ++r) hacc[r] = st[(wp * 32 + rowmap(r, lane)) * 128 + wn * 32 + l31o];
        } else {
#pragma unroll
            for (int r = 0; r < 16; ++r) hacc[r] = 0.f;
        }
#pragma unroll 1
        for (int step = 0; step < nc; ++step) {
            int ln = lane; asm volatile("" : "+v"(ln));
            const int l31 = ln & 31, lh = ln >> 5;
            const int c = dir == 0 ? step : nc - 1 - step;
            const int q = q0 + c, t0 = q * 128;
            if (wid == 0) {
                const float d0 = dtb[(size_t)(t0 + 2 * lane) * 64 + dir * 32 + h], d1 = dtb[(size_t)(t0 + 2 * lane + 1) * 64 + dir * 32 + h];
                const float a0 = d0 * Aneg, a1 = d1 * Aneg, s = a0 + a1;
                float sc = s;
#pragma unroll
                for (int o = 1; o < 64; o <<= 1) { const float n = __shfl_up(sc, o); if (lane >= o) sc += n; }
                const float tot = __shfl(sc, 63);
                const float ex = sc - s;
                float c0 = ex + a0, c1 = ex + a0 + a1;
                if (dir == 1) { c0 = tot - c0 + a0; c1 = tot - c1 + a1; }
                sCum[2 * lane] = c0; sCum[2 * lane + 1] = c1; sDt[2 * lane] = d0; sDt[2 * lane + 1] = d1;
            }
            const bf16_t* srcC = gCM + (size_t)(q * 4 + g) * 16384;
            const bf16_t* srcB = gBM + (size_t)(q * 4 + g) * 16384;
            const bf16_t* srcBT = gBT + (size_t)(q * 4 + g) * 16384;
            const bf16_t* srcX = gXT + (size_t)(q * 32 + h) * 8192;
            const int lrow = tid >> 4, lv = tid & 15;
            const int goff = lrow * 128 + lv * 8, soff = lrow * 272 + lv * 16;
#pragma unroll
            for (int i = 0; i < 4; ++i) {
                *(uint4*)(sC + soff + i * 32 * 272) = *(const uint4*)(srcC + goff + i * 32 * 128);
                *(uint4*)(sB + soff + i * 32 * 272) = *(const uint4*)(srcB + goff + i * 32 * 128); }
            const uint4 rbt0 = *(const uint4*)(srcBT + goff), rbt1 = *(const uint4*)(srcBT + goff + 32 * 128);
            const uint4 rbt2 = *(const uint4*)(srcBT + goff + 64 * 128), rbt3 = *(const uint4*)(srcBT + goff + 96 * 128);
            bf16_t* yp = yssd + (size_t)t0 * 2048 + h * 64 + wc * 32 + l31;
            f32x16 yprev;
#pragma unroll
            for (int r = 0; r < 16; ++r) yprev[r] = 0.f;
            if (rmw) {
#pragma unroll
                for (int r = 0; r < 16; ++r) yprev[r] = bf2f(yp[(size_t)(wr * 32 + rowmap(r, ln)) * 2048]);
            }
            const uint4 rx0 = *(const uint4*)(srcX + goff), rx1 = *(const uint4*)(srcX + goff + 32 * 128);
            *(uint4*)(sX + soff) = rx0; *(uint4*)(sX + soff + 32 * 272) = rx1;
#pragma unroll
            for (int r = 0; r < 16; ++r) *(bf16_t*)(sH + (wp * 32 + rowmap(r, ln)) * 272 + (wn * 32 + l31) * 2) = f2bf(hacc[r]);
            __syncthreads();
            const float cend = dir == 0 ? sCum[127] : sCum[0];
            {
                float wj[8];
#pragma unroll
                for (int u = 0; u < 8; ++u) wj[u] = __expf(cend - sCum[lv * 8 + u]) * sDt[lv * 8 + u];
#define XW(w, a, b) pk2(__uint_as_float((w) << 16) * wj[a], __uint_as_float((w) & 0xffff0000u) * wj[b])
                *(uint4*)(sXw + soff) = make_uint4(XW(rx0.x, 0, 1), XW(rx0.y, 2, 3), XW(rx0.z, 4, 5), XW(rx0.w, 6, 7));
                *(uint4*)(sXw + soff + 32 * 272) = make_uint4(XW(rx1.x, 0, 1), XW(rx1.y, 2, 3), XW(rx1.z, 4, 5), XW(rx1.w, 6, 7));
#undef XW
            }
            f32x16 cb0, cb1, yo;
#pragma unroll
            for (int r = 0; r < 16; ++r) { cb0[r] = 0.f; cb1[r] = 0.f; yo[r] = 0.f; }
#pragma unroll 2
            for (int ks = 0; ks < 8; ++ks) {
                const int ko = ks * 32 + lh * 16;
                const bf16x8 a = *(const bf16x8*)(sC + (wr * 32 + l31) * 272 + ko);
                const bf16x8 b0 = *(const bf16x8*)(sB + (wc * 64 + l31) * 272 + ko);
                const bf16x8 b1 = *(const bf16x8*)(sB + (wc * 64 + 32 + l31) * 272 + ko);
                const bf16x8 bh = *(const bf16x8*)(sH + (wc * 32 + l31) * 272 + ko);
                cb0 = __builtin_amdgcn_mfma_f32_32x32x16_bf16(a, b0, cb0, 0, 0, 0);
                cb1 = __builtin_amdgcn_mfma_f32_32x32x16_bf16(a, b1, cb1, 0, 0, 0);
                yo = __builtin_amdgcn_mfma_f32_32x32x16_bf16(a, bh, yo, 0, 0, 0);
            }
            {
                const int j0 = wc * 64 + l31, j1 = j0 + 32;
                const float cj0 = sCum[j0], cj1 = sCum[j1], dj0 = sDt[j0], dj1 = sDt[j1];
#pragma unroll
                for (int r = 0; r < 16; ++r) {
                    const int i = wr * 32 + rowmap(r, ln); const float ci = sCum[i];
                    const bool v0 = dir == 0 ? (j0 <= i) : (j0 >= i), v1 = dir == 0 ? (j1 <= i) : (j1 >= i);
                    float m0 = v0 ? cb0[r] * __expf(ci - cj0) * dj0 : 0.f;
                    float m1 = v1 ? cb1[r] * __expf(ci - cj1) * dj1 : 0.f;
                    if (dir == 0) { if (i == j0) m0 += Dh; if (i == j1) m1 += Dh; }
                    cb0[r] = m0; cb1[r] = m1;
                    yo[r] *= __expf(ci);
                }
            }
            __syncthreads();
            {
                const int j0 = wc * 64 + l31;
#pragma unroll
                for (int r = 0; r < 16; ++r) { const int i = wr * 32 + rowmap(r, ln);
                    *(bf16_t*)(sB + i * 272 + j0 * 2) = f2bf(cb0[r]); *(bf16_t*)(sB + i * 272 + (j0 + 32) * 2) = f2bf(cb1[r]); }
                *(uint4*)(sC + soff) = rbt0; *(uint4*)(sC + soff + 32 * 272) = rbt1; *(uint4*)(sC + soff + 64 * 272) = rbt2; *(uint4*)(sC + soff + 96 * 272) = rbt3;
            }
            __syncthreads();
            const float cdec = __expf(cend);
#pragma unroll
            for (int r = 0; r < 16; ++r) hacc[r] *= cdec;
#pragma unroll 2
            for (int ks = 0; ks < 8; ++ks) {
                const int ko = ks * 32 + lh * 16;
                const bf16x8 am = *(const bf16x8*)(sB + (wr * 32 + l31) * 272 + ko);
                const bf16x8 bx = *(const bf16x8*)(sX + (wc * 32 + l31) * 272 + ko);
                yo = __builtin_amdgcn_mfma_f32_32x32x16_bf16(am, bx, yo, 0, 0, 0);
                const bf16x8 ax = *(const bf16x8*)(sXw + (wp * 32 + l31) * 272 + ko);
                const bf16x8 bb = *(const bf16x8*)(sC + (wn * 32 + l31) * 272 + ko);
                hacc = __builtin_amdgcn_mfma_f32_32x32x16_bf16(ax, bb, hacc, 0, 0, 0);
            }
            {
#pragma unroll
                for (int r = 0; r < 16; ++r) { const int i = wr * 32 + rowmap(r, ln); yp[(size_t)i * 2048] = f2bf(yo[r] + yprev[r]); }
            }
            __syncthreads();
        }
        if (!samp) {
            float* dst = p.out + (size_t)T * 1024 + (size_t)dir * 8388608 + (size_t)(seq * 32 + h) * 8192;
#pragma unroll
            for (int r = 0; r < 16; ++r) dst[(wp * 32 + rowmap(r, lane)) * 128 + wn * 32 + l31o] = hacc[r];
        }
    }
}

template <bool ALPHA, bool BETA>
__device__ __forceinline__ void ssd_cstep(const Params& p, unsigned char* lds, int q, int h, float AnegF, float AnegB, float Dh,
                                          const f32x16& enter, int enterDir, bool scaleB, f32x16& accF, f32x16& accB, float& piF) {
    const int tid = tid_opaque(), lane = tid & 63, wid = tid >> 6;
    const int g = h >> 3, t0 = q * 128;
    unsigned char* sC = lds;
    unsigned char* sB = lds + 34816;
    unsigned char* sX = lds + 69632;
    unsigned char* sH = lds + 87040;
    unsigned char* sXwF = lds + 104448;
    unsigned char* sXwB = lds + 121856;
    float* sCumF = (float*)(lds + 139264);
    float* sCumB = sCumF + 128;
    float* sDtF = sCumF + 256;
    float* sDtB = sCumF + 384;
    const bf16_t* srcC = (const bf16_t*)(p.ws + WS_CM) + (size_t)(q * 4 + g) * 16384;
    const bf16_t* srcB = (const bf16_t*)(p.ws + WS_BM) + (size_t)(q * 4 + g) * 16384;
    const bf16_t* srcBT = (const bf16_t*)(p.ws + WS_BT) + (size_t)(q * 4 + g) * 16384;
    const bf16_t* srcX = (const bf16_t*)(p.ws + WS_XT) + (size_t)(q * 32 + h) * 8192;
    const float* dtb = (const float*)(p.ws + WS_DTB);
    bf16_t* yssd = (bf16_t*)(p.ws + WS_YSSD);
    const int wr = wid >> 1, wc = wid & 1, wp = wid >> 2, wn = wid & 3;
    const int l31 = lane & 31, lh = lane >> 5;
    if (wid == 0) {
        const float f0 = dtb[(size_t)(t0 + 2 * lane) * 64 + h], f1 = dtb[(size_t)(t0 + 2 * lane + 1) * 64 + h];
        const float b0 = dtb[(size_t)(t0 + 2 * lane) * 64 + 32 + h], b1 = dtb[(size_t)(t0 + 2 * lane + 1) * 64 + 32 + h];
        const float af0 = f0 * AnegF, af1 = f1 * AnegF, ab0 = b0 * AnegB, ab1 = b1 * AnegB;
        float sf = af0 + af1, sb = ab0 + ab1;
        const float sf0 = sf, sb0 = sb;
#pragma unroll
        for (int o = 1; o < 64; o <<= 1) { const float nf = __shfl_up(sf, o), nb = __shfl_up(sb, o); if (lane >= o) { sf += nf; sb += nb; } }
        const float totb = __shfl(sb, 63);
        const float exf = sf - sf0, exb = sb - sb0;
        sCumF[2 * lane] = exf + af0; sCumF[2 * lane + 1] = exf + af0 + af1;
        sCumB[2 * lane] = totb - exb; sCumB[2 * lane + 1] = totb - exb - ab0;
        sDtF[2 * lane] = f0; sDtF[2 * lane + 1] = f1; sDtB[2 * lane] = b0; sDtB[2 * lane + 1] = b1;
    }
    const int lrow = tid >> 4, lv = tid & 15;
    const int goff = lrow * 128 + lv * 8, soff = lrow * 272 + lv * 16;
    if (BETA) {
#pragma unroll
        for (int i = 0; i < 4; ++i) {
            *(uint4*)(sC + soff + i * 32 * 272) = *(const uint4*)(srcC + goff + i * 32 * 128);
            *(uint4*)(sB + soff + i * 32 * 272) = *(const uint4*)(srcB + goff + i * 32 * 128); }
    }
    uint4 rbt0 = make_uint4(0, 0, 0, 0), rbt1 = rbt0, rbt2 = rbt0, rbt3 = rbt0;
    if (ALPHA) {
        rbt0 = *(const uint4*)(srcBT + goff); rbt1 = *(const uint4*)(srcBT + goff + 32 * 128);
        rbt2 = *(const uint4*)(srcBT + goff + 64 * 128); rbt3 = *(const uint4*)(srcBT + goff + 96 * 128);
        if (!BETA) { *(uint4*)(sC + soff) = rbt0; *(uint4*)(sC + soff + 32 * 272) = rbt1; *(uint4*)(sC + soff + 64 * 272) = rbt2; *(uint4*)(sC + soff + 96 * 272) = rbt3; }
    }
    const uint4 rx0 = *(const uint4*)(srcX + goff), rx1 = *(const uint4*)(srcX + goff + 32 * 128);
    if (BETA) {
        *(uint4*)(sX + soff) = rx0; *(uint4*)(sX + soff + 32 * 272) = rx1;
#pragma unroll
        for (int r = 0; r < 16; ++r) *(bf16_t*)(sH + (wp * 32 + rowmap(r, lane)) * 272 + (wn * 32 + l31) * 2) = f2bf(enter[r]);
    }
    __syncthreads();
    const float pF = __expf(sCumF[127]), pB = __expf(sCumB[0]);
    if (ALPHA) {
        float wf[8], wb[8];
#pragma unroll
        for (int u = 0; u < 8; ++u) { wf[u] = __expf(sCumF[127] - sCumF[lv * 8 + u]) * sDtF[lv * 8 + u]; wb[u] = __expf(sCumB[0] - sCumB[lv * 8 + u]) * sDtB[lv * 8 + u]; }
#define XWF(w, a, b) pk2(__uint_as_float((w) << 16) * wf[a], __uint_as_float((w) & 0xffff0000u) * wf[b])
#define XWB(w, a, b) pk2(__uint_as_float((w) << 16) * wb[a], __uint_as_float((w) & 0xffff0000u) * wb[b])
        *(uint4*)(sXwF + soff) = make_uint4(XWF(rx0.x, 0, 1), XWF(rx0.y, 2, 3), XWF(rx0.z, 4, 5), XWF(rx0.w, 6, 7));
        *(uint4*)(sXwF + soff + 32 * 272) = make_uint4(XWF(rx1.x, 0, 1), XWF(rx1.y, 2, 3), XWF(rx1.z, 4, 5), XWF(rx1.w, 6, 7));
        *(uint4*)(sXwB + soff) = make_uint4(XWB(rx0.x, 0, 1), XWB(rx0.y, 2, 3), XWB(rx0.z, 4, 5), XWB(rx0.w, 6, 7));
        *(uint4*)(sXwB + soff + 32 * 272) = make_uint4(XWB(rx1.x, 0, 1), XWB(rx1.y, 2, 3), XWB(rx1.z, 4, 5), XWB(rx1.w, 6, 7));
#undef XWF
#undef XWB
    }
    f32x16 yo;
#pragma unroll
    for (int r = 0; r < 16; ++r) yo[r] = 0.f;
    if (BETA) {
        f32x16 cb0, cb1;
#pragma unroll
        for (int r = 0; r < 16; ++r) { cb0[r] = 0.f; cb1[r] = 0.f; }
#pragma unroll 2
        for (int ks = 0; ks < 8; ++ks) {
            const int ko = ks * 32 + lh * 16;
            const bf16x8 a = *(const bf16x8*)(sC + (wr * 32 + l31) * 272 + ko);
            const bf16x8 b0 = *(const bf16x8*)(sB + (wc * 64 + l31) * 272 + ko);
            const bf16x8 b1 = *(const bf16x8*)(sB + (wc * 64 + 32 + l31) * 272 + ko);
            const bf16x8 bh = *(const bf16x8*)(sH + (wc * 32 + l31) * 272 + ko);
            cb0 = __builtin_amdgcn_mfma_f32_32x32x16_bf16(a, b0, cb0, 0, 0, 0);
            cb1 = __builtin_amdgcn_mfma_f32_32x32x16_bf16(a, b1, cb1, 0, 0, 0);
            yo = __builtin_amdgcn_mfma_f32_32x32x16_bf16(a, bh, yo, 0, 0, 0);
        }
        {
            const int j0 = wc * 64 + l31, j1 = j0 + 32;
            const float fj0 = sCumF[j0], fj1 = sCumF[j1], bj0 = sCumB[j0], bj1 = sCumB[j1];
            const float df0 = sDtF[j0], df1 = sDtF[j1], db0 = sDtB[j0], db1 = sDtB[j1];
            const float* sCe = enterDir == 0 ? sCumF : sCumB;
#pragma unroll
            for (int r = 0; r < 16; ++r) {
                const int i = wr * 32 + rowmap(r, lane); const float fi = sCumF[i], bi = sCumB[i];
                const float e0 = j0 <= i ? __expf(fi - fj0) * df0 : 0.f, g0 = j0 >= i ? __expf(bi - bj0) * db0 : 0.f;
                const float e1 = j1 <= i ? __expf(fi - fj1) * df1 : 0.f, g1 = j1 >= i ? __expf(bi - bj1) * db1 : 0.f;
                float m0 = cb0[r] * (e0 + g0), m1 = cb1[r] * (e1 + g1);
                if (i == j0) m0 += Dh;
                if (i == j1) m1 += Dh;
                cb0[r] = m0; cb1[r] = m1;
                yo[r] *= __expf(sCe[i]);
            }
        }
        __syncthreads();
        {
            const int j0 = wc * 64 + l31;
#pragma unroll
            for (int r = 0; r < 16; ++r) { const int i = wr * 32 + rowmap(r, lane);
                *(bf16_t*)(sB + i * 272 + j0 * 2) = f2bf(cb0[r]); *(bf16_t*)(sB + i * 272 + (j0 + 32) * 2) = f2bf(cb1[r]); }
            if (ALPHA) { *(uint4*)(sC + soff) = rbt0; *(uint4*)(sC + soff + 32 * 272) = rbt1; *(uint4*)(sC + soff + 64 * 272) = rbt2; *(uint4*)(sC + soff + 96 * 272) = rbt3; }
        }
    }
    __syncthreads();
    if (ALPHA) {
        if (scaleB) {
#pragma unroll
            for (int r = 0; r < 16; ++r) accB[r] *= pB;
        }
    }
#pragma unroll 2
    for (int ks = 0; ks < 8; ++ks) {
        const int ko = ks * 32 + lh * 16;
        if (BETA) {
            const bf16x8 am = *(const bf16x8*)(sB + (wr * 32 + l31) * 272 + ko);
            const bf16x8 bx = *(const bf16x8*)(sX + (wc * 32 + l31) * 272 + ko);
            yo = __builtin_amdgcn_mfma_f32_32x32x16_bf16(am, bx, yo, 0, 0, 0);
        }
        if (ALPHA) {
            const bf16x8 bb = *(const bf16x8*)(sC + (wn * 32 + l31) * 272 + ko);
            const bf16x8 axf = *(const bf16x8*)(sXwF + (wp * 32 + l31) * 272 + ko);
            const bf16x8 axb = *(const bf16x8*)(sXwB + (wp * 32 + l31) * 272 + ko);
            accF = __builtin_amdgcn_mfma_f32_32x32x16_bf16(axf, bb, accF, 0, 0, 0);
            accB = __builtin_amdgcn_mfma_f32_32x32x16_bf16(axb, bb, accB, 0, 0, 0);
        }
    }
    if (BETA) {
        bf16_t* yp = yssd + (size_t)t0 * 2048 + h * 64 + wc * 32 + l31;
#pragma unroll
        for (int r = 0; r < 16; ++r) { const int i = wr * 32 + rowmap(r, lane); yp[(size_t)i * 2048] = f2bf(yo[r]); }
    }
    piF = pF;
    __syncthreads();
}

__device__ __forceinline__ void ssd_prompt_item(const Params& p, int seq, int h, unsigned char* lds) {
    const int lane = tid_opaque() & 63, wid = tid_opaque() >> 6, wp = wid >> 2, wn = wid & 3, l31 = lane & 31;
    const float AnegF = -__expf(p.in[14][h]), AnegB = -__expf(p.in[14][32 + h]), Dh = p.in[15][h];
    const int q0 = seq * 2;
    f32x16 SF1, SB, SF0, zero;
#pragma unroll
    for (int r = 0; r < 16; ++r) { SF1[r] = 0.f; SB[r] = 0.f; SF0[r] = 0.f; zero[r] = 0.f; }
    float piF1 = 1.f, piF0 = 1.f;
    ssd_cstep<true, false>(p, lds, q0 + 1, h, AnegF, AnegB, Dh, zero, 0, false, SF1, SB, piF1);
    ssd_cstep<true, true>(p, lds, q0, h, AnegF, AnegB, Dh, SB, 1, true, SF0, SB, piF0);
    {
        float* dstF = p.out + (size_t)T * 1024 + (size_t)(seq * 32 + h) * 8192;
        float* dstB = dstF + 8388608;
#pragma unroll
        for (int r = 0; r < 16; ++r) { const int o = (wp * 32 + rowmap(r, lane)) * 128 + wn * 32 + l31; dstF[o] = SF0[r] * piF1 + SF1[r]; dstB[o] = SB[r]; }
    }
    ssd_cstep<false, true>(p, lds, q0 + 1, h, AnegF, AnegB, Dh, SF0, 0, false, SF1, SB, piF0);
}

__device__ __forceinline__ void phase_ssd(const Params& p, unsigned char* lds) {
    const int G = gridDim.x, b = blockIdx.x;
    const bool bal = (G == 256);
    if (!bal || b < 128) {
#pragma unroll 1
        for (int v = b; v < 128; v += G) ssd_item(p, 32 + (v >> 6), v & 31, (v >> 5) & 1, lds);
    }
    const int p0 = bal ? (b < 128 ? 896 + b : (b - 128) * 7) : b, pstep = bal ? 1 : G, pend = bal ? (b < 128 ? 897 + b : (b - 128) * 7 + 7) : 1024;
#pragma unroll 1
    for (int pi = p0; pi < pend; pi += pstep) ssd_prompt_item(p, pi >> 5, pi & 31, lds);
}

__device__ __forceinline__ void phase_combine(const Params& p) {
    const int lane = tid_opaque() & 63, wid = tid_opaque() >> 6;
    bf16_t* yssd = (bf16_t*)(p.ws + WS_YSSD);
    const bf16_t* zs = (const bf16_t*)(p.ws + WS_ZS);
    const bf16_t* ysb2 = (const bf16_t*)(p.ws + WS_YSB2);
    const float* g = p.in[16];
    for (int t = blockIdx.x * 8 + wid; t < T; t += gridDim.x * 8) {
        float y[32]; float ss = 0.f;
#pragma unroll
        for (int i = 0; i < 4; ++i) { const int c = i * 512 + lane * 8;
            const uint4 a = *(const uint4*)(yssd + (size_t)t * 2048 + c), b = *(const uint4*)(zs + (size_t)t * 2048 + c);
            uint4 a2 = make_uint4(0u, 0u, 0u, 0u);
            if (t >= TP) a2 = *(const uint4*)(ysb2 + (size_t)(t - TP) * 2048 + c);
            const unsigned aw[4] = {a.x, a.y, a.z, a.w}, bw[4] = {b.x, b.y, b.z, b.w}, cw[4] = {a2.x, a2.y, a2.z, a2.w};
#pragma unroll
            for (int u = 0; u < 4; ++u) { const float y0 = (__uint_as_float(aw[u] << 16) + __uint_as_float(cw[u] << 16)) * siluf(__uint_as_float(bw[u] << 16)), y1 = (__uint_as_float(aw[u] & 0xffff0000u) + __uint_as_float(cw[u] & 0xffff0000u)) * siluf(__uint_as_float(bw[u] & 0xffff0000u));
                y[i * 8 + 2 * u] = y0; y[i * 8 + 2 * u + 1] = y1; ss += y0 * y0 + y1 * y1; } }
#pragma unroll
        for (int o = 32; o > 0; o >>= 1) ss += __shfl_xor(ss, o);
        const float rstd = rsqrtf(ss * (1.f / 2048.f) + 1e-6f);
#pragma unroll
        for (int i = 0; i < 4; ++i) { const int c = i * 512 + lane * 8; const float4 g0 = *(const float4*)(g + c), g1 = *(const float4*)(g + c + 4);
            *(uint4*)(yssd + (size_t)t * 2048 + c) = make_uint4(pk2(y[i * 8] * rstd * g0.x, y[i * 8 + 1] * rstd * g0.y), pk2(y[i * 8 + 2] * rstd * g0.z, y[i * 8 + 3] * rstd * g0.w),
                                                                pk2(y[i * 8 + 4] * rstd * g1.x, y[i * 8 + 5] * rstd * g1.y), pk2(y[i * 8 + 6] * rstd * g1.z, y[i * 8 + 7] * rstd * g1.w)); }
    }
}

struct EpiMerge {
    static constexpr bool PERM = true, AFTER_DRAIN = false;
    bf16_t* m; const bf16_t* gates; int second;
    __device__ __forceinline__ void operator()(const pg8::f32x4 (&acc)[2][2][4][2], const pg8::Unit& u, int wr, int wc, int fr, int fq) const {
#pragma unroll
        for (int ai = 0; ai < 2; ++ai)
#pragma unroll
            for (int mm = 0; mm < 4; ++mm) {
                const int row = u.pm * 256 + ai * 128 + wr * 64 + mm * 16 + fr;
#pragma unroll
                for (int bj = 0; bj < 2; ++bj) {
                    const int col = u.pn * 256 + bj * 128 + wc * 32 + 8 * fq;
                    const pg8::f32x4 v0 = acc[ai][bj][mm][0], v1 = acc[ai][bj][mm][1];
                    const uint4 gq = *(const uint4*)(gates + (size_t)row * 2048 + (second ? 1024 : 0) + col);
                    const float4 g0 = bf4_to_f4(make_uint2(gq.x, gq.y)), g1 = bf4_to_f4(make_uint2(gq.z, gq.w));
                    uint4* d = (uint4*)(m + (size_t)row * 1024 + col);
                    float4 o0 = make_float4(0.f, 0.f, 0.f, 0.f), o1 = o0;
                    if (second) { const uint4 oq = *d; o0 = bf4_to_f4(make_uint2(oq.x, oq.y)); o1 = bf4_to_f4(make_uint2(oq.z, oq.w)); }
                    *d = make_uint4(pk2(o0.x + v0[0] * g0.x, o0.y + v0[1] * g0.y), pk2(o0.z + v0[2] * g0.z, o0.w + v0[3] * g0.w),
                                    pk2(o1.x + v1[0] * g1.x, o1.y + v1[1] * g1.y), pk2(o1.z + v1[2] * g1.z, o1.w + v1[3] * g1.w));
                }
            }
    }
};

struct EpiResid {
    static constexpr bool PERM = false, AFTER_DRAIN = false;
    float* out; const float* xp; const float* xs; const float* mod; int gate_off; int inplace;
    __device__ __forceinline__ void operator()(const pg8::f32x4 (&acc)[2][2][4][2], const pg8::Unit& u, int wr, int wc, int fr, int fq) const {
#pragma unroll
        for (int ai = 0; ai < 2; ++ai)
#pragma unroll
            for (int mm = 0; mm < 4; ++mm) {
                const int row = u.pm * 256 + ai * 128 + wr * 64 + mm * 16 + fr;
                const float* gp = mod + modidx(row) * 6144 + gate_off;
                float* orow = out + (size_t)row * 1024;
                const float* brow = inplace ? orow : (row < TP ? xp + (size_t)row * 1024 : xs + (size_t)(row - TP) * 1024);
#pragma unroll
                for (int bj = 0; bj < 2; ++bj)
#pragma unroll
                    for (int n = 0; n < 2; ++n) {
                        const int col = u.pn * 256 + bj * 128 + wc * 32 + 16 * n + 4 * fq;
                        const pg8::f32x4 v = acc[ai][bj][mm][n];
                        const float4 x = *(const float4*)(brow + col), g = *(const float4*)(gp + col);
                        *(float4*)(orow + col) = make_float4(x.x + g.x * v[0], x.y + g.y * v[1], x.z + g.z * v[2], x.w + g.w * v[3]);
                    }
            }
    }
};

__device__ __forceinline__ void phase_merge(const Params& p, unsigned char* lds) {
    const bf16_t* gates = (const bf16_t*)((unsigned char*)p.out + DO_GATES);
    bf16_t* m = (bf16_t*)(p.ws + WS_M);
    pg8::StaticOrder S; S.init(T, 1024, (int)gridDim.x, (int)blockIdx.x);
    if (gridDim.x == 256 && blockIdx.x >= 192) {
#pragma unroll 1
        for (int tI = 2832 + ((int)blockIdx.x - 192); tI < 5136; tI += 64) transpose_tile(p, tI, lds);
        return;
    }
    {
        pg8::Gemm g{(const bf16_t*)(p.ws + WS_YFM), (const bf16_t*)(p.ws + WS_WF), T, 1024, 1024};
        EpiMerge E{m, gates, 0};
        pg8::gemm_phase<EpiMerge, pg8::StaticOrder, false>((PG8_LAS unsigned char*)lds, g, S, E, nullptr);
    }
    {
        pg8::Gemm g{(const bf16_t*)(p.ws + WS_YSSD), (const bf16_t*)(p.ws + WS_WSO), T, 1024, 2048};
        EpiMerge E{m, gates, 1};
        pg8::gemm_phase<EpiMerge, pg8::StaticOrder, false>((PG8_LAS unsigned char*)lds, g, S, E, nullptr);
    }
}

__device__ __forceinline__ void phase_out(const Params& p, unsigned char* lds) {
    pg8::Gemm g{(const bf16_t*)(p.ws + WS_M), (const bf16_t*)(p.ws + WS_WO), T, 1024, 1024};
    pg8::StaticOrder S; S.init(T, 1024, (int)gridDim.x, (int)blockIdx.x);
    EpiResid E{p.out, p.in[0], p.in[1], (const float*)(p.ws + WS_MOD), 2048, 0};
    pg8::gemm_phase<EpiResid, pg8::StaticOrder, false>((PG8_LAS unsigned char*)lds, g, S, E, nullptr);
}

struct EpiFF1 {
    static constexpr bool PERM = true, AFTER_DRAIN = false;
    bf16_t* f;
    __device__ __forceinline__ void operator()(const pg8::f32x4 (&acc)[2][2][4][2], const pg8::Unit& u, int wr, int wc, int fr, int fq) const {
#pragma unroll
        for (int ai = 0; ai < 2; ++ai)
#pragma unroll
            for (int m = 0; m < 4; ++m) {
                bf16_t* rowp = f + (size_t)(u.pm * 256 + ai * 128 + wr * 64 + m * 16 + fr) * 4096 + u.pn * 256 + wc * 32 + 8 * fq;
#pragma unroll
                for (int bj = 0; bj < 2; ++bj) {
                    const pg8::f32x4 v0 = acc[ai][bj][m][0], v1 = acc[ai][bj][m][1];
                    const float r0 = fmaxf(v0[0], 0.f), r1 = fmaxf(v0[1], 0.f), r2 = fmaxf(v0[2], 0.f), r3 = fmaxf(v0[3], 0.f);
                    const float r4 = fmaxf(v1[0], 0.f), r5 = fmaxf(v1[1], 0.f), r6 = fmaxf(v1[2], 0.f), r7 = fmaxf(v1[3], 0.f);
                    *(uint4*)(rowp + bj * 128) = make_uint4(pk2(r0 * r0, r1 * r1), pk2(r2 * r2, r3 * r3), pk2(r4 * r4, r5 * r5), pk2(r6 * r6, r7 * r7));
                }
            }
    }
};

__device__ __forceinline__ void phase_ff1(const Params& p, unsigned char* lds) {
    pg8::Gemm g{(const bf16_t*)(p.ws + WS_H2), (const bf16_t*)(p.ws + WS_W1), T, 4096, 1024};
    pg8::StaticOrder S; S.init(T, 4096, (int)gridDim.x, (int)blockIdx.x);
    EpiFF1 E{(bf16_t*)(p.ws + WS_F)};
    pg8::gemm_phase<EpiFF1, pg8::StaticOrder, false>((PG8_LAS unsigned char*)lds, g, S, E, nullptr);
}

__device__ __forceinline__ void phase_ff2(const Params& p, unsigned char* lds) {
    pg8::Gemm g{(const bf16_t*)(p.ws + WS_F), (const bf16_t*)(p.ws + WS_W2), T, 1024, 4096};
    pg8::StaticOrder S; S.init(T, 1024, (int)gridDim.x, (int)blockIdx.x);
    EpiResid E{p.out, p.in[0], p.in[1], (const float*)(p.ws + WS_MOD), 5120, 1};
    pg8::gemm_phase<EpiResid, pg8::StaticOrder, false>((PG8_LAS unsigned char*)lds, g, S, E, nullptr);
}

__global__ void __launch_bounds__(NT) fwd_megakernel(Params p) {
    extern __shared__ __attribute__((aligned(16))) unsigned char lds[];
    cg::grid_group grid = cg::this_grid();
    if (__builtin_amdgcn_workitem_id_x() == 0) *(uint4*)(lds + LDS_ST) = make_uint4(0u, 0u, 0u, 0u);
    __syncthreads();
    XcdBarrier xb = xcd_barrier_post((unsigned*)(p.ws + WS_BAR), (volatile LAS unsigned*)(lds + LDS_ST));
#define RUN(k, call) if (PH_ON(k) && p.ph_lo <= (k) && (k) < p.ph_hi) { call; } if ((k) == REPEAT_PH) { call; } if (p.ph_lo <= (k) && (k) + 1 < p.ph_hi) { if ((k) == 0) grid.sync(); else xcd_barrier(xb); }
    RUN(0, phase_prep(p, lds))
    RUN(1, phase_norm(p, 0))
    RUN(2, phase_inproj(p, lds))
    RUN(3, phase_conv_f1(p, lds))
    RUN(4, phase_f1(p, lds))
    RUN(5, phase_f2(p, lds))
    RUN(6, phase_ssd(p, lds))
    RUN(7, phase_combine(p))
    RUN(8, phase_merge(p, lds))
    RUN(9, phase_out(p, lds))
    RUN(10, phase_norm(p, 1))
    RUN(11, phase_ff1(p, lds))
    RUN(12, phase_ff2(p, lds))
    if (PH_ON(13) && p.ph_lo <= 13 && 13 < p.ph_hi) phase_norm(p, 2);
}

extern "C" void kernel_launch(void* const* d_in, const int* in_sizes, int n_in, void* d_out, int out_size, void* d_ws, size_t ws_size, hipStream_t stream) {
    static int grid_blocks = 0;
    if (grid_blocks == 0) {
        if (n_in != 23 || ws_size < WS_END || out_size != T * 1024 + 2 * 8388608) { fprintf(stderr, "kernel_launch: unexpected shapes (n_in %d, ws %zu, out %d)\n", n_in, ws_size, out_size); grid_blocks = -1; return; }
        int dev = 0, cus = 0, per_cu = 0;
        (void)hipGetDevice(&dev);
        (void)hipDeviceGetAttribute(&cus, hipDeviceAttributeMultiprocessorCount, dev);
        if (hipFuncSetAttribute((const void*)fwd_megakernel, hipFuncAttributeMaxDynamicSharedMemorySize, LDS_BYTES) != hipSuccess) { fprintf(stderr, "kernel_launch: hipFuncSetAttribute failed\n"); grid_blocks = -1; return; }
        if (hipOccupancyMaxActiveBlocksPerMultiprocessor(&per_cu, (const void*)fwd_megakernel, NT, LDS_BYTES) != hipSuccess || per_cu < 1) { fprintf(stderr, "kernel_launch: occupancy query failed (%d)\n", per_cu); grid_blocks = -1; return; }
        grid_blocks = cus * per_cu;
    }
    if (grid_blocks < 0) return;
    Params p{};
    for (int i = 0; i < 23; ++i) p.in[i] = (const float*)d_in[i];
    p.out = (float*)d_out; p.ws = (unsigned char*)d_ws;
    if (hipMemsetAsync((unsigned char*)d_ws + WS_BAR, 0, XCD_BAR_WORDS * 4, stream) != hipSuccess) { fprintf(stderr, "kernel_launch: memset failed\n"); return; }
#if ONE_LAUNCH
    p.ph_lo = 0; p.ph_hi = NPH + 1;
    void* args[] = {&p};
    hipError_t e = hipLaunchCooperativeKernel((const void*)fwd_megakernel, dim3(grid_blocks), dim3(NT), args, LDS_BYTES, stream);
    if (e != hipSuccess) fprintf(stderr, "cooperative launch failed: %s (grid %d)\n", hipGetErrorString(e), grid_blocks);
#else
    for (int ph = 0; ph <= NPH; ++ph) {
        p.ph_lo = ph; p.ph_hi = ph + 1;
        hipLaunchKernelGGL(fwd_megakernel, dim3(grid_blocks), dim3(NT), LDS_BYTES, stream, p);
    }
#endif
}
```

```cpp
#include <hip/hip_runtime.h>
#include <hip/hip_cooperative_groups.h>
#include <cstdio>
#include <cstdint>
namespace cg = cooperative_groups;

#ifndef PHMASK
#define PHMASK 0xFFFF
#endif
#define PH_ON(n) ((PHMASK >> (n)) & 1)
#ifndef REPEAT_PH
#define REPEAT_PH -1
#endif
#ifndef ONE_LAUNCH
#define ONE_LAUNCH 1
#endif

typedef unsigned short bf16_t;
typedef short bf16x8 __attribute__((ext_vector_type(8)));
typedef float f32x16 __attribute__((ext_vector_type(16)));

#define NT 512
constexpr int T = 12288, TP = 8192;
constexpr int NPH = 13;
constexpr size_t MiB = 1048576;
constexpr size_t WS_WF = 0, WS_WSO = 2 * MiB, WS_WO = 6 * MiB, WS_W1 = 8 * MiB, WS_W2 = 16 * MiB;
constexpr size_t WS_CSC = 24 * MiB, WS_A256 = 24 * MiB + 262144, WS_MOD = 24 * MiB + 524288, WS_DTB = 25 * MiB;
constexpr size_t WS_WIN = 28 * MiB;
constexpr size_t WS_YSB2 = 28 * MiB;
constexpr size_t WS_ZS = 45 * MiB;
constexpr size_t WS_XBC = 93 * MiB;
constexpr size_t WS_Z1P = 93 * MiB;
constexpr size_t WS_Z1S = 125 * MiB;
constexpr size_t WS_YFM = 141 * MiB;
constexpr size_t WS_YSSD = 93 * MiB;
constexpr size_t WS_XT = 165 * MiB;
constexpr size_t WS_CM = 213 * MiB, WS_BM = 225 * MiB, WS_BT = 237 * MiB;
constexpr size_t WS_M = 165 * MiB;
constexpr size_t WS_H2 = 189 * MiB;
constexpr size_t WS_R = 141 * MiB;
constexpr size_t WS_F = 45 * MiB;
constexpr size_t WS_BAR = 249 * MiB;
constexpr size_t WS_END = 250 * MiB;
constexpr size_t DO_GATES = 0, DO_H1 = 48 * MiB, DO_UF = 72 * MiB, DO_APOS = 96 * MiB;
constexpr int LDS_ST = 147456;
constexpr int LDS_BYTES = 147472;

struct Params {
    const float* in[23];
    float* out;
    unsigned char* ws;
    int ph_lo, ph_hi;
};

__device__ __forceinline__ int tid_opaque() { int t = (int)__builtin_amdgcn_workitem_id_x(); asm volatile("" : "+v"(t)); return t; }
typedef __bf16 bf16x2v __attribute__((ext_vector_type(2)));
typedef float f32x2v __attribute__((ext_vector_type(2)));
__device__ __forceinline__ unsigned pk2(float lo, float hi) { f32x2v v = {lo, hi}; bf16x2v b = __builtin_convertvector(v, bf16x2v); return __builtin_bit_cast(unsigned, b); }
__device__ __forceinline__ bf16_t f2bf(float f) { return (bf16_t)(pk2(f, f) & 0xffffu); }
__device__ __forceinline__ float bf2f(bf16_t h) { return __uint_as_float(((unsigned)h) << 16); }
__device__ __forceinline__ float sigmf(float v) { return __builtin_amdgcn_rcpf(1.f + __expf(-v)); }
__device__ __forceinline__ float siluf(float v) { return v * sigmf(v); }
__device__ __forceinline__ int rowmap(int reg, int lane) { return (reg & 3) + 8 * (reg >> 2) + 4 * (lane >> 5); }


#define XB_TMO      128
#define XB_XCNT(j)  (256  + 64 * (j))
#define XB_XSUB(j)  (1280 + 64 * (j))
#define XB_XGEN(j)  (2304 + 64 * (j))
#define XB_TOP      3328
#define XB_TOPGEN   3392
#define XCD_BAR_WORDS 3456
#define XB_SPIN_CAP (1u << 18)
#define LAS __attribute__((address_space(3)))
__device__ __forceinline__ unsigned xb_ld(unsigned* p)              { return __hip_atomic_load(p, __ATOMIC_RELAXED, __HIP_MEMORY_SCOPE_AGENT); }
__device__ __forceinline__ unsigned xb_add(unsigned* p, unsigned v) { return __hip_atomic_fetch_add(p, v, __ATOMIC_RELAXED, __HIP_MEMORY_SCOPE_AGENT); }
__device__ __forceinline__ unsigned xb_xcc_id() { return (unsigned)__builtin_amdgcn_s_getreg((3 << 11) | 20) & 0xFu; }
#define XB_SPIN(cond, bar) do { unsigned _sp = 0; while (cond) { __builtin_amdgcn_s_sleep(1); \
    if ((++_sp & 255u) == 0u) { if (xb_ld(&(bar)[XB_TMO])) break; if (_sp > XB_SPIN_CAP) { atomicAdd(&(bar)[XB_TMO], 1u); break; } } } } while (0)
struct XcdBarrier { unsigned* bar; unsigned x; volatile LAS unsigned* st; };
__device__ __forceinline__ XcdBarrier xcd_barrier_post(unsigned* bar, volatile LAS unsigned* st) {
    XcdBarrier b; b.bar = bar; b.x = xb_xcc_id(); b.st = st;
    if (__builtin_amdgcn_workitem_id_x() == 0) (void)xb_add(&bar[XB_XCNT(b.x)], 1u);
    return b;
}
__device__ __forceinline__ void xcd_barrier_complete(unsigned* bar, unsigned x, unsigned& nloc, unsigned& nx) {
    const unsigned G = gridDim.x * gridDim.y * gridDim.z;
    unsigned sum, cnt, mine, sp = 0u;
    for (;;) {
        sum = 0u; cnt = 0u; mine = 0u;
#pragma unroll
        for (unsigned j = 0; j < 16; ++j) { const unsigned c = xb_ld(&bar[XB_XCNT(j)]); sum += c; cnt += (c > 0u) ? 1u : 0u; mine = (j == x) ? c : mine; }
        if (sum == G) break;
        __builtin_amdgcn_s_sleep(1);
        if ((++sp & 255u) == 0u) { if (xb_ld(&bar[XB_TMO])) break; if (sp > XB_SPIN_CAP) { atomicAdd(&bar[XB_TMO], 1u); break; } }
    }
    nloc = mine > 0u ? mine : 1u; nx = cnt > 0u ? cnt : 1u;
}
__device__ __forceinline__ void xcd_barrier(const XcdBarrier& b) {
    asm volatile("s_waitcnt vmcnt(0)" ::: "memory");
    __syncthreads();
    if (__builtin_amdgcn_workitem_id_x() == 0) {
        unsigned* bar = b.bar;
        __builtin_amdgcn_s_waitcnt(0);
        unsigned nloc = b.st[0], nx = b.st[1];
        if (nloc == 0u) { xcd_barrier_complete(bar, b.x, nloc, nx); b.st[0] = nloc; b.st[1] = nx; }
        const unsigned old = xb_add(&bar[XB_XSUB(b.x)], 1u);
        const unsigned gen = old / nloc;
        if (old + 1u == (gen + 1u) * nloc) {
            __builtin_amdgcn_fence(__ATOMIC_RELEASE, "agent");
            asm volatile("s_waitcnt vmcnt(0)" ::: "memory");
            const unsigned og = xb_add(&bar[XB_TOP], 1u);
            const unsigned tg = og / nx;
            if (og + 1u == (tg + 1u) * nx) xb_add(&bar[XB_TOPGEN], 1u);
            else XB_SPIN(xb_ld(&bar[XB_TOPGEN]) == tg, bar);
            __builtin_amdgcn_fence(__ATOMIC_ACQUIRE, "agent");
            xb_add(&bar[XB_XGEN(b.x)], 1u);
            asm volatile("s_waitcnt vmcnt(0)" ::: "memory");
        } else {
            XB_SPIN(xb_ld(&bar[XB_XGEN(b.x)]) == gen, bar);
            __builtin_amdgcn_fence(__ATOMIC_ACQUIRE, "agent");
            asm volatile("s_waitcnt vmcnt(0)" ::: "memory");
        }
    }
    __syncthreads();
}

namespace pg8 {
#define PG8_LAS __attribute__((address_space(3)))
typedef unsigned short bf16_t;
typedef short bf16x8 __attribute__((ext_vector_type(8)));
typedef float f32x4 __attribute__((ext_vector_type(4)));
typedef unsigned u32x4 __attribute__((ext_vector_type(4)));
constexpr int BM = 256, BK = 64, HALF = 128, HTB = HALF * BK * 2  , STAGE_BYTES = 8 * HTB, NXCD = 8, WGM = 8;

__host__ __device__ __forceinline__ int lds_byte(int r, int c) { const int st = (r >> 4) * 2 + (c >> 5), rr = r & 15, cc = c & 31, ob = rr * 64 + cc * 2; return st * 1024 + (ob ^ (((ob >> 9) & 1) << 5)); }
__host__ __device__ __forceinline__ void stage_rc(int b, int& R, int& C) { const int st = b / 1024, sb = b % 1024, swz = sb ^ (((sb >> 9) & 1) << 5); R = (st >> 1) * 16 + swz / 64; C = (st & 1) * 32 + (swz % 64) / 2; }
__host__ __device__ __forceinline__ int perm32(int rho) { const int n = rho >> 4, i = rho & 15; return 8 * (i >> 2) + 4 * n + (i & 3); }

struct Unit { int pm, pn; };
struct Gemm { const bf16_t* A; const bf16_t* Bt; int M, N, K; };

struct StaticOrder {
    int nM, nN, nwg, G, c;
    __host__ __device__ void init(int M, int N, int G_, int c_) { nM = M / BM; nN = N / BM; nwg = nM * nN; G = G_; c = c_; }
    __host__ __device__ bool next(int i, Unit& u) const {
        const long L = (long)i * G + c; if (L >= nwg) return false;
        int wgid = (int)L; { const int q = nwg / NXCD, r = nwg % NXCD, xcd = wgid % NXCD, off = wgid / NXCD; wgid = (xcd < r ? xcd * (q + 1) : r * (q + 1) + (xcd - r) * q) + off; }
        const int nig = WGM * nN, gid = wgid / nig, fm = gid * WGM, gsz = (nM - fm) < WGM ? (nM - fm) : WGM;
        u.pm = fm + ((wgid % nig) % gsz); u.pn = (wgid % nig) / gsz; return true;
    }
    __device__ __forceinline__ void a_ready(const Unit&) const {}
    __device__ __forceinline__ void done(const Unit&) const {}
};
template <class Epi, class Sched, bool STAMP = false>
__device__ __forceinline__ void gemm_phase(PG8_LAS unsigned char* lds, const Gemm g, const Sched& S, const Epi& E, unsigned long long* stamps) {
    const int tid = threadIdx.x, wid = __builtin_amdgcn_readfirstlane(tid >> 6), lane = tid & 63, wr = wid >> 2, wc = wid & 3, fr = lane & 15, fq = lane >> 4;
    const int K = g.K, nt = K / BK;
    int ts_lo = 0, ts_hi = 0, nts = 0; const unsigned long long rt_entry = STAMP ? (unsigned long long)wall_clock64() : 0ull;
#define PG8_STAMP() do { if (STAMP && wid == 0 && nts < 64) { const unsigned long long _c = (unsigned long long)clock64(); \
        ts_lo = (lane == nts) ? (int)(unsigned)_c : ts_lo; ts_hi = (lane == nts) ? (int)(unsigned)(_c >> 32) : ts_hi; ++nts; } } while (0)
    PG8_STAMP();
    unsigned voffA[2], voffB[2];
#pragma unroll
    for (int i = 0; i < 2; ++i) { int R, C; stage_rc(tid * 16 + i * 8192, R, C); const int Rb = Epi::PERM ? ((R & ~31) + perm32(R & 31)) : R;
        voffA[i] = (unsigned)(R * K + C) * 2u; voffB[i] = (unsigned)(Rb * K + C) * 2u; }
    const size_t kstep = (size_t)(BK * 2);
    const size_t hstep = (size_t)HALF * K * 2;
    const size_t tstep = 2 * hstep;
    const unsigned ldsw = (unsigned)wid * 1024u;
    const int aoff = lds_byte(wr * 64 + fr, fq * 8), boff = lds_byte(wc * 32 + fr, fq * 8);
#define PG8_SA(b, h) (((b) * 2 + (h)) * HTB)
#define PG8_SB(b, h) ((4 + (b) * 2 + (h)) * HTB)
#define PG8_STAGE(bufoff, gbase, voff) do { _Pragma("unroll") for (int _i = 0; _i < 2; ++_i) \
        __builtin_amdgcn_global_load_lds((const unsigned*)((const char*)(gbase) + (voff)[_i]), (PG8_LAS unsigned*)(lds + (bufoff) + ldsw + _i * 8192), 16, 0, 0); } while (0)
#define PG8_LDA(dst, b, h) do { _Pragma("unroll") for (int m = 0; m < 4; ++m) _Pragma("unroll") for (int k = 0; k < 2; ++k) dst[m][k] = *(const PG8_LAS bf16x8*)(lds + PG8_SA(b, h) + aoff + m * 2048 + k * 1024); } while (0)
#define PG8_LDB(dst, b, h) do { _Pragma("unroll") for (int n = 0; n < 2; ++n) _Pragma("unroll") for (int k = 0; k < 2; ++k) dst[n][k] = *(const PG8_LAS bf16x8*)(lds + PG8_SB(b, h) + boff + n * 2048 + k * 1024); } while (0)
#define PG8_MMA(ai, bj, At, Bt) do { __builtin_amdgcn_s_setprio(1); _Pragma("unroll") for (int m = 0; m < 4; ++m) _Pragma("unroll") for (int n = 0; n < 2; ++n) _Pragma("unroll") for (int k = 0; k < 2; ++k) \
        acc[ai][bj][m][n] = __builtin_amdgcn_mfma_f32_16x16x32_bf16(Bt[n][k], At[m][k], acc[ai][bj][m][n], 0, 0, 0); __builtin_amdgcn_s_setprio(0); } while (0)
#define PG8_WAIT_V(n) asm volatile("s_waitcnt vmcnt(" #n ")" ::: "memory")
#define PG8_WAIT_L(n) asm volatile("s_waitcnt lgkmcnt(" #n ")" ::: "memory")
#define PG8_BAR __builtin_amdgcn_s_barrier()
#define PG8_SCHED __builtin_amdgcn_sched_barrier(0)
    Unit cur, nxt; int ui = 0;
    if (!S.next(0, cur)) return;
    f32x4 acc[2][2][4][2];
#pragma unroll
    for (int a = 0; a < 2; ++a)
#pragma unroll
        for (int b = 0; b < 2; ++b)
#pragma unroll
            for (int m = 0; m < 4; ++m)
#pragma unroll
                for (int n = 0; n < 2; ++n) acc[a][b][m][n] = (f32x4){0.f, 0.f, 0.f, 0.f};
    bf16x8 At[4][2], B0[2][2], B1[2][2];
    const char* cA = (const char*)g.A + (size_t)cur.pm * tstep; const char* cB = (const char*)g.Bt + (size_t)cur.pn * tstep;
    S.a_ready(cur);
    PG8_STAGE(PG8_SB(0, 0), cB, voffB); PG8_STAGE(PG8_SA(0, 0), cA, voffA); PG8_STAGE(PG8_SB(0, 1), cB + hstep, voffB); PG8_STAGE(PG8_SA(0, 1), cA + hstep, voffA);
    if (wr == 1) PG8_BAR;
    PG8_WAIT_V(4); PG8_BAR;
    PG8_STAGE(PG8_SB(1, 0), cB + kstep, voffB); PG8_STAGE(PG8_SA(1, 0), cA + kstep, voffA); PG8_STAGE(PG8_SB(1, 1), cB + hstep + kstep, voffB);
    PG8_WAIT_V(6); PG8_BAR;
    PG8_STAMP();
    for (;;) {
        const bool has_next = S.next(ui + 1, nxt);
        const char* nA = has_next ? (const char*)g.A + (size_t)nxt.pm * tstep : cA; const char* nB = has_next ? (const char*)g.Bt + (size_t)nxt.pn * tstep : cB;
        for (int t = 0; t < nt; t += 2) {
            const bool last = (t == nt - 2);
            const char* a1 = cA + (size_t)(t + 1) * kstep;
            const char* a2 = last ? nA : cA + (size_t)(t + 2) * kstep; const char* b2 = last ? nB : cB + (size_t)(t + 2) * kstep;
            const char* a3 = a2 + kstep; const char* b3 = b2 + kstep;
            if (last && has_next) S.a_ready(nxt);
            PG8_LDB(B0, 0, 0); PG8_SCHED; PG8_LDA(At, 0, 0); PG8_STAGE(PG8_SA(1, 1), a1 + hstep, voffA);
            PG8_WAIT_L(8); PG8_BAR; PG8_WAIT_L(0); PG8_MMA(0, 0, At, B0); PG8_BAR; PG8_SCHED;
            PG8_LDB(B1, 0, 1); PG8_STAGE(PG8_SB(0, 0), b2, voffB);
            PG8_BAR; PG8_WAIT_L(0); PG8_MMA(0, 1, At, B1); PG8_BAR;
            PG8_LDA(At, 0, 1); PG8_STAGE(PG8_SA(0, 0), a2, voffA);
            PG8_BAR; PG8_WAIT_L(0); PG8_MMA(1, 0, At, B0); PG8_BAR; PG8_SCHED;
            PG8_STAGE(PG8_SB(0, 1), b2 + hstep, voffB);
            PG8_WAIT_V(6); PG8_BAR; PG8_MMA(1, 1, At, B1); PG8_BAR;
            PG8_LDB(B0, 1, 0); PG8_SCHED; PG8_LDA(At, 1, 0); PG8_STAGE(PG8_SA(0, 1), a2 + hstep, voffA);
            PG8_WAIT_L(8); PG8_BAR; PG8_WAIT_L(0); PG8_MMA(0, 0, At, B0); PG8_BAR; PG8_SCHED;
            PG8_LDB(B1, 1, 1); PG8_STAGE(PG8_SB(1, 0), b3, voffB);
            PG8_BAR; PG8_WAIT_L(0); PG8_MMA(0, 1, At, B1); PG8_BAR;
            PG8_LDA(At, 1, 1); PG8_STAGE(PG8_SA(1, 0), a3, voffA);
            PG8_BAR; PG8_WAIT_L(0); PG8_MMA(1, 0, At, B0); PG8_BAR; PG8_SCHED;
            PG8_STAGE(PG8_SB(1, 1), b3 + hstep, voffB);
            PG8_WAIT_V(6); PG8_BAR; PG8_MMA(1, 1, At, B1); PG8_BAR;
        }
        PG8_STAMP();
        if constexpr (!Epi::AFTER_DRAIN) { E(acc, cur, wr, wc, fr, fq); S.done(cur); }
        PG8_STAMP();
        if (!has_next) break;
#pragma unroll
        for (int a = 0; a < 2; ++a)
#pragma unroll
            for (int b = 0; b < 2; ++b)
#pragma unroll
                for (int m = 0; m < 4; ++m)
#pragma unroll
                    for (int n = 0; n < 2; ++n) acc[a][b][m][n] = (f32x4){0.f, 0.f, 0.f, 0.f};
        cur = nxt; cA = nA; cB = nB; ++ui;
    }
    PG8_WAIT_V(0);
    if (wr == 0) PG8_BAR;
    PG8_BAR;
    if constexpr (Epi::AFTER_DRAIN) { E.fused(acc, cur, wr, wc, fr, fq, lds, wid, lane); S.done(cur); }
    PG8_STAMP();
    if (STAMP && wid == 0) { stamps[lane] = lane < nts ? (((unsigned long long)(unsigned)ts_hi << 32) | (unsigned)ts_lo) : 0ull;
        if (lane == 62) stamps[62] = rt_entry; if (lane == 63) stamps[63] = (unsigned long long)wall_clock64(); }
#undef PG8_STAMP
#undef PG8_SA
#undef PG8_SB
#undef PG8_STAGE
#undef PG8_LDA
#undef PG8_LDB
#undef PG8_MMA
#undef PG8_WAIT_V
#undef PG8_WAIT_L
#undef PG8_BAR
#undef PG8_SCHED
}
}

template <int MI, int BK = 64, int NI = 2, int WR = 4, bool TR = false>
__device__ __forceinline__ void gemm_mainloop(f32x16 (&acc)[MI][NI], const bf16_t* __restrict__ A, int lda, const bf16_t* __restrict__ Bt, int ldb, int K, unsigned char* lds) {
    constexpr int WC = 8 / WR;
    constexpr int BM = 32 * MI * WR, BN = 32 * NI * WC;
    constexpr int RS = (BK + 8) * 2;
    constexpr int VPR = BK / 8;
    constexpr int RPP = NT / VPR;
    constexpr int NA = BM / RPP, NB = BN / RPP;
    constexpr int ABYTES = BM * RS, BBYTES = BN * RS, STAGE = ABYTES + BBYTES;
    static_assert(NA >= 2 && NA <= 4 && NB >= 2 && NB <= 4 && BM % RPP == 0 && BN % RPP == 0, "tile config");
    const int tid = tid_opaque(), lane = tid & 63, wid = tid >> 6, wr = wid / WC, wc = wid % WC;
    const int lr = tid / VPR, lk = tid % VPR;
    uint4 ra0, ra1, ra2, ra3, rb0, rb1, rb2, rb3;
    const bf16_t* Ap = A + (size_t)lr * lda + lk * 8;
    const bf16_t* Bp = Bt + (size_t)lr * ldb + lk * 8;
    const int nk = K / BK;
    const int wo = lr * RS + lk * 16;
#define G_LOAD(k0) { ra0 = *(const uint4*)(Ap + (k0)); ra1 = *(const uint4*)(Ap + (size_t)RPP * lda + (k0)); \
        if (NA >= 3) ra2 = *(const uint4*)(Ap + (size_t)(2 * RPP) * lda + (k0)); \
        if (NA >= 4) ra3 = *(const uint4*)(Ap + (size_t)(3 * RPP) * lda + (k0)); \
        rb0 = *(const uint4*)(Bp + (k0)); rb1 = *(const uint4*)(Bp + (size_t)RPP * ldb + (k0)); \
        if (NB >= 3) rb2 = *(const uint4*)(Bp + (size_t)(2 * RPP) * ldb + (k0)); \
        if (NB >= 4) rb3 = *(const uint4*)(Bp + (size_t)(3 * RPP) * ldb + (k0)); }
#define S_STORE(buf) { *(uint4*)((buf) + wo) = ra0; *(uint4*)((buf) + wo + RPP * RS) = ra1; \
        if (NA >= 3) *(uint4*)((buf) + wo + 2 * RPP * RS) = ra2; \
        if (NA >= 4) *(uint4*)((buf) + wo + 3 * RPP * RS) = ra3; \
        *(uint4*)((buf) + ABYTES + wo) = rb0; *(uint4*)((buf) + ABYTES + wo + RPP * RS) = rb1; \
        if (NB >= 3) *(uint4*)((buf) + ABYTES + wo + 2 * RPP * RS) = rb2; \
        if (NB >= 4) *(uint4*)((buf) + ABYTES + wo + 3 * RPP * RS) = rb3; }
    ra2 = ra3 = rb2 = rb3 = make_uint4(0, 0, 0, 0);
    __syncthreads();
    G_LOAD(0)
    S_STORE(lds)
    __syncthreads();
    const int aoff = (wr * 32 * MI + (lane & 31)) * RS + (lane >> 5) * 16;
    const int boff = ABYTES + (wc * 32 * NI + (lane & 31)) * RS + (lane >> 5) * 16;
#pragma unroll 1
    for (int kt = 0; kt < nk; ++kt) {
        unsigned char* cur = lds + (kt & 1) * STAGE;
        unsigned char* nxt = lds + ((kt + 1) & 1) * STAGE;
        const bool more = (kt + 1 < nk);
        if (more) { const int k0 = (kt + 1) * BK; G_LOAD(k0) }
#pragma unroll
        for (int ks = 0; ks < BK / 16; ++ks) {
            bf16x8 af[MI], bfr[NI];
#pragma unroll
            for (int mi = 0; mi < MI; ++mi) af[mi] = *(const bf16x8*)(cur + aoff + mi * 32 * RS + ks * 32);
#pragma unroll
            for (int ni = 0; ni < NI; ++ni) bfr[ni] = *(const bf16x8*)(cur + boff + ni * 32 * RS + ks * 32);
#pragma unroll
            for (int mi = 0; mi < MI; ++mi)
#pragma unroll
                for (int ni = 0; ni < NI; ++ni)
                    acc[mi][ni] = TR ? __builtin_amdgcn_mfma_f32_32x32x16_bf16(bfr[ni], af[mi], acc[mi][ni], 0, 0, 0)
                                     : __builtin_amdgcn_mfma_f32_32x32x16_bf16(af[mi], bfr[ni], acc[mi][ni], 0, 0, 0);
        }
        if (more) S_STORE(nxt)
        __syncthreads();
    }
#undef G_LOAD
#undef S_STORE
}

template <int MI, int NI = 2>
__device__ __forceinline__ void zero_acc(f32x16 (&acc)[MI][NI]) {
#pragma unroll
    for (int mi = 0; mi < MI; ++mi)
#pragma unroll
        for (int ni = 0; ni < NI; ++ni)
#pragma unroll
            for (int r = 0; r < 16; ++r) acc[mi][ni][r] = 0.f;
}

template <int MI, int NI = 2, int WR = 4, class F>
__device__ __forceinline__ void for_each_acc(f32x16 (&acc)[MI][NI], int row0, int col0, F f) {
    constexpr int WC = 8 / WR;
    const int lane = tid_opaque() & 63, wid = tid_opaque() >> 6, wr = wid / WC, wc = wid % WC;
#pragma unroll
    for (int mi = 0; mi < MI; ++mi)
#pragma unroll
        for (int ni = 0; ni < NI; ++ni) {
            const int col = col0 + wc * 32 * NI + ni * 32 + (lane & 31);
            const int rb = row0 + wr * 32 * MI + mi * 32 + 4 * (lane >> 5);
#pragma unroll
            for (int r = 0; r < 16; ++r) { float v = acc[mi][ni][r]; f(rb + (r & 3) + 8 * (r >> 2), col, v); acc[mi][ni][r] = v; }
        }
}

template <int MI, int NI = 2, int WR = 4, class F>
__device__ __forceinline__ void for_each_acc4(f32x16 (&acc)[MI][NI], int row0, int col0, F f) {
    constexpr int WC = 8 / WR;
    const int lane = tid_opaque() & 63, wid = tid_opaque() >> 6, wr = wid / WC, wc = wid % WC;
#pragma unroll
    for (int mi = 0; mi < MI; ++mi)
#pragma unroll
        for (int ni = 0; ni < NI; ++ni) {
            const int row = row0 + wr * 32 * MI + mi * 32 + (lane & 31);
            const int cb = col0 + wc * 32 * NI + ni * 32 + 4 * (lane >> 5);
#pragma unroll
            for (int g = 0; g < 4; ++g) {
                float4 v = make_float4(acc[mi][ni][4 * g], acc[mi][ni][4 * g + 1], acc[mi][ni][4 * g + 2], acc[mi][ni][4 * g + 3]);
                f(row, cb + 8 * g, v);
                acc[mi][ni][4 * g] = v.x; acc[mi][ni][4 * g + 1] = v.y; acc[mi][ni][4 * g + 2] = v.z; acc[mi][ni][4 * g + 3] = v.w;
            }
        }
}
__device__ __forceinline__ float4 bf4_to_f4(uint2 u) { return make_float4(__uint_as_float(u.x << 16), __uint_as_float(u.x & 0xffff0000u), __uint_as_float(u.y << 16), __uint_as_float(u.y & 0xffff0000u)); }
__device__ __forceinline__ uint2 f4_to_bf4(float4 v) { return make_uint2(pk2(v.x, v.y), pk2(v.z, v.w)); }

template <class F>
__device__ __forceinline__ void for_tiles(int n_mt, int n_nt, F f) {
    const int G = gridDim.x, b = blockIdx.x;
    const bool ok = ((G & 7) == 0) && ((n_mt & 7) == 0);
    const int xcd = ok ? (b & 7) : 0, mul = ok ? 8 : 1, mpx = ok ? (n_mt >> 3) : n_mt;
    const int t0 = ok ? (b >> 3) : b, tstep = ok ? (G >> 3) : G, ntot = mpx * n_nt;
#pragma unroll 1
    for (int t = t0; t < ntot; t += tstep) f(xcd + mul * (t % mpx), t / mpx);
}

__device__ __forceinline__ const float* xrow(const Params& p, int t) { return t < TP ? p.in[0] + (size_t)t * 1024 : p.in[1] + (size_t)(t - TP) * 1024; }
__device__ __forceinline__ int modidx(int t) { return t < TP ? 0 : 1 + ((t - TP) >> 11); }

__device__ __forceinline__ void transpose_tile(const Params& p, int tI, unsigned char* lds) {
    const int tid = tid_opaque();
    const float* src; bf16_t* dst; int K, N;
    if (tI < 2064) { src = p.in[9]; dst = (bf16_t*)(p.ws + WS_WIN); K = 1024; N = 8256; }
    else if (tI < 2320) { tI -= 2064; src = p.in[10]; dst = (bf16_t*)(p.ws + WS_WF); K = 1024; N = 1024; }
    else if (tI < 2832) { tI -= 2320; src = p.in[17]; dst = (bf16_t*)(p.ws + WS_WSO); K = 2048; N = 1024; }
    else if (tI < 3088) { tI -= 2832; src = p.in[18]; dst = (bf16_t*)(p.ws + WS_WO); K = 1024; N = 1024; }
    else if (tI < 4112) { tI -= 3088; src = p.in[20]; dst = (bf16_t*)(p.ws + WS_W1); K = 1024; N = 4096; }
    else { tI -= 4112; src = p.in[21]; dst = (bf16_t*)(p.ws + WS_W2); K = 4096; N = 1024; }
    const int nkt = K >> 6; const int k0 = (tI % nkt) * 64, n0 = (tI / nkt) * 64;
    bf16_t* ts = (bf16_t*)lds;
    __syncthreads();
#pragma unroll
    for (int i = 0; i < 2; ++i) { const int idx = tid + i * NT, kr = idx >> 4, nv = idx & 15;
        const float4 v = *(const float4*)(src + (size_t)(k0 + kr) * N + n0 + nv * 4);
        ts[(nv * 4 + 0) * 72 + kr] = f2bf(v.x); ts[(nv * 4 + 1) * 72 + kr] = f2bf(v.y); ts[(nv * 4 + 2) * 72 + kr] = f2bf(v.z); ts[(nv * 4 + 3) * 72 + kr] = f2bf(v.w); }
    __syncthreads();
    { const int n = tid >> 3, kv = tid & 7; *(uint4*)(dst + (size_t)(n0 + n) * K + k0 + kv * 8) = *(const uint4*)(ts + n * 72 + kv * 8); }
}

__device__ __forceinline__ void phase_prep(const Params& p, unsigned char* lds) {
    const int tid = tid_opaque();
    float* mod = (float*)(p.ws + WS_MOD);
    const bool defer = (gridDim.x == 256);
    constexpr int N_GEMV = 192, N_TR = 5136, N_ZERO = 1, N_TAB = 32 + 32 + 2048;
    constexpr int NITEMS = N_GEMV + N_TR + N_ZERO + N_TAB;
    for (int item = blockIdx.x; item < NITEMS; item += gridDim.x) {
        if (item < N_GEMV) {
            float* sv = (float*)lds;
            float* part = sv + 3072;
            __syncthreads();
            for (int i = tid; i < 3072; i += NT) { const int r = i >> 10, k = i & 1023; const float v = (r == 0) ? p.in[5][k] : p.in[4][(r - 1) * 1024 + k]; sv[i] = siluf(v); }
            __syncthreads();
            const int col = tid & 31, kq = tid >> 5, col0 = item * 32;
            const float* w = p.in[6] + (size_t)(kq * 64) * 6144 + col0 + col;
            float a0 = 0.f, a1 = 0.f, a2 = 0.f;
#pragma unroll 16
            for (int k = 0; k < 64; ++k) { const float wv = w[(size_t)k * 6144]; const int kk = kq * 64 + k; a0 += sv[kk] * wv; a1 += sv[1024 + kk] * wv; a2 += sv[2048 + kk] * wv; }
            part[(kq * 3 + 0) * 32 + col] = a0; part[(kq * 3 + 1) * 32 + col] = a1; part[(kq * 3 + 2) * 32 + col] = a2;
            __syncthreads();
            if (tid < 96) { const int r = tid >> 5, c = tid & 31; float s = p.in[7][col0 + c];
                for (int q = 0; q < 16; ++q) s += part[(q * 3 + r) * 32 + c];
                mod[r * 6144 + col0 + c] = s; }
        } else if (item < N_GEMV + N_TR) {
            const int tI = item - N_GEMV;
            if (defer && tI >= 2832) continue;
            transpose_tile(p, tI, lds);
        } else if (item < N_GEMV + N_TR + N_ZERO) {
            uint4* d = (uint4*)(p.ws + WS_WIN + (size_t)8256 * 1024 * 2);
            for (int i = tid; i < 64 * 1024 * 2 / 16; i += NT) d[i] = make_uint4(0, 0, 0, 0);
        } else {
            const int tb = item - (N_GEMV + N_TR + N_ZERO);
            unsigned pk[4];
            bf16_t* dst; size_t e0;
            if (tb < 32) { dst = (bf16_t*)(p.ws + WS_CSC); e0 = (size_t)tb * 4096 + tid * 8;
#pragma unroll
                for (int j = 0; j < 8; j += 2) { float v[2];
                    for (int u = 0; u < 2; ++u) { const int e = (int)e0 + j + u, m = e >> 8, k = e & 255, cs = m >> 8, chp = m & 255; const float ang = (float)((chp * k) & 255) * (1.f / 128.f);
                        v[u] = (cs == 0 ? cospif(ang) : sinpif(ang)) * 0.0625f; }
                    pk[j >> 1] = pk2(v[0], v[1]); }
            } else if (tb < 64) { dst = (bf16_t*)(p.ws + WS_A256); e0 = (size_t)(tb - 32) * 4096 + tid * 8;
#pragma unroll
                for (int j = 0; j < 8; j += 2) { float v[2];
                    for (int u = 0; u < 2; ++u) { const int e = (int)e0 + j + u, lp = e >> 9, kk = e & 511, cs = kk >> 8, l = kk & 255; const float ang = (float)((lp * l) & 255) * (1.f / 128.f);
                        v[u] = (cs == 0 ? cospif(ang) : -sinpif(ang)) * 0.0625f; }
                    pk[j >> 1] = pk2(v[0], v[1]); }
            } else { dst = (bf16_t*)((unsigned char*)p.out + DO_APOS); e0 = (size_t)(tb - 64) * 4096 + tid * 8;
#pragma unroll
                for (int j = 0; j < 8; j += 2) { float v[2];
                    for (int u = 0; u < 2; ++u) { const int e = (int)e0 + j + u, lp = e >> 12, kk = e & 4095, cs = kk >> 11, l = kk & 2047;
                        const int r = l >> 6, c = l & 63, rp = lp >> 6, cp = lp & 63; const float ang = (float)((2 * r * rp + c * cp) & 63) * (1.f / 32.f);
                        v[u] = (cs == 0 ? cospif(ang) : -sinpif(ang)) * 0.02209708691f; }
                    pk[j >> 1] = pk2(v[0], v[1]); }
            }
            *(uint4*)(dst + e0) = make_uint4(pk[0], pk[1], pk[2], pk[3]);
        }
    }
}

__device__ __forceinline__ void phase_norm(const Params& p, int which) {
    const int lane = tid_opaque() & 63, wid = tid_opaque() >> 6;
    const float* mod = (const float*)(p.ws + WS_MOD);
    const float* g = which == 0 ? p.in[8] : (which == 1 ? p.in[19] : p.in[22]);
    bf16_t* dst = which == 0 ? (bf16_t*)((unsigned char*)p.out + DO_H1) : (bf16_t*)(p.ws + WS_H2);
    for (int t0 = (blockIdx.x * 8 + wid) * 2; t0 < T; t0 += gridDim.x * 16) {
        float4 v[2][4]; float ss[2] = {0.f, 0.f};
#pragma unroll
        for (int u = 0; u < 2; ++u) { const int t = t0 + u; const float* src = which == 2 ? p.out + (size_t)t * 1024 : xrow(p, t);
#pragma unroll
            for (int i = 0; i < 4; ++i) v[u][i] = *(const float4*)(src + i * 256 + lane * 4);
            if (which != 0) {
                const bf16_t* rr = (const bf16_t*)(p.ws + WS_R) + (size_t)t * 1024;
#pragma unroll
                for (int i = 0; i < 4; ++i) { const float4 r = bf4_to_f4(*(const uint2*)(rr + i * 256 + lane * 4));
                    v[u][i].x += r.x; v[u][i].y += r.y; v[u][i].z += r.z; v[u][i].w += r.w; }
                if (which == 1) {
#pragma unroll
                    for (int i = 0; i < 4; ++i) *(float4*)(p.out + (size_t)t * 1024 + i * 256 + lane * 4) = v[u][i];
                }
            } }
#pragma unroll
        for (int u = 0; u < 2; ++u) {
#pragma unroll
            for (int i = 0; i < 4; ++i) ss[u] += v[u][i].x * v[u][i].x + v[u][i].y * v[u][i].y + v[u][i].z * v[u][i].z + v[u][i].w * v[u][i].w;
#pragma unroll
            for (int o = 32; o > 0; o >>= 1) ss[u] += __shfl_xor(ss[u], o);
        }
#pragma unroll
        for (int u = 0; u < 2; ++u) {
            const int t = t0 + u;
            const float rstd = rsqrtf(ss[u] * (1.f / 1024.f) + 1e-6f);
            if (which == 2) {
#pragma unroll
                for (int i = 0; i < 4; ++i) { const int c = i * 256 + lane * 4; const float4 gg = *(const float4*)(g + c);
                    float4 o; o.x = v[u][i].x * rstd * gg.x; o.y = v[u][i].y * rstd * gg.y; o.z = v[u][i].z * rstd * gg.z; o.w = v[u][i].w * rstd * gg.w;
                    *(float4*)(p.out + (size_t)t * 1024 + c) = o; }
            } else {
                const float* mrow = mod + modidx(t) * 6144 + (which == 0 ? 0 : 3072);
#pragma unroll
                for (int i = 0; i < 4; ++i) { const int c = i * 256 + lane * 4; const float4 gg = *(const float4*)(g + c);
                    const float4 sh = *(const float4*)(mrow + c), sc = *(const float4*)(mrow + 1024 + c);
                    const float o0 = v[u][i].x * rstd * gg.x * (1.f + sc.x) + sh.x, o1 = v[u][i].y * rstd * gg.y * (1.f + sc.y) + sh.y;
                    const float o2 = v[u][i].z * rstd * gg.z * (1.f + sc.z) + sh.z, o3 = v[u][i].w * rstd * gg.w * (1.f + sc.w) + sh.w;
                    *(uint2*)(dst + (size_t)t * 1024 + c) = make_uint2(pk2(o0, o1), pk2(o2, o3)); }
            }
        }
    }
}

struct EpiInProj {
    static constexpr bool PERM = true, AFTER_DRAIN = false;
    bf16_t* uf; bf16_t* zs; bf16_t* xbc; float* dtb; bf16_t* gates; const float* dt_bias;
    __device__ __forceinline__ void operator()(const pg8::f32x4 (&acc)[2][2][4][2], const pg8::Unit& u, int wr, int wc, int fr, int fq) const {
#pragma unroll
        for (int bj = 0; bj < 2; ++bj) {
            const int cb = __builtin_amdgcn_readfirstlane(u.pn * 256 + bj * 128 + wc * 32);
            const int rbase = u.pm * 256 + wr * 64 + fr;
            if (cb >= 6144 && cb < 6208) {
                const int j = cb - 6144 + 8 * fq;
                const float4 b0 = *(const float4*)(dt_bias + j), b1 = *(const float4*)(dt_bias + j + 4);
#pragma unroll
                for (int ai = 0; ai < 2; ++ai)
#pragma unroll
                    for (int m = 0; m < 4; ++m) {
                        const pg8::f32x4 v0 = acc[ai][bj][m][0], v1 = acc[ai][bj][m][1];
                        float x[8] = {v0[0] + b0.x, v0[1] + b0.y, v0[2] + b0.z, v0[3] + b0.w, v1[0] + b1.x, v1[1] + b1.y, v1[2] + b1.z, v1[3] + b1.w};
#pragma unroll
                        for (int e = 0; e < 8; ++e) x[e] = x[e] > 20.f ? x[e] : log1pf(__expf(x[e]));
                        float* d = dtb + (size_t)(rbase + ai * 128 + m * 16) * 64 + j;
                        *(float4*)d = make_float4(x[0], x[1], x[2], x[3]); *(float4*)(d + 4) = make_float4(x[4], x[5], x[6], x[7]);
                    }
            } else {
                bf16_t* dst; int ld, c0; bool sg = false;
                if (cb < 1024) { dst = uf; ld = 1024; c0 = cb; }
                else if (cb < 3072) { dst = zs; ld = 2048; c0 = cb - 1024; }
                else if (cb < 6144) { dst = xbc; ld = 3072; c0 = cb - 3072; }
                else { dst = gates; ld = 2048; c0 = cb - 6208; sg = true; }
                bf16_t* dp = dst + (size_t)rbase * ld + c0 + 8 * fq;
                if (sg) {
#pragma unroll
                    for (int ai = 0; ai < 2; ++ai)
#pragma unroll
                        for (int m = 0; m < 4; ++m) { const pg8::f32x4 v0 = acc[ai][bj][m][0], v1 = acc[ai][bj][m][1];
                            *(uint4*)(dp + (size_t)(ai * 128 + m * 16) * ld) = make_uint4(pk2(sigmf(v0[0]), sigmf(v0[1])), pk2(sigmf(v0[2]), sigmf(v0[3])), pk2(sigmf(v1[0]), sigmf(v1[1])), pk2(sigmf(v1[2]), sigmf(v1[3]))); }
                } else {
#pragma unroll
                    for (int ai = 0; ai < 2; ++ai)
#pragma unroll
                        for (int m = 0; m < 4; ++m) { const pg8::f32x4 v0 = acc[ai][bj][m][0], v1 = acc[ai][bj][m][1];
                            *(uint4*)(dp + (size_t)(ai * 128 + m * 16) * ld) = make_uint4(pk2(v0[0], v0[1]), pk2(v0[2], v0[3]), pk2(v1[0], v1[1]), pk2(v1[2], v1[3])); }
                }
            }
        }
    }
};

__device__ __forceinline__ void phase_inproj(const Params& p, unsigned char* lds) {
    const bf16_t* h1 = (const bf16_t*)((unsigned char*)p.out + DO_H1);
    const bf16_t* W = (const bf16_t*)(p.ws + WS_WIN);
    bf16_t* uf = (bf16_t*)((unsigned char*)p.out + DO_UF);
    bf16_t* zs = (bf16_t*)(p.ws + WS_ZS);
    bf16_t* xbc = (bf16_t*)(p.ws + WS_XBC);
    float* dtb = (float*)(p.ws + WS_DTB);
    bf16_t* gates = (bf16_t*)((unsigned char*)p.out + DO_GATES);
    const float* dt_bias = p.in[13];
    auto epi = [&](const f32x16& a, int rb, int cb, int lane) {
        if (cb >= 8256) return;
        if (cb >= 6144 && cb < 6208) {
            const int j = cb - 6144 + (lane & 31); const float bias = dt_bias[j];
#pragma unroll
            for (int r = 0; r < 16; ++r) { const float x = a[r] + bias; dtb[(size_t)(rb + (r & 3) + 8 * (r >> 2)) * 64 + j] = x > 20.f ? x : log1pf(__expf(x)); }
        } else {
            bf16_t* dst; int ld, c0; bool sg = false;
            if (cb < 1024) { dst = uf; ld = 1024; c0 = cb; }
            else if (cb < 3072) { dst = zs; ld = 2048; c0 = cb - 1024; }
            else if (cb < 6144) { dst = xbc; ld = 3072; c0 = cb - 3072; }
            else { dst = gates; ld = 2048; c0 = cb - 6208; sg = true; }
            bf16_t* dp = dst + (size_t)rb * ld + c0 + (lane & 31);
            if (sg) {
#pragma unroll
                for (int r = 0; r < 16; ++r) dp[(size_t)((r & 3) + 8 * (r >> 2)) * ld] = f2bf(sigmf(a[r]));
            } else {
#pragma unroll
                for (int r = 0; r < 16; ++r) dp[(size_t)((r & 3) + 8 * (r >> 2)) * ld] = f2bf(a[r]);
            }
        }
    };
    {
        pg8::Gemm g{h1, W, T, 8192, 1024};
        pg8::StaticOrder S; S.init(T, 8192, (int)gridDim.x, (int)blockIdx.x);
        EpiInProj E{uf, zs, xbc, dtb, gates, dt_bias};
        pg8::gemm_phase<EpiInProj, pg8::StaticOrder, false>((PG8_LAS unsigned char*)lds, g, S, E, nullptr);
    }
    for (int mt = (int)gridDim.x - 1 - (int)blockIdx.x; mt < 48; mt += gridDim.x) {
        f32x16 acc[2][2]; zero_acc<2>(acc);
        gemm_mainloop<2>(acc, h1 + (size_t)mt * 256 * 1024, 1024, W + (size_t)8192 * 1024, 1024, 1024, lds);
        const int lane = tid_opaque() & 63, wid = tid_opaque() >> 6, wr = wid >> 1, wc = wid & 1;
#pragma unroll
        for (int mi = 0; mi < 2; ++mi)
#pragma unroll
            for (int ni = 0; ni < 2; ++ni)
                epi(acc[mi][ni], mt * 256 + wr * 64 + mi * 32 + 4 * (lane >> 5), __builtin_amdgcn_readfirstlane(8192 + wc * 64 + ni * 32), lane);
    }
}

struct ConvPre { uint4 v0, v1, v2; float w; };
__device__ __forceinline__ void conv_prefetch(const Params& p, int item, int tid, ConvPre& r) {
    const int q = item / 48, sl = item % 48;
    const int sstart = q < 64 ? (q >> 1) * 256 : TP + ((q - 64) >> 4) * 2048;
    const int send = sstart + (q < 64 ? 256 : 2048);
    const int t0 = q * 128;
    const bf16_t* xbc = (const bf16_t*)(p.ws + WS_XBC);
    r.v0 = r.v1 = r.v2 = make_uint4(0, 0, 0, 0); r.w = 0.f;
    { const int idx = tid, row = idx >> 3, v = idx & 7; const int t = t0 - 2 + row; if (t >= sstart && t < send) r.v0 = *(const uint4*)(xbc + (size_t)t * 3072 + sl * 64 + v * 8); }
    { const int idx = tid + NT, row = idx >> 3, v = idx & 7; const int t = t0 - 2 + row; if (t >= sstart && t < send) r.v1 = *(const uint4*)(xbc + (size_t)t * 3072 + sl * 64 + v * 8); }
    { const int idx = tid + 2 * NT, row = idx >> 3, v = idx & 7; const int t = t0 - 2 + row; if (idx < 132 * 8 && t >= sstart && t < send) r.v2 = *(const uint4*)(xbc + (size_t)t * 3072 + sl * 64 + v * 8); }
    if (tid < 320) r.w = p.in[11][(tid >> 6) * 3072 + sl * 64 + (tid & 63)];
    else if (tid < 384) r.w = p.in[12][sl * 64 + (tid - 320)];
}

__device__ __forceinline__ void conv_item(const Params& p, int item, int next_item, ConvPre& pre, unsigned char* lds) {
    const int tid = tid_opaque();
    const int q = item / 48, sl = item % 48;
    bf16_t* sIn = (bf16_t*)lds;
    bf16_t* sOut = (bf16_t*)(lds + 132 * 144);
    float* sW = (float*)(lds + 132 * 144 + 128 * 144);
    __syncthreads();
    { const int idx = tid; *(uint4*)(sIn + (idx >> 3) * 72 + (idx & 7) * 8) = pre.v0; }
    { const int idx = tid + NT; *(uint4*)(sIn + (idx >> 3) * 72 + (idx & 7) * 8) = pre.v1; }
    { const int idx = tid + 2 * NT; if (idx < 132 * 8) *(uint4*)(sIn + (idx >> 3) * 72 + (idx & 7) * 8) = pre.v2; }
    if (tid < 384) sW[tid] = pre.w;
    if (next_item >= 0) conv_prefetch(p, next_item, tid, pre);
    __syncthreads();
    {
        const int j = tid >> 2, c0 = (tid & 3) * 16;
        float o[16];
#pragma unroll
        for (int c = 0; c < 16; ++c) o[c] = sW[320 + c0 + c];
#pragma unroll
        for (int k = 0; k < 5; ++k) {
            const uint4 a = *(const uint4*)(sIn + (j + k) * 72 + c0), b = *(const uint4*)(sIn + (j + k) * 72 + c0 + 8);
            const unsigned w[8] = {a.x, a.y, a.z, a.w, b.x, b.y, b.z, b.w};
#pragma unroll
            for (int u = 0; u < 8; ++u) { o[2 * u] += sW[k * 64 + c0 + 2 * u] * __uint_as_float(w[u] << 16); o[2 * u + 1] += sW[k * 64 + c0 + 2 * u + 1] * __uint_as_float(w[u] & 0xffff0000u); }
        }
        unsigned pk[8];
#pragma unroll
        for (int u = 0; u < 8; ++u) pk[u] = pk2(siluf(o[2 * u]), siluf(o[2 * u + 1]));
        *(uint4*)(sOut + j * 72 + c0) = make_uint4(pk[0], pk[1], pk[2], pk[3]);
        *(uint4*)(sOut + j * 72 + c0 + 8) = make_uint4(pk[4], pk[5], pk[6], pk[7]);
    }
    __syncthreads();
    if (sl >= 32) {
        const int s2 = sl - 32, isC = s2 >= 8, g = (s2 & 7) >> 1, nh = s2 & 1;
        bf16_t* dst = (bf16_t*)(p.ws + (isC ? WS_CM : WS_BM)) + (size_t)(q * 4 + g) * 128 * 128 + nh * 64;
#pragma unroll
        for (int i = 0; i < 2; ++i) { const int idx = tid + i * NT, j = idx >> 3, v = idx & 7; *(uint4*)(dst + (size_t)j * 128 + v * 8) = *(const uint4*)(sOut + j * 72 + v * 8); }
    }
    if (sl < 40) {
        bf16_t* dst;
        if (sl < 32) dst = (bf16_t*)(p.ws + WS_XT) + (size_t)(q * 32 + sl) * 64 * 128;
        else { const int s2 = sl - 32; dst = (bf16_t*)(p.ws + WS_BT) + (size_t)(q * 4 + (s2 >> 1)) * 128 * 128 + (size_t)(s2 & 1) * 64 * 128; }
        const int ch = tid >> 3, jv = tid & 7;
#pragma unroll
        for (int i = 0; i < 2; ++i) { const int j0 = jv * 8 + i * 64; unsigned pk[4];
#pragma unroll
            for (int u = 0; u < 4; ++u) pk[u] = (unsigned)sOut[(j0 + 2 * u) * 72 + ch] | ((unsigned)sOut[(j0 + 2 * u + 1) * 72 + ch] << 16);
            *(uint4*)(dst + (size_t)ch * 128 + j0) = make_uint4(pk[0], pk[1], pk[2], pk[3]); }
    }
}

__device__ __forceinline__ void phase_conv_f1(const Params& p, unsigned char* lds) {
    const bf16_t* csc = (const bf16_t*)(p.ws + WS_CSC);
    const bf16_t* uf = (const bf16_t*)((unsigned char*)p.out + DO_UF);
    (void)csc; (void)uf;
    ConvPre pre;
    int item = blockIdx.x;
    if (item < 96 * 48) conv_prefetch(p, item, tid_opaque(), pre);
#pragma unroll 1
    for (; item < 96 * 48; item += gridDim.x) {
        const int nxt = item + (int)gridDim.x;
        conv_item(p, item, nxt < 96 * 48 ? nxt : -1, pre, lds);
    }
}

__device__ __forceinline__ void phase_f1(const Params& p, unsigned char* lds) {
    const bf16_t* csc = (const bf16_t*)(p.ws + WS_CSC);
    const bf16_t* uf = (const bf16_t*)((unsigned char*)p.out + DO_UF);
    bf16_t* z1p = (bf16_t*)(p.ws + WS_Z1P);
    bf16_t* z1s = (bf16_t*)(p.ws + WS_Z1S);
    for (int id = blockIdx.x; id < 768; id += gridDim.x) {
        const int g = id / 192, rem = id % 192, mt = rem / 96, nt = rem % 96;
        f32x16 acc[2][2]; zero_acc<2>(acc);
        gemm_mainloop<2>(acc, csc + (size_t)mt * 256 * 256, 256, uf + (size_t)nt * 128 * 1024 + g * 256, 1024, 256, lds);
        for_each_acc<2>(acc, 0, nt * 128, [&](int chp, int t, float& v) {
            if (t < TP) { const int b = t >> 8, l = t & 255; z1p[((size_t)(b * 4 + g) * 256 + chp) * 512 + mt * 256 + l] = f2bf(v); }
            else { const int ts = t - TP, b = ts >> 11, l = ts & 2047; z1s[((size_t)(b * 4 + g) * 256 + chp) * 4096 + mt * 2048 + l] = f2bf(v); }
        });
    }
}

__device__ __forceinline__ void phase_f2(const Params& p, unsigned char* lds) {
    const bf16_t* a256 = (const bf16_t*)(p.ws + WS_A256);
    const bf16_t* apos = (const bf16_t*)((unsigned char*)p.out + DO_APOS);
    const bf16_t* z1p = (const bf16_t*)(p.ws + WS_Z1P);
    const bf16_t* z1s = (const bf16_t*)(p.ws + WS_Z1S);
    bf16_t* yfm = (bf16_t*)(p.ws + WS_YFM);
    for (int id = blockIdx.x; id < 512; id += gridDim.x) {
        if (id < 256) {
            const int bg = id >> 5, rem = id & 31, mt = rem >> 1, nt = rem & 1;
            f32x16 acc[1][2]; zero_acc<1>(acc);
            gemm_mainloop<1, 128>(acc, apos + (size_t)mt * 128 * 4096, 4096, z1s + (size_t)(bg * 256 + nt * 128) * 4096, 4096, 4096, lds);
            const int b = bg >> 2, g = bg & 3;
            for_each_acc<1>(acc, mt * 128, nt * 128, [&](int lp, int chp, float& v) { yfm[(size_t)(TP + b * 2048 + lp) * 1024 + g * 256 + chp] = f2bf(v); });
        } else {
            const int i2 = id - 256, bg = i2 >> 1, nt = i2 & 1;
            f32x16 acc[2][2]; zero_acc<2>(acc);
            gemm_mainloop<2>(acc, a256, 512, z1p + (size_t)(bg * 256 + nt * 128) * 512, 512, 512, lds);
            const int b = bg >> 2, g = bg & 3;
            for_each_acc<2>(acc, 0, nt * 128, [&](int lp, int chp, float& v) { yfm[(size_t)(b * 256 + lp) * 1024 + g * 256 + chp] = f2bf(v); });
        }
    }
}

__device__ __forceinline__ void ssd_item(const Params& p, int seq, int h, int mode, unsigned char* lds) {
    const int tid = tid_opaque(), lane = tid & 63, wid = tid >> 6;
    const bool samp = seq >= 32;
    const int nc = samp ? 16 : 2;
    const int q0 = samp ? 64 + (seq - 32) * 16 : seq * 2;
    const int g = h >> 3;
    unsigned char* sC = lds;
    unsigned char* sB = lds + 34816;
    unsigned char* sX = lds + 69632;
    unsigned char* sH = lds + 87040;
    unsigned char* sXw = lds + 104448;
    float* sCum = (float*)(lds + 121856);
    float* sDt = sCum + 128;
    const bf16_t* gXT = (const bf16_t*)(p.ws + WS_XT);
    const bf16_t* gCM = (const bf16_t*)(p.ws + WS_CM);
    const bf16_t* gBM = (const bf16_t*)(p.ws + WS_BM);
    const bf16_t* gBT = (const bf16_t*)(p.ws + WS_BT);
    const float* dtb = (const float*)(p.ws + WS_DTB);
    bf16_t* yssd = (mode == 1) ? (bf16_t*)(p.ws + WS_YSB2) - (size_t)TP * 2048 : (bf16_t*)(p.ws + WS_YSSD);
    const float Dh = p.in[15][h];
    const int npass = mode == 2 ? 2 : 1;
    const int wr = wid >> 1, wc = wid & 1;
    const int wp = wid >> 2, wn = wid & 3;
    const int l31o = lane & 31;

#pragma unroll 1
    for (int pass = 0; pass < npass; ++pass) {
        const int dir = mode == 2 ? 1 - pass : mode;
        const bool rmw = (mode == 2 && pass == 1);
        const float Aneg = -__expf(p.in[14][dir * 32 + h]);
        f32x16 hacc;
        if (samp) {
            const float* st = p.in[2 + dir] + (size_t)((seq - 32) * 32 + h) * 8192;
#pragma unroll
            for (int r = 0; r < 16; ++r) hacc[r] = st[(wp * 32 + rowmap(r, lane)) * 128 + wn * 32 + l31o];
        } else {
#pragma unroll
            for (int r = 0; r < 16; ++r) hacc[r] = 0.f;
        }
#pragma unroll 1
        for (int step = 0; step < nc; ++step) {
            int ln = lane; asm volatile("" : "+v"(ln));
            const int l31 = ln & 31, lh = ln >> 5;
            const int c = dir == 0 ? step : nc - 1 - step;
            const int q = q0 + c, t0 = q * 128;
            if (wid == 0) {
                const float d0 = dtb[(size_t)(t0 + 2 * lane) * 64 + dir * 32 + h], d1 = dtb[(size_t)(t0 + 2 * lane + 1) * 64 + dir * 32 + h];
                const float a0 = d0 * Aneg, a1 = d1 * Aneg, s = a0 + a1;
                float sc = s;
#pragma unroll
                for (int o = 1; o < 64; o <<= 1) { const float n = __shfl_up(sc, o); if (lane >= o) sc += n; }
                const float tot = __shfl(sc, 63);
                const float ex = sc - s;
                float c0 = ex + a0, c1 = ex + a0 + a1;
                if (dir == 1) { c0 = tot - c0 + a0; c1 = tot - c1 + a1; }
                sCum[2 * lane] = c0; sCum[2 * lane + 1] = c1; sDt[2 * lane] = d0; sDt[2 * lane + 1] = d1;
            }
            const bf16_t* srcC = gCM + (size_t)(q * 4 + g) * 16384;
            const bf16_t* srcB = gBM + (size_t)(q * 4 + g) * 16384;
            const bf16_t* srcBT = gBT + (size_t)(q * 4 + g) * 16384;
            const bf16_t* srcX = gXT + (size_t)(q * 32 + h) * 8192;
            const int lrow = tid >> 4, lv = tid & 15;
            const int goff = lrow * 128 + lv * 8, soff = lrow * 272 + lv * 16;
#pragma unroll
            for (int i = 0; i < 4; ++i) {
                *(uint4*)(sC + soff + i * 32 * 272) = *(const uint4*)(srcC + goff + i * 32 * 128);
                *(uint4*)(sB + soff + i * 32 * 272) = *(const uint4*)(srcB + goff + i * 32 * 128); }
            const uint4 rbt0 = *(const uint4*)(srcBT + goff), rbt1 = *(const uint4*)(srcBT + goff + 32 * 128);
            const uint4 rbt2 = *(const uint4*)(srcBT + goff + 64 * 128), rbt3 = *(const uint4*)(srcBT + goff + 96 * 128);
            bf16_t* yp = yssd + (size_t)t0 * 2048 + h * 64 + wc * 32 + l31;
            f32x16 yprev;
#pragma unroll
            for (int r = 0; r < 16; ++r) yprev[r] = 0.f;
            if (rmw) {
#pragma unroll
                for (int r = 0; r < 16; ++r) yprev[r] = bf2f(yp[(size_t)(wr * 32 + rowmap(r, ln)) * 2048]);
            }
            const uint4 rx0 = *(const uint4*)(srcX + goff), rx1 = *(const uint4*)(srcX + goff + 32 * 128);
            *(uint4*)(sX + soff) = rx0; *(uint4*)(sX + soff + 32 * 272) = rx1;
#pragma unroll
            for (int r = 0; r < 16; ++r) *(bf16_t*)(sH + (wp * 32 + rowmap(r, ln)) * 272 + (wn * 32 + l31) * 2) = f2bf(hacc[r]);
            __syncthreads();
            const float cend = dir == 0 ? sCum[127] : sCum[0];
            {
                float wj[8];
#pragma unroll
                for (int u = 0; u < 8; ++u) wj[u] = __expf(cend - sCum[lv * 8 + u]) * sDt[lv * 8 + u];
#define XW(w, a, b) pk2(__uint_as_float((w) << 16) * wj[a], __uint_as_float((w) & 0xffff0000u) * wj[b])
                *(uint4*)(sXw + soff) = make_uint4(XW(rx0.x, 0, 1), XW(rx0.y, 2, 3), XW(rx0.z, 4, 5), XW(rx0.w, 6, 7));
                *(uint4*)(sXw + soff + 32 * 272) = make_uint4(XW(rx1.x, 0, 1), XW(rx1.y, 2, 3), XW(rx1.z, 4, 5), XW(rx1.w, 6, 7));
#undef XW
            }
            f32x16 cb0, cb1, yo;
#pragma unroll
            for (int r = 0; r < 16; ++r) { cb0[r] = 0.f; cb1[r] = 0.f; yo[r] = 0.f; }
#pragma unroll 2
            for (int ks = 0; ks < 8; ++ks) {
                const int ko = ks * 32 + lh * 16;
                const bf16x8 a = *(const bf16x8*)(sC + (wr * 32 + l31) * 272 + ko);
                const bf16x8 b0 = *(const bf16x8*)(sB + (wc * 64 + l31) * 272 + ko);
                const bf16x8 b1 = *(const bf16x8*)(sB + (wc * 64 + 32 + l31) * 272 + ko);
                const bf16x8 bh = *(const bf16x8*)(sH + (wc * 32 + l31) * 272 + ko);
                cb0 = __builtin_amdgcn_mfma_f32_32x32x16_bf16(a, b0, cb0, 0, 0, 0);
                cb1 = __builtin_amdgcn_mfma_f32_32x32x16_bf16(a, b1, cb1, 0, 0, 0);
                yo = __builtin_amdgcn_mfma_f32_32x32x16_bf16(a, bh, yo, 0, 0, 0);
            }
            {
                const int j0 = wc * 64 + l31, j1 = j0 + 32;
                const float cj0 = sCum[j0], cj1 = sCum[j1], dj0 = sDt[j0], dj1 = sDt[j1];
#pragma unroll
                for (int r = 0; r < 16; ++r) {
                    const int i = wr * 32 + rowmap(r, ln); const float ci = sCum[i];
                    const bool v0 = dir == 0 ? (j0 <= i) : (j0 >= i), v1 = dir == 0 ? (j1 <= i) : (j1 >= i);
                    float m0 = v0 ? cb0[r] * __expf(ci - cj0) * dj0 : 0.f;
                    float m1 = v1 ? cb1[r] * __expf(ci - cj1) * dj1 : 0.f;
                    if (dir == 0) { if (i == j0) m0 += Dh; if (i == j1) m1 += Dh; }
                    cb0[r] = m0; cb1[r] = m1;
                    yo[r] *= __expf(ci);
                }
            }
            __syncthreads();
            {
                const int j0 = wc * 64 + l31;
#pragma unroll
                for (int r = 0; r < 16; ++r) { const int i = wr * 32 + rowmap(r, ln);
                    *(bf16_t*)(sB + i * 272 + j0 * 2) = f2bf(cb0[r]); *(bf16_t*)(sB + i * 272 + (j0 + 32) * 2) = f2bf(cb1[r]); }
                *(uint4*)(sC + soff) = rbt0; *(uint4*)(sC + soff + 32 * 272) = rbt1; *(uint4*)(sC + soff + 64 * 272) = rbt2; *(uint4*)(sC + soff + 96 * 272) = rbt3;
            }
            __syncthreads();
            const float cdec = __expf(cend);
#pragma unroll
            for (int r = 0; r < 16; ++r) hacc[r] *= cdec;
#pragma unroll 2
            for (int ks = 0; ks < 8; ++ks) {
                const int ko = ks * 32 + lh * 16;
                const bf16x8 am = *(const bf16x8*)(sB + (wr * 32 + l31) * 272 + ko);
                const bf16x8 bx = *(const bf16x8*)(sX + (wc * 32 + l31) * 272 + ko);
                yo = __builtin_amdgcn_mfma_f32_32x32x16_bf16(am, bx, yo, 0, 0, 0);
                const bf16x8 ax = *(const bf16x8*)(sXw + (wp * 32 + l31) * 272 + ko);
                const bf16x8 bb = *(const bf16x8*)(sC + (wn * 32 + l31) * 272 + ko);
                hacc = __builtin_amdgcn_mfma_f32_32x32x16_bf16(ax, bb, hacc, 0, 0, 0);
            }
            {
#pragma unroll
                for (int r = 0; r < 16; ++r) { const int i = wr * 32 + rowmap(r, ln); yp[(size_t)i * 2048] = f2bf(yo[r] + yprev[r]); }
            }
            __syncthreads();
        }
        if (!samp) {
            float* dst = p.out + (size_t)T * 1024 + (size_t)dir * 8388608 + (size_t)(seq * 32 + h) * 8192;
#pragma unroll
            for (int r = 0; r < 16; ++r) dst[(wp * 32 + rowmap(r, lane)) * 128 + wn * 32 + l31o] = hacc[r];
        }
    }
}

template <bool ALPHA, bool BETA>
__device__ __forceinline__ void ssd_cstep(const Params& p, unsigned char* lds, int q, int h, float AnegF, float AnegB, float Dh,
                                          const f32x16& enter, int enterDir, bool scaleB, f32x16& accF, f32x16& accB, float& piF) {
    const int tid = tid_opaque(), lane = tid & 63, wid = tid >> 6;
    const int g = h >> 3, t0 = q * 128;
    unsigned char* sC = lds;
    unsigned char* sB = lds + 34816;
    unsigned char* sX = lds + 69632;
    unsigned char* sH = lds + 87040;
    unsigned char* sXwF = lds + 104448;
    unsigned char* sXwB = lds + 121856;
    float* sCumF = (float*)(lds + 139264);
    float* sCumB = sCumF + 128;
    float* sDtF = sCumF + 256;
    float* sDtB = sCumF + 384;
    const bf16_t* srcC = (const bf16_t*)(p.ws + WS_CM) + (size_t)(q * 4 + g) * 16384;
    const bf16_t* srcB = (const bf16_t*)(p.ws + WS_BM) + (size_t)(q * 4 + g) * 16384;
    const bf16_t* srcBT = (const bf16_t*)(p.ws + WS_BT) + (size_t)(q * 4 + g) * 16384;
    const bf16_t* srcX = (const bf16_t*)(p.ws + WS_XT) + (size_t)(q * 32 + h) * 8192;
    const float* dtb = (const float*)(p.ws + WS_DTB);
    bf16_t* yssd = (bf16_t*)(p.ws + WS_YSSD);
    const int wr = wid >> 1, wc = wid & 1, wp = wid >> 2, wn = wid & 3;
    const int l31 = lane & 31, lh = lane >> 5;
    if (wid == 0) {
        const float f0 = dtb[(size_t)(t0 + 2 * lane) * 64 + h], f1 = dtb[(size_t)(t0 + 2 * lane + 1) * 64 + h];
        const float b0 = dtb[(size_t)(t0 + 2 * lane) * 64 + 32 + h], b1 = dtb[(size_t)(t0 + 2 * lane + 1) * 64 + 32 + h];
        const float af0 = f0 * AnegF, af1 = f1 * AnegF, ab0 = b0 * AnegB, ab1 = b1 * AnegB;
        float sf = af0 + af1, sb = ab0 + ab1;
        const float sf0 = sf, sb0 = sb;
#pragma unroll
        for (int o = 1; o < 64; o <<= 1) { const float nf = __shfl_up(sf, o), nb = __shfl_up(sb, o); if (lane >= o) { sf += nf; sb += nb; } }
        const float totb = __shfl(sb, 63);
        const float exf = sf - sf0, exb = sb - sb0;
        sCumF[2 * lane] = exf + af0; sCumF[2 * lane + 1] = exf + af0 + af1;
        sCumB[2 * lane] = totb - exb; sCumB[2 * lane + 1] = totb - exb - ab0;
        sDtF[2 * lane] = f0; sDtF[2 * lane + 1] = f1; sDtB[2 * lane] = b0; sDtB[2 * lane + 1] = b1;
    }
    const int lrow = tid >> 4, lv = tid & 15;
    const int goff = lrow * 128 + lv * 8, soff = lrow * 272 + lv * 16;
    if (BETA) {
#pragma unroll
        for (int i = 0; i < 4; ++i) {
            *(uint4*)(sC + soff + i * 32 * 272) = *(const uint4*)(srcC + goff + i * 32 * 128);
            *(uint4*)(sB + soff + i * 32 * 272) = *(const uint4*)(srcB + goff + i * 32 * 128); }
    }
    uint4 rbt0 = make_uint4(0, 0, 0, 0), rbt1 = rbt0, rbt2 = rbt0, rbt3 = rbt0;
    if (ALPHA) {
        rbt0 = *(const uint4*)(srcBT + goff); rbt1 = *(const uint4*)(srcBT + goff + 32 * 128);
        rbt2 = *(const uint4*)(srcBT + goff + 64 * 128); rbt3 = *(const uint4*)(srcBT + goff + 96 * 128);
        if (!BETA) { *(uint4*)(sC + soff) = rbt0; *(uint4*)(sC + soff + 32 * 272) = rbt1; *(uint4*)(sC + soff + 64 * 272) = rbt2; *(uint4*)(sC + soff + 96 * 272) = rbt3; }
    }
    const uint4 rx0 = *(const uint4*)(srcX + goff), rx1 = *(const uint4*)(srcX + goff + 32 * 128);
    if (BETA) {
        *(uint4*)(sX + soff) = rx0; *(uint4*)(sX + soff + 32 * 272) = rx1;
#pragma unroll
        for (int r = 0; r < 16; ++r) *(bf16_t*)(sH + (wp * 32 + rowmap(r, lane)) * 272 + (wn * 32 + l31) * 2) = f2bf(enter[r]);
    }
    __syncthreads();
    const float pF = __expf(sCumF[127]), pB = __expf(sCumB[0]);
    if (ALPHA) {
        float wf[8], wb[8];
#pragma unroll
        for (int u = 0; u < 8; ++u) { wf[u] = __expf(sCumF[127] - sCumF[lv * 8 + u]) * sDtF[lv * 8 + u]; wb[u] = __expf(sCumB[0] - sCumB[lv * 8 + u]) * sDtB[lv * 8 + u]; }
#define XWF(w, a, b) pk2(__uint_as_float((w) << 16) * wf[a], __uint_as_float((w) & 0xffff0000u) * wf[b])
#define XWB(w, a, b) pk2(__uint_as_float((w) << 16) * wb[a], __uint_as_float((w) & 0xffff0000u) * wb[b])
        *(uint4*)(sXwF + soff) = make_uint4(XWF(rx0.x, 0, 1), XWF(rx0.y, 2, 3), XWF(rx0.z, 4, 5), XWF(rx0.w, 6, 7));
        *(uint4*)(sXwF + soff + 32 * 272) = make_uint4(XWF(rx1.x, 0, 1), XWF(rx1.y, 2, 3), XWF(rx1.z, 4, 5), XWF(rx1.w, 6, 7));
        *(uint4*)(sXwB + soff) = make_uint4(XWB(rx0.x, 0, 1), XWB(rx0.y, 2, 3), XWB(rx0.z, 4, 5), XWB(rx0.w, 6, 7));
        *(uint4*)(sXwB + soff + 32 * 272) = make_uint4(XWB(rx1.x, 0, 1), XWB(rx1.y, 2, 3), XWB(rx1.z, 4, 5), XWB(rx1.w, 6, 7));
#undef XWF
#undef XWB
    }
    f32x16 yo;
#pragma unroll
    for (int r = 0; r < 16; ++r) yo[r] = 0.f;
    if (BETA) {
        f32x16 cb0, cb1;
#pragma unroll
        for (int r = 0; r < 16; ++r) { cb0[r] = 0.f; cb1[r] = 0.f; }
#pragma unroll 2
        for (int ks = 0; ks < 8; ++ks) {
            const int ko = ks * 32 + lh * 16;
            const bf16x8 a = *(const bf16x8*)(sC + (wr * 32 + l31) * 272 + ko);
            const bf16x8 b0 = *(const bf16x8*)(sB + (wc * 64 + l31) * 272 + ko);
            const bf16x8 b1 = *(const bf16x8*)(sB + (wc * 64 + 32 + l31) * 272 + ko);
            const bf16x8 bh = *(const bf16x8*)(sH + (wc * 32 + l31) * 272 + ko);
            cb0 = __builtin_amdgcn_mfma_f32_32x32x16_bf16(a, b0, cb0, 0, 0, 0);
            cb1 = __builtin_amdgcn_mfma_f32_32x32x16_bf16(a, b1, cb1, 0, 0, 0);
            yo = __builtin_amdgcn_mfma_f32_32x32x16_bf16(a, bh, yo, 0, 0, 0);
        }
        {
            const int j0 = wc * 64 + l31, j1 = j0 + 32;
            const float fj0 = sCumF[j0], fj1 = sCumF[j1], bj0 = sCumB[j0], bj1 = sCumB[j1];
            const float df0 = sDtF[j0], df1 = sDtF[j1], db0 = sDtB[j0], db1 = sDtB[j1];
            const float* sCe = enterDir == 0 ? sCumF : sCumB;
#pragma unroll
            for (int r = 0; r < 16; ++r) {
                const int i = wr * 32 + rowmap(r, lane); const float fi = sCumF[i], bi = sCumB[i];
                const float e0 = j0 <= i ? __expf(fi - fj0) * df0 : 0.f, g0 = j0 >= i ? __expf(bi - bj0) * db0 : 0.f;
                const float e1 = j1 <= i ? __expf(fi - fj1) * df1 : 0.f, g1 = j1 >= i ? __expf(bi - bj1) * db1 : 0.f;
                float m0 = cb0[r] * (e0 + g0), m1 = cb1[r] * (e1 + g1);
                if (i == j0) m0 += Dh;
                if (i == j1) m1 += Dh;
                cb0[r] = m0; cb1[r] = m1;
                yo[r] *= __expf(sCe[i]);
            }
        }
        __syncthreads();
        {
            const int j0 = wc * 64 + l31;
#pragma unroll
            for (int r = 0; r < 16; ++r) { const int i = wr * 32 + rowmap(r, lane);
                *(bf16_t*)(sB + i * 272 + j0 * 2) = f2bf(cb0[r]); *(bf16_t*)(sB + i * 272 + (j0 + 32) * 2) = f2bf(cb1[r]); }
            if (ALPHA) { *(uint4*)(sC + soff) = rbt0; *(uint4*)(sC + soff + 32 * 272) = rbt1; *(uint4*)(sC + soff + 64 * 272) = rbt2; *(uint4*)(sC + soff + 96 * 272) = rbt3; }
        }
    }
    __syncthreads();
    if (ALPHA) {
        if (scaleB) {
#pragma unroll
            for (int r = 0; r < 16; ++r) accB[r] *= pB;
        }
    }
#pragma unroll 2
    for (int ks = 0; ks < 8; ++ks) {
        const int ko = ks * 32 + lh * 16;
        if (BETA) {
            const bf16x8 am = *(const bf16x8*)(sB + (wr * 32 + l31) * 272 + ko);
            const bf16x8 bx = *(const bf16x8*)(sX + (wc * 32 + l31) * 272 + ko);
            yo = __builtin_amdgcn_mfma_f32_32x32x16_bf16(am, bx, yo, 0, 0, 0);
        }
        if (ALPHA) {
            const bf16x8 bb = *(const bf16x8*)(sC + (wn * 32 + l31) * 272 + ko);
            const bf16x8 axf = *(const bf16x8*)(sXwF + (wp * 32 + l31) * 272 + ko);
            const bf16x8 axb = *(const bf16x8*)(sXwB + (wp * 32 + l31) * 272 + ko);
            accF = __builtin_amdgcn_mfma_f32_32x32x16_bf16(axf, bb, accF, 0, 0, 0);
            accB = __builtin_amdgcn_mfma_f32_32x32x16_bf16(axb, bb, accB, 0, 0, 0);
        }
    }
    if (BETA) {
        bf16_t* yp = yssd + (size_t)t0 * 2048 + h * 64 + wc * 32 + l31;
#pragma unroll
        for (int r = 0; r < 16; ++r) { const int i = wr * 32 + rowmap(r, lane); yp[(size_t)i * 2048] = f2bf(yo[r]); }
    }
    piF = pF;
    __syncthreads();
}

__device__ __forceinline__ void ssd_prompt_item(const Params& p, int seq, int h, unsigned char* lds) {
    const int lane = tid_opaque() & 63, wid = tid_opaque() >> 6, wp = wid >> 2, wn = wid & 3, l31 = lane & 31;
    const float AnegF = -__expf(p.in[14][h]), AnegB = -__expf(p.in[14][32 + h]), Dh = p.in[15][h];
    const int q0 = seq * 2;
    f32x16 SF1, SB, SF0, zero;
#pragma unroll
    for (int r = 0; r < 16; ++r) { SF1[r] = 0.f; SB[r] = 0.f; SF0[r] = 0.f; zero[r] = 0.f; }
    float piF1 = 1.f, piF0 = 1.f;
    ssd_cstep<true, false>(p, lds, q0 + 1, h, AnegF, AnegB, Dh, zero, 0, false, SF1, SB, piF1);
    ssd_cstep<true, true>(p, lds, q0, h, AnegF, AnegB, Dh, SB, 1, true, SF0, SB, piF0);
    {
        float* dstF = p.out + (size_t)T * 1024 + (size_t)(seq * 32 + h) * 8192;
        float* dstB = dstF + 8388608;
#pragma unroll
        for (int r = 0; r < 16; ++r) { const int o = (wp * 32 + rowmap(r, lane)) * 128 + wn * 32 + l31; dstF[o] = SF0[r] * piF1 + SF1[r]; dstB[o] = SB[r]; }
    }
    ssd_cstep<false, true>(p, lds, q0 + 1, h, AnegF, AnegB, Dh, SF0, 0, false, SF1, SB, piF0);
}

__device__ __forceinline__ void phase_ssd(const Params& p, unsigned char* lds) {
    const int G = gridDim.x, b = blockIdx.x;
    const bool bal = (G == 256);
    if (!bal || b < 128) {
#pragma unroll 1
        for (int v = b; v < 128; v += G) ssd_item(p, 32 + (v >> 6), v & 31, (v >> 5) & 1, lds);
    }
    const int p0 = bal ? (b < 128 ? 896 + b : (b - 128) * 7) : b, pstep = bal ? 1 : G, pend = bal ? (b < 128 ? 897 + b : (b - 128) * 7 + 7) : 1024;
#pragma unroll 1
    for (int pi = p0; pi < pend; pi += pstep) ssd_prompt_item(p, pi >> 5, pi & 31, lds);
}

__device__ __forceinline__ void phase_combine(const Params& p) {
    const int lane = tid_opaque() & 63, wid = tid_opaque() >> 6;
    bf16_t* yssd = (bf16_t*)(p.ws + WS_YSSD);
    const bf16_t* zs = (const bf16_t*)(p.ws + WS_ZS);
    const bf16_t* ysb2 = (const bf16_t*)(p.ws + WS_YSB2);
    const float* g = p.in[16];
    for (int t = blockIdx.x * 8 + wid; t < T; t += gridDim.x * 8) {
        float y[32]; float ss = 0.f;
#pragma unroll
        for (int i = 0; i < 4; ++i) { const int c = i * 512 + lane * 8;
            const uint4 a = *(const uint4*)(yssd + (size_t)t * 2048 + c), b = *(const uint4*)(zs + (size_t)t * 2048 + c);
            uint4 a2 = make_uint4(0u, 0u, 0u, 0u);
            if (t >= TP) a2 = *(const uint4*)(ysb2 + (size_t)(t - TP) * 2048 + c);
            const unsigned aw[4] = {a.x, a.y, a.z, a.w}, bw[4] = {b.x, b.y, b.z, b.w}, cw[4] = {a2.x, a2.y, a2.z, a2.w};
#pragma unroll
            for (int u = 0; u < 4; ++u) { const float y0 = (__uint_as_float(aw[u] << 16) + __uint_as_float(cw[u] << 16)) * siluf(__uint_as_float(bw[u] << 16)), y1 = (__uint_as_float(aw[u] & 0xffff0000u) + __uint_as_float(cw[u] & 0xffff0000u)) * siluf(__uint_as_float(bw[u] & 0xffff0000u));
                y[i * 8 + 2 * u] = y0; y[i * 8 + 2 * u + 1] = y1; ss += y0 * y0 + y1 * y1; } }
#pragma unroll
        for (int o = 32; o > 0; o >>= 1) ss += __shfl_xor(ss, o);
        const float rstd = rsqrtf(ss * (1.f / 2048.f) + 1e-6f);
#pragma unroll
        for (int i = 0; i < 4; ++i) { const int c = i * 512 + lane * 8; const float4 g0 = *(const float4*)(g + c), g1 = *(const float4*)(g + c + 4);
            *(uint4*)(yssd + (size_t)t * 2048 + c) = make_uint4(pk2(y[i * 8] * rstd * g0.x, y[i * 8 + 1] * rstd * g0.y), pk2(y[i * 8 + 2] * rstd * g0.z, y[i * 8 + 3] * rstd * g0.w),
                                                                pk2(y[i * 8 + 4] * rstd * g1.x, y[i * 8 + 5] * rstd * g1.y), pk2(y[i * 8 + 6] * rstd * g1.z, y[i * 8 + 7] * rstd * g1.w)); }
    }
}

struct EpiMerge {
    static constexpr bool PERM = true, AFTER_DRAIN = false;
    bf16_t* m; const bf16_t* gates; int second;
    __device__ __forceinline__ void operator()(const pg8::f32x4 (&acc)[2][2][4][2], const pg8::Unit& u, int wr, int wc, int fr, int fq) const {
#pragma unroll
        for (int ai = 0; ai < 2; ++ai)
#pragma unroll
            for (int mm = 0; mm < 4; ++mm) {
                const int row = u.pm * 256 + ai * 128 + wr * 64 + mm * 16 + fr;
#pragma unroll
                for (int bj = 0; bj < 2; ++bj) {
                    const int col = u.pn * 256 + bj * 128 + wc * 32 + 8 * fq;
                    const pg8::f32x4 v0 = acc[ai][bj][mm][0], v1 = acc[ai][bj][mm][1];
                    const uint4 gq = *(const uint4*)(gates + (size_t)row * 2048 + (second ? 1024 : 0) + col);
                    const float4 g0 = bf4_to_f4(make_uint2(gq.x, gq.y)), g1 = bf4_to_f4(make_uint2(gq.z, gq.w));
                    uint4* d = (uint4*)(m + (size_t)row * 1024 + col);
                    float4 o0 = make_float4(0.f, 0.f, 0.f, 0.f), o1 = o0;
                    if (second) { const uint4 oq = *d; o0 = bf4_to_f4(make_uint2(oq.x, oq.y)); o1 = bf4_to_f4(make_uint2(oq.z, oq.w)); }
                    *d = make_uint4(pk2(o0.x + v0[0] * g0.x, o0.y + v0[1] * g0.y), pk2(o0.z + v0[2] * g0.z, o0.w + v0[3] * g0.w),
                                    pk2(o1.x + v1[0] * g1.x, o1.y + v1[1] * g1.y), pk2(o1.z + v1[2] * g1.z, o1.w + v1[3] * g1.w));
                }
            }
    }
};

struct EpiGateBf16 {
    static constexpr bool PERM = true, AFTER_DRAIN = false;
    bf16_t* R; const float* mod; int gate_off;
    __device__ __forceinline__ void operator()(const pg8::f32x4 (&acc)[2][2][4][2], const pg8::Unit& u, int wr, int wc, int fr, int fq) const {
#pragma unroll
        for (int ai = 0; ai < 2; ++ai)
#pragma unroll
            for (int mm = 0; mm < 4; ++mm) {
                const int row = u.pm * 256 + ai * 128 + wr * 64 + mm * 16 + fr;
                const float* gp = mod + modidx(row) * 6144 + gate_off;
#pragma unroll
                for (int bj = 0; bj < 2; ++bj) {
                    const int col = u.pn * 256 + bj * 128 + wc * 32 + 8 * fq;
                    const pg8::f32x4 v0 = acc[ai][bj][mm][0], v1 = acc[ai][bj][mm][1];
                    const float4 g0 = *(const float4*)(gp + col), g1 = *(const float4*)(gp + col + 4);
                    *(uint4*)(R + (size_t)row * 1024 + col) = make_uint4(pk2(g0.x * v0[0], g0.y * v0[1]), pk2(g0.z * v0[2], g0.w * v0[3]), pk2(g1.x * v1[0], g1.y * v1[1]), pk2(g1.z * v1[2], g1.w * v1[3]));
                }
            }
    }
};

struct EpiResid {
    static constexpr bool PERM = false, AFTER_DRAIN = false;
    float* out; const float* xp; const float* xs; const float* mod; int gate_off; int inplace;
    __device__ __forceinline__ void operator()(const pg8::f32x4 (&acc)[2][2][4][2], const pg8::Unit& u, int wr, int wc, int fr, int fq) const {
#pragma unroll
        for (int ai = 0; ai < 2; ++ai)
#pragma unroll
            for (int mm = 0; mm < 4; ++mm) {
                const int row = u.pm * 256 + ai * 128 + wr * 64 + mm * 16 + fr;
                const float* gp = mod + modidx(row) * 6144 + gate_off;
                float* orow = out + (size_t)row * 1024;
                const float* brow = inplace ? orow : (row < TP ? xp + (size_t)row * 1024 : xs + (size_t)(row - TP) * 1024);
#pragma unroll
                for (int bj = 0; bj < 2; ++bj)
#pragma unroll
                    for (int n = 0; n < 2; ++n) {
                        const int col = u.pn * 256 + bj * 128 + wc * 32 + 16 * n + 4 * fq;
                        const pg8::f32x4 v = acc[ai][bj][mm][n];
                        const float4 x = *(const float4*)(brow + col), g = *(const float4*)(gp + col);
                        *(float4*)(orow + col) = make_float4(x.x + g.x * v[0], x.y + g.y * v[1], x.z + g.z * v[2], x.w + g.w * v[3]);
                    }
            }
    }
};

__device__ __forceinline__ void phase_merge(const Params& p, unsigned char* lds) {
    const bf16_t* gates = (const bf16_t*)((unsigned char*)p.out + DO_GATES);
    bf16_t* m = (bf16_t*)(p.ws + WS_M);
    pg8::StaticOrder S; S.init(T, 1024, (int)gridDim.x, (int)blockIdx.x);
    if (gridDim.x == 256 && blockIdx.x >= 192) {
#pragma unroll 1
        for (int tI = 2832 + ((int)blockIdx.x - 192); tI < 5136; tI += 64) transpose_tile(p, tI, lds);
        return;
    }
    {
        pg8::Gemm g{(const bf16_t*)(p.ws + WS_YFM), (const bf16_t*)(p.ws + WS_WF), T, 1024, 1024};
        EpiMerge E{m, gates, 0};
        pg8::gemm_phase<EpiMerge, pg8::StaticOrder, false>((PG8_LAS unsigned char*)lds, g, S, E, nullptr);
    }
    {
        pg8::Gemm g{(const bf16_t*)(p.ws + WS_YSSD), (const bf16_t*)(p.ws + WS_WSO), T, 1024, 2048};
        EpiMerge E{m, gates, 1};
        pg8::gemm_phase<EpiMerge, pg8::StaticOrder, false>((PG8_LAS unsigned char*)lds, g, S, E, nullptr);
    }
}

__device__ __forceinline__ void phase_out(const Params& p, unsigned char* lds) {
    pg8::Gemm g{(const bf16_t*)(p.ws + WS_M), (const bf16_t*)(p.ws + WS_WO), T, 1024, 1024};
    pg8::StaticOrder S; S.init(T, 1024, (int)gridDim.x, (int)blockIdx.x);
    EpiGateBf16 E{(bf16_t*)(p.ws + WS_R), (const float*)(p.ws + WS_MOD), 2048};
    pg8::gemm_phase<EpiGateBf16, pg8::StaticOrder, false>((PG8_LAS unsigned char*)lds, g, S, E, nullptr);
}

struct EpiFF1 {
    static constexpr bool PERM = true, AFTER_DRAIN = false;
    bf16_t* f;
    __device__ __forceinline__ void operator()(const pg8::f32x4 (&acc)[2][2][4][2], const pg8::Unit& u, int wr, int wc, int fr, int fq) const {
#pragma unroll
        for (int ai = 0; ai < 2; ++ai)
#pragma unroll
            for (int m = 0; m < 4; ++m) {
                bf16_t* rowp = f + (size_t)(u.pm * 256 + ai * 128 + wr * 64 + m * 16 + fr) * 4096 + u.pn * 256 + wc * 32 + 8 * fq;
#pragma unroll
                for (int bj = 0; bj < 2; ++bj) {
                    const pg8::f32x4 v0 = acc[ai][bj][m][0], v1 = acc[ai][bj][m][1];
                    const float r0 = fmaxf(v0[0], 0.f), r1 = fmaxf(v0[1], 0.f), r2 = fmaxf(v0[2], 0.f), r3 = fmaxf(v0[3], 0.f);
                    const float r4 = fmaxf(v1[0], 0.f), r5 = fmaxf(v1[1], 0.f), r6 = fmaxf(v1[2], 0.f), r7 = fmaxf(v1[3], 0.f);
                    *(uint4*)(rowp + bj * 128) = make_uint4(pk2(r0 * r0, r1 * r1), pk2(r2 * r2, r3 * r3), pk2(r4 * r4, r5 * r5), pk2(r6 * r6, r7 * r7));
                }
            }
    }
};

__device__ __forceinline__ void phase_ff1(const Params& p, unsigned char* lds) {
    pg8::Gemm g{(const bf16_t*)(p.ws + WS_H2), (const bf16_t*)(p.ws + WS_W1), T, 4096, 1024};
    pg8::StaticOrder S; S.init(T, 4096, (int)gridDim.x, (int)blockIdx.x);
    EpiFF1 E{(bf16_t*)(p.ws + WS_F)};
    pg8::gemm_phase<EpiFF1, pg8::StaticOrder, false>((PG8_LAS unsigned char*)lds, g, S, E, nullptr);
}

__device__ __forceinline__ void phase_ff2(const Params& p, unsigned char* lds) {
    pg8::Gemm g{(const bf16_t*)(p.ws + WS_F), (const bf16_t*)(p.ws + WS_W2), T, 1024, 4096};
    pg8::StaticOrder S; S.init(T, 1024, (int)gridDim.x, (int)blockIdx.x);
    EpiGateBf16 E{(bf16_t*)(p.ws + WS_R), (const float*)(p.ws + WS_MOD), 5120};
    pg8::gemm_phase<EpiGateBf16, pg8::StaticOrder, false>((PG8_LAS unsigned char*)lds, g, S, E, nullptr);
}

__global__ void __launch_bounds__(NT) fwd_megakernel(Params p) {
    extern __shared__ __attribute__((aligned(16))) unsigned char lds[];
    cg::grid_group grid = cg::this_grid();
    if (__builtin_amdgcn_workitem_id_x() == 0) *(uint4*)(lds + LDS_ST) = make_uint4(0u, 0u, 0u, 0u);
    __syncthreads();
    XcdBarrier xb = xcd_barrier_post((unsigned*)(p.ws + WS_BAR), (volatile LAS unsigned*)(lds + LDS_ST));
#define RUN(k, call) if (PH_ON(k) && p.ph_lo <= (k) && (k) < p.ph_hi) { call; } if ((k) == REPEAT_PH) { call; } if (p.ph_lo <= (k) && (k) + 1 < p.ph_hi) { if ((k) == 0) grid.sync(); else xcd_barrier(xb); }
    RUN(0, phase_prep(p, lds))
    RUN(1, phase_norm(p, 0))
    RUN(2, phase_inproj(p, lds))
    RUN(3, phase_conv_f1(p, lds))
    RUN(4, phase_f1(p, lds))
    RUN(5, phase_f2(p, lds))
    RUN(6, phase_ssd(p, lds))
    RUN(7, phase_combine(p))
    RUN(8, phase_merge(p, lds))
    RUN(9, phase_out(p, lds))
    RUN(10, phase_norm(p, 1))
    RUN(11, phase_ff1(p, lds))
    RUN(12, phase_ff2(p, lds))
    if (PH_ON(13) && p.ph_lo <= 13 && 13 < p.ph_hi) phase_norm(p, 2);
}

extern "C" void kernel_launch(void* const* d_in, const int* in_sizes, int n_in, void* d_out, int out_size, void* d_ws, size_t ws_size, hipStream_t stream) {
    static int grid_blocks = 0;
    if (grid_blocks == 0) {
        if (n_in != 23 || ws_size < WS_END || out_size != T * 1024 + 2 * 8388608) { fprintf(stderr, "kernel_launch: unexpected shapes (n_in %d, ws %zu, out %d)\n", n_in, ws_size, out_size); grid_blocks = -1; return; }
        int dev = 0, cus = 0, per_cu = 0;
        (void)hipGetDevice(&dev);
        (void)hipDeviceGetAttribute(&cus, hipDeviceAttributeMultiprocessorCount, dev);
        if (hipFuncSetAttribute((const void*)fwd_megakernel, hipFuncAttributeMaxDynamicSharedMemorySize, LDS_BYTES) != hipSuccess) { fprintf(stderr, "kernel_launch: hipFuncSetAttribute failed\n"); grid_blocks = -1; return; }
        if (hipOccupancyMaxActiveBlocksPerMultiprocessor(&per_cu, (const void*)fwd_megakernel, NT, LDS_BYTES) != hipSuccess || per_cu < 1) { fprintf(stderr, "kernel_launch: occupancy query failed (%d)\n", per_cu); grid_blocks = -1; return; }
        grid_blocks = cus * per_cu;
    }
    if (grid_blocks < 0) return;
    Params p{};
    for (int i = 0; i < 23; ++i) p.in[i] = (const float*)d_in[i];
    p.out = (float*)d_out; p.ws = (unsigned char*)d_ws;
    if (hipMemsetAsync((unsigned char*)d_ws + WS_BAR, 0, XCD_BAR_WORDS * 4, stream) != hipSuccess) { fprintf(stderr, "kernel_launch: memset failed\n"); return; }
#if ONE_LAUNCH
    p.ph_lo = 0; p.ph_hi = NPH + 1;
    void* args[] = {&p};
    hipError_t e = hipLaunchCooperativeKernel((const void*)fwd_megakernel, dim3(grid_blocks), dim3(NT), args, LDS_BYTES, stream);
    if (e != hipSuccess) fprintf(stderr, "cooperative launch failed: %s (grid %d)\n", hipGetErrorString(e), grid_blocks);
#else
    for (int ph = 0; ph <= NPH; ++ph) {
        p.ph_lo = ph; p.ph_hi = ph + 1;
        hipLaunchKernelGGL(fwd_megakernel, dim3(grid_blocks), dim3(NT), LDS_BYTES, stream, p);
    }
#endif
}
```

```cpp
#include <hip/hip_runtime.h>
#include <hip/hip_cooperative_groups.h>
#include <cstdio>
#include <cstdint>
namespace cg = cooperative_groups;

#ifndef PHMASK
#define PHMASK 0xFFFF
#endif
#define PH_ON(n) ((PHMASK >> (n)) & 1)
#ifndef REPEAT_PH
#define REPEAT_PH -1
#endif
#ifndef ONE_LAUNCH
#define ONE_LAUNCH 1
#endif

typedef unsigned short bf16_t;
typedef short bf16x8 __attribute__((ext_vector_type(8)));
typedef float f32x16 __attribute__((ext_vector_type(16)));

#define NT 512
constexpr int T = 12288, TP = 8192;
constexpr int NPH = 13;
constexpr size_t MiB = 1048576;
constexpr size_t WS_WF = 0, WS_WSO = 2 * MiB, WS_WO = 6 * MiB, WS_W1 = 8 * MiB, WS_W2 = 16 * MiB;
constexpr size_t WS_CSC = 24 * MiB, WS_A256 = 24 * MiB + 262144, WS_MOD = 24 * MiB + 524288, WS_DTB = 25 * MiB;
constexpr size_t WS_WIN = 28 * MiB;
constexpr size_t WS_YSB2 = 28 * MiB;
constexpr size_t WS_ZS = 45 * MiB;
constexpr size_t WS_XBC = 93 * MiB;
constexpr size_t WS_Z1P = 93 * MiB;
constexpr size_t WS_Z1S = 125 * MiB;
constexpr size_t WS_YFM = 141 * MiB;
constexpr size_t WS_YSSD = 93 * MiB;
constexpr size_t WS_XT = 165 * MiB;
constexpr size_t WS_CM = 213 * MiB, WS_BM = 225 * MiB, WS_BT = 237 * MiB;
constexpr size_t WS_M = 165 * MiB;
constexpr size_t WS_H2 = 189 * MiB;
constexpr size_t WS_R = 141 * MiB;
constexpr size_t WS_F = 45 * MiB;
constexpr size_t WS_BAR = 249 * MiB;
constexpr size_t WS_END = 250 * MiB;
constexpr size_t DO_GATES = 0, DO_H1 = 48 * MiB, DO_UF = 72 * MiB, DO_APOS = 96 * MiB;
constexpr int LDS_ST = 147456;
constexpr int LDS_BYTES = 147472;

struct Params {
    const float* in[23];
    float* out;
    unsigned char* ws;
    int ph_lo, ph_hi;
};

__device__ __forceinline__ int tid_opaque() { int t = (int)__builtin_amdgcn_workitem_id_x(); asm volatile("" : "+v"(t)); return t; }
typedef __bf16 bf16x2v __attribute__((ext_vector_type(2)));
typedef float f32x2v __attribute__((ext_vector_type(2)));
__device__ __forceinline__ unsigned pk2(float lo, float hi) { f32x2v v = {lo, hi}; bf16x2v b = __builtin_convertvector(v, bf16x2v); return __builtin_bit_cast(unsigned, b); }
__device__ __forceinline__ bf16_t f2bf(float f) { return (bf16_t)(pk2(f, f) & 0xffffu); }
__device__ __forceinline__ float bf2f(bf16_t h) { return __uint_as_float(((unsigned)h) << 16); }
__device__ __forceinline__ float sigmf(float v) { return __builtin_amdgcn_rcpf(1.f + __expf(-v)); }
__device__ __forceinline__ float siluf(float v) { return v * sigmf(v); }
__device__ __forceinline__ int rowmap(int reg, int lane) { return (reg & 3) + 8 * (reg >> 2) + 4 * (lane >> 5); }


#define XB_TMO      128
#define XB_XCNT(j)  (256  + 64 * (j))
#define XB_XSUB(j)  (1280 + 64 * (j))
#define XB_XGEN(j)  (2304 + 64 * (j))
#define XB_TOP      3328
#define XB_TOPGEN   3392
#define XCD_BAR_WORDS 3456
#define XB_SPIN_CAP (1u << 18)
#define LAS __attribute__((address_space(3)))
__device__ __forceinline__ unsigned xb_ld(unsigned* p)              { return __hip_atomic_load(p, __ATOMIC_RELAXED, __HIP_MEMORY_SCOPE_AGENT); }
__device__ __forceinline__ unsigned xb_add(unsigned* p, unsigned v) { return __hip_atomic_fetch_add(p, v, __ATOMIC_RELAXED, __HIP_MEMORY_SCOPE_AGENT); }
__device__ __forceinline__ unsigned xb_xcc_id() { return (unsigned)__builtin_amdgcn_s_getreg((3 << 11) | 20) & 0xFu; }
#define XB_SPIN(cond, bar) do { unsigned _sp = 0; while (cond) { __builtin_amdgcn_s_sleep(1); \
    if ((++_sp & 255u) == 0u) { if (xb_ld(&(bar)[XB_TMO])) break; if (_sp > XB_SPIN_CAP) { atomicAdd(&(bar)[XB_TMO], 1u); break; } } } } while (0)
struct XcdBarrier { unsigned* bar; unsigned x; volatile LAS unsigned* st; };
__device__ __forceinline__ XcdBarrier xcd_barrier_post(unsigned* bar, volatile LAS unsigned* st) {
    XcdBarrier b; b.bar = bar; b.x = xb_xcc_id(); b.st = st;
    if (__builtin_amdgcn_workitem_id_x() == 0) (void)xb_add(&bar[XB_XCNT(b.x)], 1u);
    return b;
}
__device__ __forceinline__ void xcd_barrier_complete(unsigned* bar, unsigned x, unsigned& nloc, unsigned& nx) {
    const unsigned G = gridDim.x * gridDim.y * gridDim.z;
    unsigned sum, cnt, mine, sp = 0u;
    for (;;) {
        sum = 0u; cnt = 0u; mine = 0u;
#pragma unroll
        for (unsigned j = 0; j < 16; ++j) { const unsigned c = xb_ld(&bar[XB_XCNT(j)]); sum += c; cnt += (c > 0u) ? 1u : 0u; mine = (j == x) ? c : mine; }
        if (sum == G) break;
        __builtin_amdgcn_s_sleep(1);
        if ((++sp & 255u) == 0u) { if (xb_ld(&bar[XB_TMO])) break; if (sp > XB_SPIN_CAP) { atomicAdd(&bar[XB_TMO], 1u); break; } }
    }
    nloc = mine > 0u ? mine : 1u; nx = cnt > 0u ? cnt : 1u;
}
__device__ __forceinline__ void xcd_barrier(const XcdBarrier& b) {
    asm volatile("s_waitcnt vmcnt(0)" ::: "memory");
    __syncthreads();
    if (__builtin_amdgcn_workitem_id_x() == 0) {
        unsigned* bar = b.bar;
        __builtin_amdgcn_s_waitcnt(0);
        unsigned nloc = b.st[0], nx = b.st[1];
        if (nloc == 0u) { xcd_barrier_complete(bar, b.x, nloc, nx); b.st[0] = nloc; b.st[1] = nx; }
        const unsigned old = xb_add(&bar[XB_XSUB(b.x)], 1u);
        const unsigned gen = old / nloc;
        if (old + 1u == (gen + 1u) * nloc) {
            __builtin_amdgcn_fence(__ATOMIC_RELEASE, "agent");
            asm volatile("s_waitcnt vmcnt(0)" ::: "memory");
            const unsigned og = xb_add(&bar[XB_TOP], 1u);
            const unsigned tg = og / nx;
            if (og + 1u == (tg + 1u) * nx) xb_add(&bar[XB_TOPGEN], 1u);
            else XB_SPIN(xb_ld(&bar[XB_TOPGEN]) == tg, bar);
            __builtin_amdgcn_fence(__ATOMIC_ACQUIRE, "agent");
            xb_add(&bar[XB_XGEN(b.x)], 1u);
            asm volatile("s_waitcnt vmcnt(0)" ::: "memory");
        } else {
            XB_SPIN(xb_ld(&bar[XB_XGEN(b.x)]) == gen, bar);
            __builtin_amdgcn_fence(__ATOMIC_ACQUIRE, "agent");
            asm volatile("s_waitcnt vmcnt(0)" ::: "memory");
        }
    }
    __syncthreads();
}

namespace pg8 {
#define PG8_LAS __attribute__((address_space(3)))
typedef unsigned short bf16_t;
typedef short bf16x8 __attribute__((ext_vector_type(8)));
typedef float f32x4 __attribute__((ext_vector_type(4)));
typedef unsigned u32x4 __attribute__((ext_vector_type(4)));
constexpr int BM = 256, BK = 64, HALF = 128, HTB = HALF * BK * 2  , STAGE_BYTES = 8 * HTB, NXCD = 8, WGM = 8;

__host__ __device__ __forceinline__ int lds_byte(int r, int c) { const int st = (r >> 4) * 2 + (c >> 5), rr = r & 15, cc = c & 31, ob = rr * 64 + cc * 2; return st * 1024 + (ob ^ (((ob >> 9) & 1) << 5)); }
__host__ __device__ __forceinline__ void stage_rc(int b, int& R, int& C) { const int st = b / 1024, sb = b % 1024, swz = sb ^ (((sb >> 9) & 1) << 5); R = (st >> 1) * 16 + swz / 64; C = (st & 1) * 32 + (swz % 64) / 2; }
__host__ __device__ __forceinline__ int perm32(int rho) { const int n = rho >> 4, i = rho & 15; return 8 * (i >> 2) + 4 * n + (i & 3); }

struct Unit { int pm, pn; };
struct Gemm { const bf16_t* A; const bf16_t* Bt; int M, N, K; };

struct StaticOrder {
    int nM, nN, nwg, G, c;
    __host__ __device__ void init(int M, int N, int G_, int c_) { nM = M / BM; nN = N / BM; nwg = nM * nN; G = G_; c = c_; }
    __host__ __device__ bool next(int i, Unit& u) const {
        const long L = (long)i * G + c; if (L >= nwg) return false;
        int wgid = (int)L; { const int q = nwg / NXCD, r = nwg % NXCD, xcd = wgid % NXCD, off = wgid / NXCD; wgid = (xcd < r ? xcd * (q + 1) : r * (q + 1) + (xcd - r) * q) + off; }
        const int nig = WGM * nN, gid = wgid / nig, fm = gid * WGM, gsz = (nM - fm) < WGM ? (nM - fm) : WGM;
        u.pm = fm + ((wgid % nig) % gsz); u.pn = (wgid % nig) / gsz; return true;
    }
    __device__ __forceinline__ void a_ready(const Unit&) const {}
    __device__ __forceinline__ void done(const Unit&) const {}
};
template <class Epi, class Sched, bool STAMP = false>
__device__ __forceinline__ void gemm_phase(PG8_LAS unsigned char* lds, const Gemm g, const Sched& S, const Epi& E, unsigned long long* stamps) {
    const int tid = threadIdx.x, wid = __builtin_amdgcn_readfirstlane(tid >> 6), lane = tid & 63, wr = wid >> 2, wc = wid & 3, fr = lane & 15, fq = lane >> 4;
    const int K = g.K, nt = K / BK;
    int ts_lo = 0, ts_hi = 0, nts = 0; const unsigned long long rt_entry = STAMP ? (unsigned long long)wall_clock64() : 0ull;
#define PG8_STAMP() do { if (STAMP && wid == 0 && nts < 64) { const unsigned long long _c = (unsigned long long)clock64(); \
        ts_lo = (lane == nts) ? (int)(unsigned)_c : ts_lo; ts_hi = (lane == nts) ? (int)(unsigned)(_c >> 32) : ts_hi; ++nts; } } while (0)
    PG8_STAMP();
    unsigned voffA[2], voffB[2];
#pragma unroll
    for (int i = 0; i < 2; ++i) { int R, C; stage_rc(tid * 16 + i * 8192, R, C); const int Rb = Epi::PERM ? ((R & ~31) + perm32(R & 31)) : R;
        voffA[i] = (unsigned)(R * K + C) * 2u; voffB[i] = (unsigned)(Rb * K + C) * 2u; }
    const size_t kstep = (size_t)(BK * 2);
    const size_t hstep = (size_t)HALF * K * 2;
    const size_t tstep = 2 * hstep;
    const unsigned ldsw = (unsigned)wid * 1024u;
    const int aoff = lds_byte(wr * 64 + fr, fq * 8), boff = lds_byte(wc * 32 + fr, fq * 8);
#define PG8_SA(b, h) (((b) * 2 + (h)) * HTB)
#define PG8_SB(b, h) ((4 + (b) * 2 + (h)) * HTB)
#define PG8_STAGE(bufoff, gbase, voff) do { _Pragma("unroll") for (int _i = 0; _i < 2; ++_i) \
        __builtin_amdgcn_global_load_lds((const unsigned*)((const char*)(gbase) + (voff)[_i]), (PG8_LAS unsigned*)(lds + (bufoff) + ldsw + _i * 8192), 16, 0, 0); } while (0)
#define PG8_LDA(dst, b, h) do { _Pragma("unroll") for (int m = 0; m < 4; ++m) _Pragma("unroll") for (int k = 0; k < 2; ++k) dst[m][k] = *(const PG8_LAS bf16x8*)(lds + PG8_SA(b, h) + aoff + m * 2048 + k * 1024); } while (0)
#define PG8_LDB(dst, b, h) do { _Pragma("unroll") for (int n = 0; n < 2; ++n) _Pragma("unroll") for (int k = 0; k < 2; ++k) dst[n][k] = *(const PG8_LAS bf16x8*)(lds + PG8_SB(b, h) + boff + n * 2048 + k * 1024); } while (0)
#define PG8_MMA(ai, bj, At, Bt) do { __builtin_amdgcn_s_setprio(1); _Pragma("unroll") for (int m = 0; m < 4; ++m) _Pragma("unroll") for (int n = 0; n < 2; ++n) _Pragma("unroll") for (int k = 0; k < 2; ++k) \
        acc[ai][bj][m][n] = __builtin_amdgcn_mfma_f32_16x16x32_bf16(Bt[n][k], At[m][k], acc[ai][bj][m][n], 0, 0, 0); __builtin_amdgcn_s_setprio(0); } while (0)
#define PG8_WAIT_V(n) asm volatile("s_waitcnt vmcnt(" #n ")" ::: "memory")
#define PG8_WAIT_L(n) asm volatile("s_waitcnt lgkmcnt(" #n ")" ::: "memory")
#define PG8_BAR __builtin_amdgcn_s_barrier()
#define PG8_SCHED __builtin_amdgcn_sched_barrier(0)
    Unit cur, nxt; int ui = 0;
    if (!S.next(0, cur)) return;
    f32x4 acc[2][2][4][2];
#pragma unroll
    for (int a = 0; a < 2; ++a)
#pragma unroll
        for (int b = 0; b < 2; ++b)
#pragma unroll
            for (int m = 0; m < 4; ++m)
#pragma unroll
                for (int n = 0; n < 2; ++n) acc[a][b][m][n] = (f32x4){0.f, 0.f, 0.f, 0.f};
    bf16x8 At[4][2], B0[2][2], B1[2][2];
    const char* cA = (const char*)g.A + (size_t)cur.pm * tstep; const char* cB = (const char*)g.Bt + (size_t)cur.pn * tstep;
    S.a_ready(cur);
    PG8_STAGE(PG8_SB(0, 0), cB, voffB); PG8_STAGE(PG8_SA(0, 0), cA, voffA); PG8_STAGE(PG8_SB(0, 1), cB + hstep, voffB); PG8_STAGE(PG8_SA(0, 1), cA + hstep, voffA);
    if (wr == 1) PG8_BAR;
    PG8_WAIT_V(4); PG8_BAR;
    PG8_STAGE(PG8_SB(1, 0), cB + kstep, voffB); PG8_STAGE(PG8_SA(1, 0), cA + kstep, voffA); PG8_STAGE(PG8_SB(1, 1), cB + hstep + kstep, voffB);
    PG8_WAIT_V(6); PG8_BAR;
    PG8_STAMP();
    for (;;) {
        const bool has_next = S.next(ui + 1, nxt);
        const char* nA = has_next ? (const char*)g.A + (size_t)nxt.pm * tstep : cA; const char* nB = has_next ? (const char*)g.Bt + (size_t)nxt.pn * tstep : cB;
        for (int t = 0; t < nt; t += 2) {
            const bool last = (t == nt - 2);
            const char* a1 = cA + (size_t)(t + 1) * kstep;
            const char* a2 = last ? nA : cA + (size_t)(t + 2) * kstep; const char* b2 = last ? nB : cB + (size_t)(t + 2) * kstep;
            const char* a3 = a2 + kstep; const char* b3 = b2 + kstep;
            if (last && has_next) S.a_ready(nxt);
            PG8_LDB(B0, 0, 0); PG8_SCHED; PG8_LDA(At, 0, 0); PG8_STAGE(PG8_SA(1, 1), a1 + hstep, voffA);
            PG8_WAIT_L(8); PG8_BAR; PG8_WAIT_L(0); PG8_MMA(0, 0, At, B0); PG8_BAR; PG8_SCHED;
            PG8_LDB(B1, 0, 1); PG8_STAGE(PG8_SB(0, 0), b2, voffB);
            PG8_BAR; PG8_WAIT_L(0); PG8_MMA(0, 1, At, B1); PG8_BAR;
            PG8_LDA(At, 0, 1); PG8_STAGE(PG8_SA(0, 0), a2, voffA);
            PG8_BAR; PG8_WAIT_L(0); PG8_MMA(1, 0, At, B0); PG8_BAR; PG8_SCHED;
            PG8_STAGE(PG8_SB(0, 1), b2 + hstep, voffB);
            PG8_WAIT_V(6); PG8_BAR; PG8_MMA(1, 1, At, B1); PG8_BAR;
            PG8_LDB(B0, 1, 0); PG8_SCHED; PG8_LDA(At, 1, 0); PG8_STAGE(PG8_SA(0, 1), a2 + hstep, voffA);
            PG8_WAIT_L(8); PG8_BAR; PG8_WAIT_L(0); PG8_MMA(0, 0, At, B0); PG8_BAR; PG8_SCHED;
            PG8_LDB(B1, 1, 1); PG8_STAGE(PG8_SB(1, 0), b3, voffB);
            PG8_BAR; PG8_WAIT_L(0); PG8_MMA(0, 1, At, B1); PG8_BAR;
            PG8_LDA(At, 1, 1); PG8_STAGE(PG8_SA(1, 0), a3, voffA);
            PG8_BAR; PG8_WAIT_L(0); PG8_MMA(1, 0, At, B0); PG8_BAR; PG8_SCHED;
            PG8_STAGE(PG8_SB(1, 1), b3 + hstep, voffB);
            PG8_WAIT_V(6); PG8_BAR; PG8_MMA(1, 1, At, B1); PG8_BAR;
        }
        PG8_STAMP();
        if constexpr (!Epi::AFTER_DRAIN) { E(acc, cur, wr, wc, fr, fq); S.done(cur); }
        PG8_STAMP();
        if (!has_next) break;
#pragma unroll
        for (int a = 0; a < 2; ++a)
#pragma unroll
            for (int b = 0; b < 2; ++b)
#pragma unroll
                for (int m = 0; m < 4; ++m)
#pragma unroll
                    for (int n = 0; n < 2; ++n) acc[a][b][m][n] = (f32x4){0.f, 0.f, 0.f, 0.f};
        cur = nxt; cA = nA; cB = nB; ++ui;
    }
    PG8_WAIT_V(0);
    if (wr == 0) PG8_BAR;
    PG8_BAR;
    if constexpr (Epi::AFTER_DRAIN) { E.fused(acc, cur, wr, wc, fr, fq, lds, wid, lane); S.done(cur); }
    PG8_STAMP();
    if (STAMP && wid == 0) { stamps[lane] = lane < nts ? (((unsigned long long)(unsigned)ts_hi << 32) | (unsigned)ts_lo) : 0ull;
        if (lane == 62) stamps[62] = rt_entry; if (lane == 63) stamps[63] = (unsigned long long)wall_clock64(); }
#undef PG8_STAMP
#undef PG8_SA
#undef PG8_SB
#undef PG8_STAGE
#undef PG8_LDA
#undef PG8_LDB
#undef PG8_MMA
#undef PG8_WAIT_V
#undef PG8_WAIT_L
#undef PG8_BAR
#undef PG8_SCHED
}
}

template <int MI, int BK = 64, int NI = 2, int WR = 4, bool TR = false>
__device__ __forceinline__ void gemm_mainloop(f32x16 (&acc)[MI][NI], const bf16_t* __restrict__ A, int lda, const bf16_t* __restrict__ Bt, int ldb, int K, unsigned char* lds) {
    constexpr int WC = 8 / WR;
    constexpr int BM = 32 * MI * WR, BN = 32 * NI * WC;
    constexpr int RS = (BK + 8) * 2;
    constexpr int VPR = BK / 8;
    constexpr int RPP = NT / VPR;
    constexpr int NA = BM / RPP, NB = BN / RPP;
    constexpr int ABYTES = BM * RS, BBYTES = BN * RS, STAGE = ABYTES + BBYTES;
    static_assert(NA >= 2 && NA <= 4 && NB >= 2 && NB <= 4 && BM % RPP == 0 && BN % RPP == 0, "tile config");
    const int tid = tid_opaque(), lane = tid & 63, wid = tid >> 6, wr = wid / WC, wc = wid % WC;
    const int lr = tid / VPR, lk = tid % VPR;
    uint4 ra0, ra1, ra2, ra3, rb0, rb1, rb2, rb3;
    const bf16_t* Ap = A + (size_t)lr * lda + lk * 8;
    const bf16_t* Bp = Bt + (size_t)lr * ldb + lk * 8;
    const int nk = K / BK;
    const int wo = lr * RS + lk * 16;
#define G_LOAD(k0) { ra0 = *(const uint4*)(Ap + (k0)); ra1 = *(const uint4*)(Ap + (size_t)RPP * lda + (k0)); \
        if (NA >= 3) ra2 = *(const uint4*)(Ap + (size_t)(2 * RPP) * lda + (k0)); \
        if (NA >= 4) ra3 = *(const uint4*)(Ap + (size_t)(3 * RPP) * lda + (k0)); \
        rb0 = *(const uint4*)(Bp + (k0)); rb1 = *(const uint4*)(Bp + (size_t)RPP * ldb + (k0)); \
        if (NB >= 3) rb2 = *(const uint4*)(Bp + (size_t)(2 * RPP) * ldb + (k0)); \
        if (NB >= 4) rb3 = *(const uint4*)(Bp + (size_t)(3 * RPP) * ldb + (k0)); }
#define S_STORE(buf) { *(uint4*)((buf) + wo) = ra0; *(uint4*)((buf) + wo + RPP * RS) = ra1; \
        if (NA >= 3) *(uint4*)((buf) + wo + 2 * RPP * RS) = ra2; \
        if (NA >= 4) *(uint4*)((buf) + wo + 3 * RPP * RS) = ra3; \
        *(uint4*)((buf) + ABYTES + wo) = rb0; *(uint4*)((buf) + ABYTES + wo + RPP * RS) = rb1; \
        if (NB >= 3) *(uint4*)((buf) + ABYTES + wo + 2 * RPP * RS) = rb2; \
        if (NB >= 4) *(uint4*)((buf) + ABYTES + wo + 3 * RPP * RS) = rb3; }
    ra2 = ra3 = rb2 = rb3 = make_uint4(0, 0, 0, 0);
    __syncthreads();
    G_LOAD(0)
    S_STORE(lds)
    __syncthreads();
    const int aoff = (wr * 32 * MI + (lane & 31)) * RS + (lane >> 5) * 16;
    const int boff = ABYTES + (wc * 32 * NI + (lane & 31)) * RS + (lane >> 5) * 16;
#pragma unroll 1
    for (int kt = 0; kt < nk; ++kt) {
        unsigned char* cur = lds + (kt & 1) * STAGE;
        unsigned char* nxt = lds + ((kt + 1) & 1) * STAGE;
        const bool more = (kt + 1 < nk);
        if (more) { const int k0 = (kt + 1) * BK; G_LOAD(k0) }
#pragma unroll
        for (int ks = 0; ks < BK / 16; ++ks) {
            bf16x8 af[MI], bfr[NI];
#pragma unroll
            for (int mi = 0; mi < MI; ++mi) af[mi] = *(const bf16x8*)(cur + aoff + mi * 32 * RS + ks * 32);
#pragma unroll
            for (int ni = 0; ni < NI; ++ni) bfr[ni] = *(const bf16x8*)(cur + boff + ni * 32 * RS + ks * 32);
#pragma unroll
            for (int mi = 0; mi < MI; ++mi)
#pragma unroll
                for (int ni = 0; ni < NI; ++ni)
                    acc[mi][ni] = TR ? __builtin_amdgcn_mfma_f32_32x32x16_bf16(bfr[ni], af[mi], acc[mi][ni], 0, 0, 0)
                                     : __builtin_amdgcn_mfma_f32_32x32x16_bf16(af[mi], bfr[ni], acc[mi][ni], 0, 0, 0);
        }
        if (more) S_STORE(nxt)
        __syncthreads();
    }
#undef G_LOAD
#undef S_STORE
}

template <int MI, int NI = 2>
__device__ __forceinline__ void zero_acc(f32x16 (&acc)[MI][NI]) {
#pragma unroll
    for (int mi = 0; mi < MI; ++mi)
#pragma unroll
        for (int ni = 0; ni < NI; ++ni)
#pragma unroll
            for (int r = 0; r < 16; ++r) acc[mi][ni][r] = 0.f;
}

template <int MI, int NI = 2, int WR = 4, class F>
__device__ __forceinline__ void for_each_acc(f32x16 (&acc)[MI][NI], int row0, int col0, F f) {
    constexpr int WC = 8 / WR;
    const int lane = tid_opaque() & 63, wid = tid_opaque() >> 6, wr = wid / WC, wc = wid % WC;
#pragma unroll
    for (int mi = 0; mi < MI; ++mi)
#pragma unroll
        for (int ni = 0; ni < NI; ++ni) {
            const int col = col0 + wc * 32 * NI + ni * 32 + (lane & 31);
            const int rb = row0 + wr * 32 * MI + mi * 32 + 4 * (lane >> 5);
#pragma unroll
            for (int r = 0; r < 16; ++r) { float v = acc[mi][ni][r]; f(rb + (r & 3) + 8 * (r >> 2), col, v); acc[mi][ni][r] = v; }
        }
}

template <int MI, int NI = 2, int WR = 4, class F>
__device__ __forceinline__ void for_each_acc4(f32x16 (&acc)[MI][NI], int row0, int col0, F f) {
    constexpr int WC = 8 / WR;
    const int lane = tid_opaque() & 63, wid = tid_opaque() >> 6, wr = wid / WC, wc = wid % WC;
#pragma unroll
    for (int mi = 0; mi < MI; ++mi)
#pragma unroll
        for (int ni = 0; ni < NI; ++ni) {
            const int row = row0 + wr * 32 * MI + mi * 32 + (lane & 31);
            const int cb = col0 + wc * 32 * NI + ni * 32 + 4 * (lane >> 5);
#pragma unroll
            for (int g = 0; g < 4; ++g) {
                float4 v = make_float4(acc[mi][ni][4 * g], acc[mi][ni][4 * g + 1], acc[mi][ni][4 * g + 2], acc[mi][ni][4 * g + 3]);
                f(row, cb + 8 * g, v);
                acc[mi][ni][4 * g] = v.x; acc[mi][ni][4 * g + 1] = v.y; acc[mi][ni][4 * g + 2] = v.z; acc[mi][ni][4 * g + 3] = v.w;
            }
        }
}
__device__ __forceinline__ float4 bf4_to_f4(uint2 u) { return make_float4(__uint_as_float(u.x << 16), __uint_as_float(u.x & 0xffff0000u), __uint_as_float(u.y << 16), __uint_as_float(u.y & 0xffff0000u)); }
__device__ __forceinline__ uint2 f4_to_bf4(float4 v) { return make_uint2(pk2(v.x, v.y), pk2(v.z, v.w)); }

template <class F>
__device__ __forceinline__ void for_tiles(int n_mt, int n_nt, F f) {
    const int G = gridDim.x, b = blockIdx.x;
    const bool ok = ((G & 7) == 0) && ((n_mt & 7) == 0);
    const int xcd = ok ? (b & 7) : 0, mul = ok ? 8 : 1, mpx = ok ? (n_mt >> 3) : n_mt;
    const int t0 = ok ? (b >> 3) : b, tstep = ok ? (G >> 3) : G, ntot = mpx * n_nt;
#pragma unroll 1
    for (int t = t0; t < ntot; t += tstep) f(xcd + mul * (t % mpx), t / mpx);
}

__device__ __forceinline__ const float* xrow(const Params& p, int t) { return t < TP ? p.in[0] + (size_t)t * 1024 : p.in[1] + (size_t)(t - TP) * 1024; }
__device__ __forceinline__ int modidx(int t) { return t < TP ? 0 : 1 + ((t - TP) >> 11); }

__device__ __forceinline__ void transpose_tile(const Params& p, int tI, unsigned char* lds) {
    const int tid = tid_opaque();
    const float* src; bf16_t* dst; int K, N;
    if (tI < 2064) { src = p.in[9]; dst = (bf16_t*)(p.ws + WS_WIN); K = 1024; N = 8256; }
    else if (tI < 2320) { tI -= 2064; src = p.in[10]; dst = (bf16_t*)(p.ws + WS_WF); K = 1024; N = 1024; }
    else if (tI < 2832) { tI -= 2320; src = p.in[17]; dst = (bf16_t*)(p.ws + WS_WSO); K = 2048; N = 1024; }
    else if (tI < 3088) { tI -= 2832; src = p.in[18]; dst = (bf16_t*)(p.ws + WS_WO); K = 1024; N = 1024; }
    else if (tI < 4112) { tI -= 3088; src = p.in[20]; dst = (bf16_t*)(p.ws + WS_W1); K = 1024; N = 4096; }
    else { tI -= 4112; src = p.in[21]; dst = (bf16_t*)(p.ws + WS_W2); K = 4096; N = 1024; }
    const int nkt = K >> 6; const int k0 = (tI % nkt) * 64, n0 = (tI / nkt) * 64;
    bf16_t* ts = (bf16_t*)lds;
    __syncthreads();
#pragma unroll
    for (int i = 0; i < 2; ++i) { const int idx = tid + i * NT, kr = idx >> 4, nv = idx & 15;
        const float4 v = *(const float4*)(src + (size_t)(k0 + kr) * N + n0 + nv * 4);
        ts[(nv * 4 + 0) * 72 + kr] = f2bf(v.x); ts[(nv * 4 + 1) * 72 + kr] = f2bf(v.y); ts[(nv * 4 + 2) * 72 + kr] = f2bf(v.z); ts[(nv * 4 + 3) * 72 + kr] = f2bf(v.w); }
    __syncthreads();
    { const int n = tid >> 3, kv = tid & 7; *(uint4*)(dst + (size_t)(n0 + n) * K + k0 + kv * 8) = *(const uint4*)(ts + n * 72 + kv * 8); }
}

__device__ __forceinline__ void phase_prep(const Params& p, unsigned char* lds) {
    const int tid = tid_opaque();
    float* mod = (float*)(p.ws + WS_MOD);
    const bool defer = (gridDim.x == 256);
    constexpr int N_GEMV = 192, N_TR = 5136, N_ZERO = 1, N_TAB = 32 + 32 + 2048;
    constexpr int NITEMS = N_GEMV + N_TR + N_ZERO + N_TAB;
    for (int item = blockIdx.x; item < NITEMS; item += gridDim.x) {
        if (item < N_GEMV) {
            float* sv = (float*)lds;
            float* part = sv + 3072;
            __syncthreads();
            for (int i = tid; i < 3072; i += NT) { const int r = i >> 10, k = i & 1023; const float v = (r == 0) ? p.in[5][k] : p.in[4][(r - 1) * 1024 + k]; sv[i] = siluf(v); }
            __syncthreads();
            const int col = tid & 31, kq = tid >> 5, col0 = item * 32;
            const float* w = p.in[6] + (size_t)(kq * 64) * 6144 + col0 + col;
            float a0 = 0.f, a1 = 0.f, a2 = 0.f;
#pragma unroll 16
            for (int k = 0; k < 64; ++k) { const float wv = w[(size_t)k * 6144]; const int kk = kq * 64 + k; a0 += sv[kk] * wv; a1 += sv[1024 + kk] * wv; a2 += sv[2048 + kk] * wv; }
            part[(kq * 3 + 0) * 32 + col] = a0; part[(kq * 3 + 1) * 32 + col] = a1; part[(kq * 3 + 2) * 32 + col] = a2;
            __syncthreads();
            if (tid < 96) { const int r = tid >> 5, c = tid & 31; float s = p.in[7][col0 + c];
                for (int q = 0; q < 16; ++q) s += part[(q * 3 + r) * 32 + c];
                mod[r * 6144 + col0 + c] = s; }
        } else if (item < N_GEMV + N_TR) {
            const int tI = item - N_GEMV;
            if (defer && tI >= 2832) continue;
            transpose_tile(p, tI, lds);
        } else if (item < N_GEMV + N_TR + N_ZERO) {
            uint4* d = (uint4*)(p.ws + WS_WIN + (size_t)8256 * 1024 * 2);
            for (int i = tid; i < 64 * 1024 * 2 / 16; i += NT) d[i] = make_uint4(0, 0, 0, 0);
        } else {
            const int tb = item - (N_GEMV + N_TR + N_ZERO);
            unsigned pk[4];
            bf16_t* dst; size_t e0;
            if (tb < 32) { dst = (bf16_t*)(p.ws + WS_CSC); e0 = (size_t)tb * 4096 + tid * 8;
#pragma unroll
                for (int j = 0; j < 8; j += 2) { float v[2];
                    for (int u = 0; u < 2; ++u) { const int e = (int)e0 + j + u, m = e >> 8, k = e & 255, cs = m >> 8, chp = m & 255; const float ang = (float)((chp * k) & 255) * (1.f / 128.f);
                        v[u] = (cs == 0 ? cospif(ang) : sinpif(ang)) * 0.0625f; }
                    pk[j >> 1] = pk2(v[0], v[1]); }
            } else if (tb < 64) { dst = (bf16_t*)(p.ws + WS_A256); e0 = (size_t)(tb - 32) * 4096 + tid * 8;
#pragma unroll
                for (int j = 0; j < 8; j += 2) { float v[2];
                    for (int u = 0; u < 2; ++u) { const int e = (int)e0 + j + u, lp = e >> 9, kk = e & 511, cs = kk >> 8, l = kk & 255; const float ang = (float)((lp * l) & 255) * (1.f / 128.f);
                        v[u] = (cs == 0 ? cospif(ang) : -sinpif(ang)) * 0.0625f; }
                    pk[j >> 1] = pk2(v[0], v[1]); }
            } else { dst = (bf16_t*)((unsigned char*)p.out + DO_APOS); e0 = (size_t)(tb - 64) * 4096 + tid * 8;
#pragma unroll
                for (int j = 0; j < 8; j += 2) { float v[2];
                    for (int u = 0; u < 2; ++u) { const int e = (int)e0 + j + u, lp = e >> 12, kk = e & 4095, cs = kk >> 11, l = kk & 2047;
                        const int r = l >> 6, c = l & 63, rp = lp >> 6, cp = lp & 63; const float ang = (float)((2 * r * rp + c * cp) & 63) * (1.f / 32.f);
                        v[u] = (cs == 0 ? cospif(ang) : -sinpif(ang)) * 0.02209708691f; }
                    pk[j >> 1] = pk2(v[0], v[1]); }
            }
            *(uint4*)(dst + e0) = make_uint4(pk[0], pk[1], pk[2], pk[3]);
        }
    }
}

__device__ __forceinline__ void phase_norm(const Params& p, int which) {
    const int lane = tid_opaque() & 63, wid = tid_opaque() >> 6;
    const float* mod = (const float*)(p.ws + WS_MOD);
    const float* g = which == 0 ? p.in[8] : (which == 1 ? p.in[19] : p.in[22]);
    bf16_t* dst = which == 0 ? (bf16_t*)((unsigned char*)p.out + DO_H1) : (bf16_t*)(p.ws + WS_H2);
    for (int t0 = (blockIdx.x * 8 + wid) * 2; t0 < T; t0 += gridDim.x * 16) {
        float4 v[2][4]; float ss[2] = {0.f, 0.f};
#pragma unroll
        for (int u = 0; u < 2; ++u) { const int t = t0 + u; const float* src = which == 2 ? p.out + (size_t)t * 1024 : xrow(p, t);
#pragma unroll
            for (int i = 0; i < 4; ++i) v[u][i] = *(const float4*)(src + i * 256 + lane * 4);
            if (which != 0) {
                const bf16_t* rr = (const bf16_t*)(p.ws + WS_R) + (size_t)t * 1024;
#pragma unroll
                for (int i = 0; i < 4; ++i) { const float4 r = bf4_to_f4(*(const uint2*)(rr + i * 256 + lane * 4));
                    v[u][i].x += r.x; v[u][i].y += r.y; v[u][i].z += r.z; v[u][i].w += r.w; }
                if (which == 1) {
#pragma unroll
                    for (int i = 0; i < 4; ++i) *(float4*)(p.out + (size_t)t * 1024 + i * 256 + lane * 4) = v[u][i];
                }
            } }
#pragma unroll
        for (int u = 0; u < 2; ++u) {
#pragma unroll
            for (int i = 0; i < 4; ++i) ss[u] += v[u][i].x * v[u][i].x + v[u][i].y * v[u][i].y + v[u][i].z * v[u][i].z + v[u][i].w * v[u][i].w;
#pragma unroll
            for (int o = 32; o > 0; o >>= 1) ss[u] += __shfl_xor(ss[u], o);
        }
#pragma unroll
        for (int u = 0; u < 2; ++u) {
            const int t = t0 + u;
            const float rstd = rsqrtf(ss[u] * (1.f / 1024.f) + 1e-6f);
            if (which == 2) {
#pragma unroll
                for (int i = 0; i < 4; ++i) { const int c = i * 256 + lane * 4; const float4 gg = *(const float4*)(g + c);
                    float4 o; o.x = v[u][i].x * rstd * gg.x; o.y = v[u][i].y * rstd * gg.y; o.z = v[u][i].z * rstd * gg.z; o.w = v[u][i].w * rstd * gg.w;
                    *(float4*)(p.out + (size_t)t * 1024 + c) = o; }
            } else {
                const float* mrow = mod + modidx(t) * 6144 + (which == 0 ? 0 : 3072);
#pragma unroll
                for (int i = 0; i < 4; ++i) { const int c = i * 256 + lane * 4; const float4 gg = *(const float4*)(g + c);
                    const float4 sh = *(const float4*)(mrow + c), sc = *(const float4*)(mrow + 1024 + c);
                    const float o0 = v[u][i].x * rstd * gg.x * (1.f + sc.x) + sh.x, o1 = v[u][i].y * rstd * gg.y * (1.f + sc.y) + sh.y;
                    const float o2 = v[u][i].z * rstd * gg.z * (1.f + sc.z) + sh.z, o3 = v[u][i].w * rstd * gg.w * (1.f + sc.w) + sh.w;
                    *(uint2*)(dst + (size_t)t * 1024 + c) = make_uint2(pk2(o0, o1), pk2(o2, o3)); }
            }
        }
    }
}

struct EpiInProj {
    static constexpr bool PERM = true, AFTER_DRAIN = false;
    bf16_t* uf; bf16_t* zs; bf16_t* xbc; float* dtb; bf16_t* gates; const float* dt_bias;
    __device__ __forceinline__ void operator()(const pg8::f32x4 (&acc)[2][2][4][2], const pg8::Unit& u, int wr, int wc, int fr, int fq) const {
#pragma unroll
        for (int bj = 0; bj < 2; ++bj) {
            const int cb = __builtin_amdgcn_readfirstlane(u.pn * 256 + bj * 128 + wc * 32);
            const int rbase = u.pm * 256 + wr * 64 + fr;
            if (cb >= 6144 && cb < 6208) {
                const int j = cb - 6144 + 8 * fq;
                const float4 b0 = *(const float4*)(dt_bias + j), b1 = *(const float4*)(dt_bias + j + 4);
#pragma unroll
                for (int ai = 0; ai < 2; ++ai)
#pragma unroll
                    for (int m = 0; m < 4; ++m) {
                        const pg8::f32x4 v0 = acc[ai][bj][m][0], v1 = acc[ai][bj][m][1];
                        float x[8] = {v0[0] + b0.x, v0[1] + b0.y, v0[2] + b0.z, v0[3] + b0.w, v1[0] + b1.x, v1[1] + b1.y, v1[2] + b1.z, v1[3] + b1.w};
#pragma unroll
                        for (int e = 0; e < 8; ++e) x[e] = x[e] > 20.f ? x[e] : log1pf(__expf(x[e]));
                        float* d = dtb + (size_t)(rbase + ai * 128 + m * 16) * 64 + j;
                        *(float4*)d = make_float4(x[0], x[1], x[2], x[3]); *(float4*)(d + 4) = make_float4(x[4], x[5], x[6], x[7]);
                    }
            } else {
                bf16_t* dst; int ld, c0; bool sg = false;
                if (cb < 1024) { dst = uf; ld = 1024; c0 = cb; }
                else if (cb < 3072) { dst = zs; ld = 2048; c0 = cb - 1024; }
                else if (cb < 6144) { dst = xbc; ld = 3072; c0 = cb - 3072; }
                else { dst = gates; ld = 2048; c0 = cb - 6208; sg = true; }
                bf16_t* dp = dst + (size_t)rbase * ld + c0 + 8 * fq;
                if (sg) {
#pragma unroll
                    for (int ai = 0; ai < 2; ++ai)
#pragma unroll
                        for (int m = 0; m < 4; ++m) { const pg8::f32x4 v0 = acc[ai][bj][m][0], v1 = acc[ai][bj][m][1];
                            *(uint4*)(dp + (size_t)(ai * 128 + m * 16) * ld) = make_uint4(pk2(sigmf(v0[0]), sigmf(v0[1])), pk2(sigmf(v0[2]), sigmf(v0[3])), pk2(sigmf(v1[0]), sigmf(v1[1])), pk2(sigmf(v1[2]), sigmf(v1[3]))); }
                } else {
#pragma unroll
                    for (int ai = 0; ai < 2; ++ai)
#pragma unroll
                        for (int m = 0; m < 4; ++m) { const pg8::f32x4 v0 = acc[ai][bj][m][0], v1 = acc[ai][bj][m][1];
                            *(uint4*)(dp + (size_t)(ai * 128 + m * 16) * ld) = make_uint4(pk2(v0[0], v0[1]), pk2(v0[2], v0[3]), pk2(v1[0], v1[1]), pk2(v1[2], v1[3])); }
                }
            }
        }
    }
};

__device__ __forceinline__ void phase_inproj(const Params& p, unsigned char* lds) {
    const bf16_t* h1 = (const bf16_t*)((unsigned char*)p.out + DO_H1);
    const bf16_t* W = (const bf16_t*)(p.ws + WS_WIN);
    bf16_t* uf = (bf16_t*)((unsigned char*)p.out + DO_UF);
    bf16_t* zs = (bf16_t*)(p.ws + WS_ZS);
    bf16_t* xbc = (bf16_t*)(p.ws + WS_XBC);
    float* dtb = (float*)(p.ws + WS_DTB);
    bf16_t* gates = (bf16_t*)((unsigned char*)p.out + DO_GATES);
    const float* dt_bias = p.in[13];
    auto epi = [&](const f32x16& a, int rb, int cb, int lane) {
        if (cb >= 8256) return;
        if (cb >= 6144 && cb < 6208) {
            const int j = cb - 6144 + (lane & 31); const float bias = dt_bias[j];
#pragma unroll
            for (int r = 0; r < 16; ++r) { const float x = a[r] + bias; dtb[(size_t)(rb + (r & 3) + 8 * (r >> 2)) * 64 + j] = x > 20.f ? x : log1pf(__expf(x)); }
        } else {
            bf16_t* dst; int ld, c0; bool sg = false;
            if (cb < 1024) { dst = uf; ld = 1024; c0 = cb; }
            else if (cb < 3072) { dst = zs; ld = 2048; c0 = cb - 1024; }
            else if (cb < 6144) { dst = xbc; ld = 3072; c0 = cb - 3072; }
            else { dst = gates; ld = 2048; c0 = cb - 6208; sg = true; }
            bf16_t* dp = dst + (size_t)rb * ld + c0 + (lane & 31);
            if (sg) {
#pragma unroll
                for (int r = 0; r < 16; ++r) dp[(size_t)((r & 3) + 8 * (r >> 2)) * ld] = f2bf(sigmf(a[r]));
            } else {
#pragma unroll
                for (int r = 0; r < 16; ++r) dp[(size_t)((r & 3) + 8 * (r >> 2)) * ld] = f2bf(a[r]);
            }
        }
    };
    {
        pg8::Gemm g{h1, W, T, 8192, 1024};
        pg8::StaticOrder S; S.init(T, 8192, (int)gridDim.x, (int)blockIdx.x);
        EpiInProj E{uf, zs, xbc, dtb, gates, dt_bias};
        pg8::gemm_phase<EpiInProj, pg8::StaticOrder, false>((PG8_LAS unsigned char*)lds, g, S, E, nullptr);
    }
    for (int mt = (int)gridDim.x - 1 - (int)blockIdx.x; mt < 48; mt += gridDim.x) {
        f32x16 acc[2][2]; zero_acc<2>(acc);
        gemm_mainloop<2>(acc, h1 + (size_t)mt * 256 * 1024, 1024, W + (size_t)8192 * 1024, 1024, 1024, lds);
        const int lane = tid_opaque() & 63, wid = tid_opaque() >> 6, wr = wid >> 1, wc = wid & 1;
#pragma unroll
        for (int mi = 0; mi < 2; ++mi)
#pragma unroll
            for (int ni = 0; ni < 2; ++ni)
                epi(acc[mi][ni], mt * 256 + wr * 64 + mi * 32 + 4 * (lane >> 5), __builtin_amdgcn_readfirstlane(8192 + wc * 64 + ni * 32), lane);
    }
}

struct ConvPre { uint4 v0, v1, v2; float w; };
__device__ __forceinline__ void conv_prefetch(const Params& p, int item, int tid, ConvPre& r) {
    const int q = item / 48, sl = item % 48;
    const int sstart = q < 64 ? (q >> 1) * 256 : TP + ((q - 64) >> 4) * 2048;
    const int send = sstart + (q < 64 ? 256 : 2048);
    const int t0 = q * 128;
    const bf16_t* xbc = (const bf16_t*)(p.ws + WS_XBC);
    r.v0 = r.v1 = r.v2 = make_uint4(0, 0, 0, 0); r.w = 0.f;
    { const int idx = tid, row = idx >> 3, v = idx & 7; const int t = t0 - 2 + row; if (t >= sstart && t < send) r.v0 = *(const uint4*)(xbc + (size_t)t * 3072 + sl * 64 + v * 8); }
    { const int idx = tid + NT, row = idx >> 3, v = idx & 7; const int t = t0 - 2 + row; if (t >= sstart && t < send) r.v1 = *(const uint4*)(xbc + (size_t)t * 3072 + sl * 64 + v * 8); }
    { const int idx = tid + 2 * NT, row = idx >> 3, v = idx & 7; const int t = t0 - 2 + row; if (idx < 132 * 8 && t >= sstart && t < send) r.v2 = *(const uint4*)(xbc + (size_t)t * 3072 + sl * 64 + v * 8); }
    if (tid < 320) r.w = p.in[11][(tid >> 6) * 3072 + sl * 64 + (tid & 63)];
    else if (tid < 384) r.w = p.in[12][sl * 64 + (tid - 320)];
}

__device__ __forceinline__ void conv_item(const Params& p, int item, int next_item, ConvPre& pre, unsigned char* lds) {
    const int tid = tid_opaque();
    const int q = item / 48, sl = item % 48;
    bf16_t* sIn = (bf16_t*)lds;
    bf16_t* sOut = (bf16_t*)(lds + 132 * 144);
    float* sW = (float*)(lds + 132 * 144 + 128 * 144);
    __syncthreads();
    { const int idx = tid; *(uint4*)(sIn + (idx >> 3) * 72 + (idx & 7) * 8) = pre.v0; }
    { const int idx = tid + NT; *(uint4*)(sIn + (idx >> 3) * 72 + (idx & 7) * 8) = pre.v1; }
    { const int idx = tid + 2 * NT; if (idx < 132 * 8) *(uint4*)(sIn + (idx >> 3) * 72 + (idx & 7) * 8) = pre.v2; }
    if (tid < 384) sW[tid] = pre.w;
    if (next_item >= 0) conv_prefetch(p, next_item, tid, pre);
    __syncthreads();
    {
        const int j = tid >> 2, c0 = (tid & 3) * 16;
        float o[16];
#pragma unroll
        for (int c = 0; c < 16; ++c) o[c] = sW[320 + c0 + c];
#pragma unroll
        for (int k = 0; k < 5; ++k) {
            const uint4 a = *(const uint4*)(sIn + (j + k) * 72 + c0), b = *(const uint4*)(sIn + (j + k) * 72 + c0 + 8);
            const unsigned w[8] = {a.x, a.y, a.z, a.w, b.x, b.y, b.z, b.w};
#pragma unroll
            for (int u = 0; u < 8; ++u) { o[2 * u] += sW[k * 64 + c0 + 2 * u] * __uint_as_float(w[u] << 16); o[2 * u + 1] += sW[k * 64 + c0 + 2 * u + 1] * __uint_as_float(w[u] & 0xffff0000u); }
        }
        unsigned pk[8];
#pragma unroll
        for (int u = 0; u < 8; ++u) pk[u] = pk2(siluf(o[2 * u]), siluf(o[2 * u + 1]));
        *(uint4*)(sOut + j * 72 + c0) = make_uint4(pk[0], pk[1], pk[2], pk[3]);
        *(uint4*)(sOut + j * 72 + c0 + 8) = make_uint4(pk[4], pk[5], pk[6], pk[7]);
    }
    __syncthreads();
    if (sl >= 32) {
        const int s2 = sl - 32, isC = s2 >= 8, g = (s2 & 7) >> 1, nh = s2 & 1;
        bf16_t* dst = (bf16_t*)(p.ws + (isC ? WS_CM : WS_BM)) + (size_t)(q * 4 + g) * 128 * 128 + nh * 64;
#pragma unroll
        for (int i = 0; i < 2; ++i) { const int idx = tid + i * NT, j = idx >> 3, v = idx & 7; *(uint4*)(dst + (size_t)j * 128 + v * 8) = *(const uint4*)(sOut + j * 72 + v * 8); }
    }
    if (sl < 40) {
        bf16_t* dst;
        if (sl < 32) dst = (bf16_t*)(p.ws + WS_XT) + (size_t)(q * 32 + sl) * 64 * 128;
        else { const int s2 = sl - 32; dst = (bf16_t*)(p.ws + WS_BT) + (size_t)(q * 4 + (s2 >> 1)) * 128 * 128 + (size_t)(s2 & 1) * 64 * 128; }
        const int ch = tid >> 3, jv = tid & 7;
#pragma unroll
        for (int i = 0; i < 2; ++i) { const int j0 = jv * 8 + i * 64; unsigned pk[4];
#pragma unroll
            for (int u = 0; u < 4; ++u) pk[u] = (unsigned)sOut[(j0 + 2 * u) * 72 + ch] | ((unsigned)sOut[(j0 + 2 * u + 1) * 72 + ch] << 16);
            *(uint4*)(dst + (size_t)ch * 128 + j0) = make_uint4(pk[0], pk[1], pk[2], pk[3]); }
    }
}

__device__ __forceinline__ void phase_conv_f1(const Params& p, unsigned char* lds) {
    const bf16_t* csc = (const bf16_t*)(p.ws + WS_CSC);
    const bf16_t* uf = (const bf16_t*)((unsigned char*)p.out + DO_UF);
    (void)csc; (void)uf;
    ConvPre pre;
    int item = blockIdx.x;
    if (item < 96 * 48) conv_prefetch(p, item, tid_opaque(), pre);
#pragma unroll 1
    for (; item < 96 * 48; item += gridDim.x) {
        const int nxt = item + (int)gridDim.x;
        conv_item(p, item, nxt < 96 * 48 ? nxt : -1, pre, lds);
    }
}

__device__ __forceinline__ void phase_f1(const Params& p, unsigned char* lds) {
    const bf16_t* csc = (const bf16_t*)(p.ws + WS_CSC);
    const bf16_t* uf = (const bf16_t*)((unsigned char*)p.out + DO_UF);
    bf16_t* z1p = (bf16_t*)(p.ws + WS_Z1P);
    bf16_t* z1s = (bf16_t*)(p.ws + WS_Z1S);
    for (int id = blockIdx.x; id < 768; id += gridDim.x) {
        const int g = id / 192, rem = id % 192, mt = rem / 96, nt = rem % 96;
        f32x16 acc[2][2]; zero_acc<2>(acc);
        gemm_mainloop<2>(acc, csc + (size_t)mt * 256 * 256, 256, uf + (size_t)nt * 128 * 1024 + g * 256, 1024, 256, lds);
        for_each_acc<2>(acc, 0, nt * 128, [&](int chp, int t, float& v) {
            if (t < TP) { const int b = t >> 8, l = t & 255; z1p[((size_t)(b * 4 + g) * 256 + chp) * 512 + mt * 256 + l] = f2bf(v); }
            else { const int ts = t - TP, b = ts >> 11, l = ts & 2047; z1s[((size_t)(b * 4 + g) * 256 + chp) * 4096 + mt * 2048 + l] = f2bf(v); }
        });
    }
}

__device__ __forceinline__ void phase_f2(const Params& p, unsigned char* lds) {
    const bf16_t* a256 = (const bf16_t*)(p.ws + WS_A256);
    const bf16_t* apos = (const bf16_t*)((unsigned char*)p.out + DO_APOS);
    const bf16_t* z1p = (const bf16_t*)(p.ws + WS_Z1P);
    const bf16_t* z1s = (const bf16_t*)(p.ws + WS_Z1S);
    bf16_t* yfm = (bf16_t*)(p.ws + WS_YFM);
    for (int id = blockIdx.x; id < 512; id += gridDim.x) {
        if (id < 256) {
            const int bg = id >> 5, rem = id & 31, mt = rem >> 1, nt = rem & 1;
            f32x16 acc[1][2]; zero_acc<1>(acc);
            gemm_mainloop<1, 128>(acc, apos + (size_t)mt * 128 * 4096, 4096, z1s + (size_t)(bg * 256 + nt * 128) * 4096, 4096, 4096, lds);
            const int b = bg >> 2, g = bg & 3;
            for_each_acc<1>(acc, mt * 128, nt * 128, [&](int lp, int chp, float& v) { yfm[(size_t)(TP + b * 2048 + lp) * 1024 + g * 256 + chp] = f2bf(v); });
        } else {
            const int i2 = id - 256, bg = i2 >> 1, nt = i2 & 1;
            f32x16 acc[2][2]; zero_acc<2>(acc);
            gemm_mainloop<2>(acc, a256, 512, z1p + (size_t)(bg * 256 + nt * 128) * 512, 512, 512, lds);
            const int b = bg >> 2, g = bg & 3;
            for_each_acc<2>(acc, 0, nt * 128, [&](int lp, int chp, float& v) { yfm[(size_t)(b * 256 + lp) * 1024 + g * 256 + chp] = f2bf(v); });
        }
    }
}

__device__ __forceinline__ void ssd_item(const Params& p, int seq, int h, int mode, unsigned char* lds) {
    const int tid = tid_opaque(), lane = tid & 63, wid = tid >> 6;
    const bool samp = seq >= 32;
    const int nc = samp ? 16 : 2;
    const int q0 = samp ? 64 + (seq - 32) * 16 : seq * 2;
    const int g = h >> 3;
    unsigned char* sC = lds;
    unsigned char* sB = lds + 34816;
    unsigned char* sX = lds + 69632;
    unsigned char* sH = lds + 87040;
    unsigned char* sXw = lds + 104448;
    float* sCum = (float*)(lds + 121856);
    float* sDt = sCum + 128;
    const bf16_t* gXT = (const bf16_t*)(p.ws + WS_XT);
    const bf16_t* gCM = (const bf16_t*)(p.ws + WS_CM);
    const bf16_t* gBM = (const bf16_t*)(p.ws + WS_BM);
    const bf16_t* gBT = (const bf16_t*)(p.ws + WS_BT);
    const float* dtb = (const float*)(p.ws + WS_DTB);
    bf16_t* yssd = (mode == 1) ? (bf16_t*)(p.ws + WS_YSB2) - (size_t)TP * 2048 : (bf16_t*)(p.ws + WS_YSSD);
    const float Dh = p.in[15][h];
    const int npass = mode == 2 ? 2 : 1;
    const int wr = wid >> 1, wc = wid & 1;
    const int wp = wid >> 2, wn = wid & 3;
    const int l31o = lane & 31;

#pragma unroll 1
    for (int pass = 0; pass < npass; ++pass) {
        const int dir = mode == 2 ? 1 - pass : mode;
        const bool rmw = (mode == 2 && pass == 1);
        const float Aneg = -__expf(p.in[14][dir * 32 + h]);
        f32x16 hacc;
        if (samp) {
            const float* st = p.in[2 + dir] + (size_t)((seq - 32) * 32 + h) * 8192;
#pragma unroll
            for (int r = 0; r < 16; ++r) hacc[r] = st[(wp * 32 + rowmap(r, lane)) * 128 + wn * 32 + l31o];
        } else {
#pragma unroll
            for (int r = 0; r < 16; ++r) hacc[r] = 0.f;
        }
#pragma unroll 1
        for (int step = 0; step < nc; ++step) {
            int ln = lane; asm volatile("" : "+v"(ln));
            const int l31 = ln & 31, lh = ln >> 5;
            const int c = dir == 0 ? step : nc - 1 - step;
            const int q = q0 + c, t0 = q * 128;
            if (wid == 0) {
                const float d0 = dtb[(size_t)(t0 + 2 * lane) * 64 + dir * 32 + h], d1 = dtb[(size_t)(t0 + 2 * lane + 1) * 64 + dir * 32 + h];
                const float a0 = d0 * Aneg, a1 = d1 * Aneg, s = a0 + a1;
                float sc = s;
#pragma unroll
                for (int o = 1; o < 64; o <<= 1) { const float n = __shfl_up(sc, o); if (lane >= o) sc += n; }
                const float tot = __shfl(sc, 63);
                const float ex = sc - s;
                float c0 = ex + a0, c1 = ex + a0 + a1;
                if (dir == 1) { c0 = tot - c0 + a0; c1 = tot - c1 + a1; }
                sCum[2 * lane] = c0; sCum[2 * lane + 1] = c1; sDt[2 * lane] = d0; sDt[2 * lane + 1] = d1;
            }
            const bf16_t* srcC = gCM + (size_t)(q * 4 + g) * 16384;
            const bf16_t* srcB = gBM + (size_t)(q * 4 + g) * 16384;
            const bf16_t* srcBT = gBT + (size_t)(q * 4 + g) * 16384;
            const bf16_t* srcX = gXT + (size_t)(q * 32 + h) * 8192;
            const int lrow = tid >> 4, lv = tid & 15;
            const int goff = lrow * 128 + lv * 8, soff = lrow * 272 + lv * 16;
#pragma unroll
            for (int i = 0; i < 4; ++i) {
                *(uint4*)(sC + soff + i * 32 * 272) = *(const uint4*)(srcC + goff + i * 32 * 128);
                *(uint4*)(sB + soff + i * 32 * 272) = *(const uint4*)(srcB + goff + i * 32 * 128); }
            const uint4 rbt0 = *(const uint4*)(srcBT + goff), rbt1 = *(const uint4*)(srcBT + goff + 32 * 128);
            const uint4 rbt2 = *(const uint4*)(srcBT + goff + 64 * 128), rbt3 = *(const uint4*)(srcBT + goff + 96 * 128);
            bf16_t* yp = yssd + (size_t)t0 * 2048 + h * 64 + wc * 32 + l31;
            f32x16 yprev;
#pragma unroll
            for (int r = 0; r < 16; ++r) yprev[r] = 0.f;
            if (rmw) {
#pragma unroll
                for (int r = 0; r < 16; ++r) yprev[r] = bf2f(yp[(size_t)(wr * 32 + rowmap(r, ln)) * 2048]);
            }
            const uint4 rx0 = *(const uint4*)(srcX + goff), rx1 = *(const uint4*)(srcX + goff + 32 * 128);
            *(uint4*)(sX + soff) = rx0; *(uint4*)(sX + soff + 32 * 272) = rx1;
#pragma unroll
            for (int r = 0; r < 16; ++r) *(bf16_t*)(sH + (wp * 32 + rowmap(r, ln)) * 272 + (wn * 32 + l31) * 2) = f2bf(hacc[r]);
            __syncthreads();
            const float cend = dir == 0 ? sCum[127] : sCum[0];
            {
                float wj[8];
#pragma unroll
                for (int u = 0; u < 8; ++u) wj[u] = __expf(cend - sCum[lv * 8 + u]) * sDt[lv * 8 + u];
#define XW(w, a, b) pk2(__uint_as_float((w) << 16) * wj[a], __uint_as_float((w) & 0xffff0000u) * wj[b])
                *(uint4*)(sXw + soff) = make_uint4(XW(rx0.x, 0, 1), XW(rx0.y, 2, 3), XW(rx0.z, 4, 5), XW(rx0.w, 6, 7));
                *(uint4*)(sXw + soff + 32 * 272) = make_uint4(XW(rx1.x, 0, 1), XW(rx1.y, 2, 3), XW(rx1.z, 4, 5), XW(rx1.w, 6, 7));
#undef XW
            }
            f32x16 cb0, cb1, yo;
#pragma unroll
            for (int r = 0; r < 16; ++r) { cb0[r] = 0.f; cb1[r] = 0.f; yo[r] = 0.f; }
#pragma unroll 2
            for (int ks = 0; ks < 8; ++ks) {
                const int ko = ks * 32 + lh * 16;
                const bf16x8 a = *(const bf16x8*)(sC + (wr * 32 + l31) * 272 + ko);
                const bf16x8 b0 = *(const bf16x8*)(sB + (wc * 64 + l31) * 272 + ko);
                const bf16x8 b1 = *(const bf16x8*)(sB + (wc * 64 + 32 + l31) * 272 + ko);
                const bf16x8 bh = *(const bf16x8*)(sH + (wc * 32 + l31) * 272 + ko);
                cb0 = __builtin_amdgcn_mfma_f32_32x32x16_bf16(a, b0, cb0, 0, 0, 0);
                cb1 = __builtin_amdgcn_mfma_f32_32x32x16_bf16(a, b1, cb1, 0, 0, 0);
                yo = __builtin_amdgcn_mfma_f32_32x32x16_bf16(a, bh, yo, 0, 0, 0);
            }
            {
                const int j0 = wc * 64 + l31, j1 = j0 + 32;
                const float cj0 = sCum[j0], cj1 = sCum[j1], dj0 = sDt[j0], dj1 = sDt[j1];
#pragma unroll
                for (int r = 0; r < 16; ++r) {
                    const int i = wr * 32 + rowmap(r, ln); const float ci = sCum[i];
                    const bool v0 = dir == 0 ? (j0 <= i) : (j0 >= i), v1 = dir == 0 ? (j1 <= i) : (j1 >= i);
                    float m0 = v0 ? cb0[r] * __expf(ci - cj0) * dj0 : 0.f;
                    float m1 = v1 ? cb1[r] * __expf(ci - cj1) * dj1 : 0.f;
                    if (dir == 0) { if (i == j0) m0 += Dh; if (i == j1) m1 += Dh; }
                    cb0[r] = m0; cb1[r] = m1;
                    yo[r] *= __expf(ci);
                }
            }
            __syncthreads();
            {
                const int j0 = wc * 64 + l31;
#pragma unroll
                for (int r = 0; r < 16; ++r) { const int i = wr * 32 + rowmap(r, ln);
                    *(bf16_t*)(sB + i * 272 + j0 * 2) = f2bf(cb0[r]); *(bf16_t*)(sB + i * 272 + (j0 + 32) * 2) = f2bf(cb1[r]); }
                *(uint4*)(sC + soff) = rbt0; *(uint4*)(sC + soff + 32 * 272) = rbt1; *(uint4*)(sC + soff + 64 * 272) = rbt2; *(uint4*)(sC + soff + 96 * 272) = rbt3;
            }
            __syncthreads();
            const float cdec = __expf(cend);
#pragma unroll
            for (int r = 0; r < 16; ++r) hacc[r] *= cdec;
#pragma unroll 2
            for (int ks = 0; ks < 8; ++ks) {
                const int ko = ks * 32 + lh * 16;
                const bf16x8 am = *(const bf16x8*)(sB + (wr * 32 + l31) * 272 + ko);
                const bf16x8 bx = *(const bf16x8*)(sX + (wc * 32 + l31) * 272 + ko);
                yo = __builtin_amdgcn_mfma_f32_32x32x16_bf16(am, bx, yo, 0, 0, 0);
                const bf16x8 ax = *(const bf16x8*)(sXw + (wp * 32 + l31) * 272 + ko);
                const bf16x8 bb = *(const bf16x8*)(sC + (wn * 32 + l31) * 272 + ko);
                hacc = __builtin_amdgcn_mfma_f32_32x32x16_bf16(ax, bb, hacc, 0, 0, 0);
            }
            {
#pragma unroll
                for (int r = 0; r < 16; ++r) { const int i = wr * 32 + rowmap(r, ln); yp[(size_t)i * 2048] = f2bf(yo[r] + yprev[r]); }
            }
            __syncthreads();
        }
        if (!samp) {
            float* dst = p.out + (size_t)T * 1024 + (size_t)dir * 8388608 + (size_t)(seq * 32 + h) * 8192;
#pragma unroll
            for (int r = 0; r < 16; ++r) dst[(wp * 32 + rowmap(r, lane)) * 128 + wn * 32 + l31o] = hacc[r];
        }
    }
}

template <bool ALPHA, bool BETA>
__device__ __forceinline__ void ssd_cstep(const Params& p, unsigned char* lds, int q, int h, float AnegF, float AnegB, float Dh,
                                          const f32x16& enter, int enterDir, bool scaleB, f32x16& accF, f32x16& accB, float& piF) {
    const int tid = tid_opaque(), lane = tid & 63, wid = tid >> 6;
    const int g = h >> 3, t0 = q * 128;
    unsigned char* sC = lds;
    unsigned char* sB = lds + 34816;
    unsigned char* sX = lds + 69632;
    unsigned char* sH = lds + 87040;
    unsigned char* sXwF = lds + 104448;
    unsigned char* sXwB = lds + 121856;
    float* sCumF = (float*)(lds + 139264);
    float* sCumB = sCumF + 128;
    float* sDtF = sCumF + 256;
    float* sDtB = sCumF + 384;
    const bf16_t* srcC = (const bf16_t*)(p.ws + WS_CM) + (size_t)(q * 4 + g) * 16384;
    const bf16_t* srcB = (const bf16_t*)(p.ws + WS_BM) + (size_t)(q * 4 + g) * 16384;
    const bf16_t* srcBT = (const bf16_t*)(p.ws + WS_BT) + (size_t)(q * 4 + g) * 16384;
    const bf16_t* srcX = (const bf16_t*)(p.ws + WS_XT) + (size_t)(q * 32 + h) * 8192;
    const float* dtb = (const float*)(p.ws + WS_DTB);
    bf16_t* yssd = (bf16_t*)(p.ws + WS_YSSD);
    const int wr = wid >> 1, wc = wid & 1, wp = wid >> 2, wn = wid & 3;
    const int l31 = lane & 31, lh = lane >> 5;
    if (wid == 0) {
        const float f0 = dtb[(size_t)(t0 + 2 * lane) * 64 + h], f1 = dtb[(size_t)(t0 + 2 * lane + 1) * 64 + h];
        const float b0 = dtb[(size_t)(t0 + 2 * lane) * 64 + 32 + h], b1 = dtb[(size_t)(t0 + 2 * lane + 1) * 64 + 32 + h];
        const float af0 = f0 * AnegF, af1 = f1 * AnegF, ab0 = b0 * AnegB, ab1 = b1 * AnegB;
        float sf = af0 + af1, sb = ab0 + ab1;
        const float sf0 = sf, sb0 = sb;
#pragma unroll
        for (int o = 1; o < 64; o <<= 1) { const float nf = __shfl_up(sf, o), nb = __shfl_up(sb, o); if (lane >= o) { sf += nf; sb += nb; } }
        const float totb = __shfl(sb, 63);
        const float exf = sf - sf0, exb = sb - sb0;
        sCumF[2 * lane] = exf + af0; sCumF[2 * lane + 1] = exf + af0 + af1;
        sCumB[2 * lane] = totb - exb; sCumB[2 * lane + 1] = totb - exb - ab0;
        sDtF[2 * lane] = f0; sDtF[2 * lane + 1] = f1; sDtB[2 * lane] = b0; sDtB[2 * lane + 1] = b1;
    }
    const int lrow = tid >> 4, lv = tid & 15;
    const int goff = lrow * 128 + lv * 8, soff = lrow * 272 + lv * 16;
    if (BETA) {
#pragma unroll
        for (int i = 0; i < 4; ++i) {
            *(uint4*)(sC + soff + i * 32 * 272) = *(const uint4*)(srcC + goff + i * 32 * 128);
            *(uint4*)(sB + soff + i * 32 * 272) = *(const uint4*)(srcB + goff + i * 32 * 128); }
    }
    uint4 rbt0 = make_uint4(0, 0, 0, 0), rbt1 = rbt0, rbt2 = rbt0, rbt3 = rbt0;
    if (ALPHA) {
        rbt0 = *(const uint4*)(srcBT + goff); rbt1 = *(const uint4*)(srcBT + goff + 32 * 128);
        rbt2 = *(const uint4*)(srcBT + goff + 64 * 128); rbt3 = *(const uint4*)(srcBT + goff + 96 * 128);
        if (!BETA) { *(uint4*)(sC + soff) = rbt0; *(uint4*)(sC + soff + 32 * 272) = rbt1; *(uint4*)(sC + soff + 64 * 272) = rbt2; *(uint4*)(sC + soff + 96 * 272) = rbt3; }
    }
    const uint4 rx0 = *(const uint4*)(srcX + goff), rx1 = *(const uint4*)(srcX + goff + 32 * 128);
    if (BETA) {
        *(uint4*)(sX + soff) = rx0; *(uint4*)(sX + soff + 32 * 272) = rx1;
#pragma unroll
        for (int r = 0; r < 16; ++r) *(bf16_t*)(sH + (wp * 32 + rowmap(r, lane)) * 272 + (wn * 32 + l31) * 2) = f2bf(enter[r]);
    }
    __syncthreads();
    const float pF = __expf(sCumF[127]), pB = __expf(sCumB[0]);
    if (ALPHA) {
        float wf[8], wb[8];
#pragma unroll
        for (int u = 0; u < 8; ++u) { wf[u] = __expf(sCumF[127] - sCumF[lv * 8 + u]) * sDtF[lv * 8 + u]; wb[u] = __expf(sCumB[0] - sCumB[lv * 8 + u]) * sDtB[lv * 8 + u]; }
#define XWF(w, a, b) pk2(__uint_as_float((w) << 16) * wf[a], __uint_as_float((w) & 0xffff0000u) * wf[b])
#define XWB(w, a, b) pk2(__uint_as_float((w) << 16) * wb[a], __uint_as_float((w) & 0xffff0000u) * wb[b])
        *(uint4*)(sXwF + soff) = make_uint4(XWF(rx0.x, 0, 1), XWF(rx0.y, 2, 3), XWF(rx0.z, 4, 5), XWF(rx0.w, 6, 7));
        *(uint4*)(sXwF + soff + 32 * 272) = make_uint4(XWF(rx1.x, 0, 1), XWF(rx1.y, 2, 3), XWF(rx1.z, 4, 5), XWF(rx1.w, 6, 7));
        *(uint4*)(sXwB + soff) = make_uint4(XWB(rx0.x, 0, 1), XWB(rx0.y, 2, 3), XWB(rx0.z, 4, 5), XWB(rx0.w, 6, 7));
        *(uint4*)(sXwB + soff + 32 * 272) = make_uint4(XWB(rx1.x, 0, 1), XWB(rx1.y, 2, 3), XWB(rx1.z, 4, 5), XWB(rx1.w, 6, 7));
#undef XWF
#undef XWB
    }
    f32x16 yo;
#pragma unroll
    for (int r = 0; r < 16; ++r) yo[r] = 0.f;
    if (BETA) {
        f32x16 cb0, cb1;
#pragma unroll
        for (int r = 0; r < 16; ++r) { cb0[r] = 0.f; cb1[r] = 0.f; }
#pragma unroll 2
        for (int ks = 0; ks < 8; ++ks) {
            const int ko = ks * 32 + lh * 16;
            const bf16x8 a = *(const bf16x8*)(sC + (wr * 32 + l31) * 272 + ko);
            const bf16x8 b0 = *(const bf16x8*)(sB + (wc * 64 + l31) * 272 + ko);
            const bf16x8 b1 = *(const bf16x8*)(sB + (wc * 64 + 32 + l31) * 272 + ko);
            const bf16x8 bh = *(const bf16x8*)(sH + (wc * 32 + l31) * 272 + ko);
            cb0 = __builtin_amdgcn_mfma_f32_32x32x16_bf16(a, b0, cb0, 0, 0, 0);
            cb1 = __builtin_amdgcn_mfma_f32_32x32x16_bf16(a, b1, cb1, 0, 0, 0);
            yo = __builtin_amdgcn_mfma_f32_32x32x16_bf16(a, bh, yo, 0, 0, 0);
        }
        {
            const int j0 = wc * 64 + l31, j1 = j0 + 32;
            const float fj0 = sCumF[j0], fj1 = sCumF[j1], bj0 = sCumB[j0], bj1 = sCumB[j1];
            const float df0 = sDtF[j0], df1 = sDtF[j1], db0 = sDtB[j0], db1 = sDtB[j1];
            const float* sCe = enterDir == 0 ? sCumF : sCumB;
#pragma unroll
            for (int r = 0; r < 16; ++r) {
                const int i = wr * 32 + rowmap(r, lane); const float fi = sCumF[i], bi = sCumB[i];
                const float e0 = j0 <= i ? __expf(fi - fj0) * df0 : 0.f, g0 = j0 >= i ? __expf(bi - bj0) * db0 : 0.f;
                const float e1 = j1 <= i ? __expf(fi - fj1) * df1 : 0.f, g1 = j1 >= i ? __expf(bi - bj1) * db1 : 0.f;
                float m0 = cb0[r] * (e0 + g0), m1 = cb1[r] * (e1 + g1);
                if (i == j0) m0 += Dh;
                if (i == j1) m1 += Dh;
                cb0[r] = m0; cb1[r] = m1;
                yo[r] *= __expf(sCe[i]);
            }
        }
        __syncthreads();
        {
            const int j0 = wc * 64 + l31;
#pragma unroll
            for (int r = 0; r < 16; ++r) { const int i = wr * 32 + rowmap(r, lane);
                *(bf16_t*)(sB + i * 272 + j0 * 2) = f2bf(cb0[r]); *(bf16_t*)(sB + i * 272 + (j0 + 32) * 2) = f2bf(cb1[r]); }
            if (ALPHA) { *(uint4*)(sC + soff) = rbt0; *(uint4*)(sC + soff + 32 * 272) = rbt1; *(uint4*)(sC + soff + 64 * 272) = rbt2; *(uint4*)(sC + soff + 96 * 272) = rbt3; }
        }
    }
    __syncthreads();
    if (ALPHA) {
        if (scaleB) {
#pragma unroll
            for (int r = 0; r < 16; ++r) accB[r] *= pB;
        }
    }
#pragma unroll 2
    for (int ks = 0; ks < 8; ++ks) {
        const int ko = ks * 32 + lh * 16;
        if (BETA) {
            const bf16x8 am = *(const bf16x8*)(sB + (wr * 32 + l31) * 272 + ko);
            const bf16x8 bx = *(const bf16x8*)(sX + (wc * 32 + l31) * 272 + ko);
            yo = __builtin_amdgcn_mfma_f32_32x32x16_bf16(am, bx, yo, 0, 0, 0);
        }
        if (ALPHA) {
            const bf16x8 bb = *(const bf16x8*)(sC + (wn * 32 + l31) * 272 + ko);
            const bf16x8 axf = *(const bf16x8*)(sXwF + (wp * 32 + l31) * 272 + ko);
            const bf16x8 axb = *(const bf16x8*)(sXwB + (wp * 32 + l31) * 272 + ko);
            accF = __builtin_amdgcn_mfma_f32_32x32x16_bf16(axf, bb, accF, 0, 0, 0);
            accB = __builtin_amdgcn_mfma_f32_32x32x16_bf16(axb, bb, accB, 0, 0, 0);
        }
    }
    if (BETA) {
        bf16_t* yp = yssd + (size_t)t0 * 2048 + h * 64 + wc * 32 + l31;
#pragma unroll
        for (int r = 0; r < 16; ++r) { const int i = wr * 32 + rowmap(r, lane); yp[(size_t)i * 2048] = f2bf(yo[r]); }
    }
    piF = pF;
    __syncthreads();
}

__device__ __forceinline__ void ssd_prompt_item(const Params& p, int seq, int h, unsigned char* lds) {
    const int lane = tid_opaque() & 63, wid = tid_opaque() >> 6, wp = wid >> 2, wn = wid & 3, l31 = lane & 31;
    const float AnegF = -__expf(p.in[14][h]), AnegB = -__expf(p.in[14][32 + h]), Dh = p.in[15][h];
    const int q0 = seq * 2;
    f32x16 SF1, SB, SF0, zero;
#pragma unroll
    for (int r = 0; r < 16; ++r) { SF1[r] = 0.f; SB[r] = 0.f; SF0[r] = 0.f; zero[r] = 0.f; }
    float piF1 = 1.f, piF0 = 1.f;
    ssd_cstep<true, false>(p, lds, q0 + 1, h, AnegF, AnegB, Dh, zero, 0, false, SF1, SB, piF1);
    ssd_cstep<true, true>(p, lds, q0, h, AnegF, AnegB, Dh, SB, 1, true, SF0, SB, piF0);
    {
        float* dstF = p.out + (size_t)T * 1024 + (size_t)(seq * 32 + h) * 8192;
        float* dstB = dstF + 8388608;
#pragma unroll
        for (int r = 0; r < 16; ++r) { const int o = (wp * 32 + rowmap(r, lane)) * 128 + wn * 32 + l31; dstF[o] = SF0[r] * piF1 + SF1[r]; dstB[o] = SB[r]; }
    }
    ssd_cstep<false, true>(p, lds, q0 + 1, h, AnegF, AnegB, Dh, SF0, 0, false, SF1, SB, piF0);
}

__device__ __forceinline__ void phase_ssd(const Params& p, unsigned char* lds) {
    const int G = gridDim.x, b = blockIdx.x;
    const bool bal = (G == 256);
    if (!bal || b < 128) {
#pragma unroll 1
        for (int v = b; v < 128; v += G) ssd_item(p, 32 + (v >> 6), v & 31, (v >> 5) & 1, lds);
    }
    const int p0 = bal ? (b < 128 ? 896 + b : (b - 128) * 7) : b, pstep = bal ? 1 : G, pend = bal ? (b < 128 ? 897 + b : (b - 128) * 7 + 7) : 1024;
#pragma unroll 1
    for (int pi = p0; pi < pend; pi += pstep) ssd_prompt_item(p, pi >> 5, pi & 31, lds);
}

__device__ __forceinline__ void phase_combine(const Params& p) {
    const int lane = tid_opaque() & 63, wid = tid_opaque() >> 6;
    bf16_t* yssd = (bf16_t*)(p.ws + WS_YSSD);
    const bf16_t* zs = (const bf16_t*)(p.ws + WS_ZS);
    const bf16_t* ysb2 = (const bf16_t*)(p.ws + WS_YSB2);
    const float* g = p.in[16];
    for (int t = blockIdx.x * 8 + wid; t < T; t += gridDim.x * 8) {
        float y[32]; float ss = 0.f;
#pragma unroll
        for (int i = 0; i < 4; ++i) { const int c = i * 512 + lane * 8;
            const uint4 a = *(const uint4*)(yssd + (size_t)t * 2048 + c), b = *(const uint4*)(zs + (size_t)t * 2048 + c);
            uint4 a2 = make_uint4(0u, 0u, 0u, 0u);
            if (t >= TP) a2 = *(const uint4*)(ysb2 + (size_t)(t - TP) * 2048 + c);
            const unsigned aw[4] = {a.x, a.y, a.z, a.w}, bw[4] = {b.x, b.y, b.z, b.w}, cw[4] = {a2.x, a2.y, a2.z, a2.w};
#pragma unroll
            for (int u = 0; u < 4; ++u) { const float y0 = (__uint_as_float(aw[u] << 16) + __uint_as_float(cw[u] << 16)) * siluf(__uint_as_float(bw[u] << 16)), y1 = (__uint_as_float(aw[u] & 0xffff0000u) + __uint_as_float(cw[u] & 0xffff0000u)) * siluf(__uint_as_float(bw[u] & 0xffff0000u));
                y[i * 8 + 2 * u] = y0; y[i * 8 + 2 * u + 1] = y1; ss += y0 * y0 + y1 * y1; } }
#pragma unroll
        for (int o = 32; o > 0; o >>= 1) ss += __shfl_xor(ss, o);
        const float rstd = rsqrtf(ss * (1.f / 2048.f) + 1e-6f);
#pragma unroll
        for (int i = 0; i < 4; ++i) { const int c = i * 512 + lane * 8; const float4 g0 = *(const float4*)(g + c), g1 = *(const float4*)(g + c + 4);
            *(uint4*)(yssd + (size_t)t * 2048 + c) = make_uint4(pk2(y[i * 8] * rstd * g0.x, y[i * 8 + 1] * rstd * g0.y), pk2(y[i * 8 + 2] * rstd * g0.z, y[i * 8 + 3] * rstd * g0.w),
                                                                pk2(y[i * 8 + 4] * rstd * g1.x, y[i * 8 + 5] * rstd * g1.y), pk2(y[i * 8 + 6] * rstd * g1.z, y[i * 8 + 7] * rstd * g1.w)); }
    }
}

struct EpiMerge {
    static constexpr bool PERM = true, AFTER_DRAIN = false;
    bf16_t* m; const bf16_t* gates; int second;
    __device__ __forceinline__ void operator()(const pg8::f32x4 (&acc)[2][2][4][2], const pg8::Unit& u, int wr, int wc, int fr, int fq) const {
#pragma unroll
        for (int ai = 0; ai < 2; ++ai)
#pragma unroll
            for (int mm = 0; mm < 4; ++mm) {
                const int row = u.pm * 256 + ai * 128 + wr * 64 + mm * 16 + fr;
#pragma unroll
                for (int bj = 0; bj < 2; ++bj) {
                    const int col = u.pn * 256 + bj * 128 + wc * 32 + 8 * fq;
                    const pg8::f32x4 v0 = acc[ai][bj][mm][0], v1 = acc[ai][bj][mm][1];
                    const uint4 gq = *(const uint4*)(gates + (size_t)row * 2048 + (second ? 1024 : 0) + col);
                    const float4 g0 = bf4_to_f4(make_uint2(gq.x, gq.y)), g1 = bf4_to_f4(make_uint2(gq.z, gq.w));
                    uint4* d = (uint4*)(m + (size_t)row * 1024 + col);
                    float4 o0 = make_float4(0.f, 0.f, 0.f, 0.f), o1 = o0;
                    if (second) { const uint4 oq = *d; o0 = bf4_to_f4(make_uint2(oq.x, oq.y)); o1 = bf4_to_f4(make_uint2(oq.z, oq.w)); }
                    *d = make_uint4(pk2(o0.x + v0[0] * g0.x, o0.y + v0[1] * g0.y), pk2(o0.z + v0[2] * g0.z, o0.w + v0[3] * g0.w),
                                    pk2(o1.x + v1[0] * g1.x, o1.y + v1[1] * g1.y), pk2(o1.z + v1[2] * g1.z, o1.w + v1[3] * g1.w));
                }
            }
    }
};

struct EpiGateBf16 {
    static constexpr bool PERM = true, AFTER_DRAIN = false;
    bf16_t* R; const float* mod; int gate_off;
    __device__ __forceinline__ void operator()(const pg8::f32x4 (&acc)[2][2][4][2], const pg8::Unit& u, int wr, int wc, int fr, int fq) const {
#pragma unroll
        for (int ai = 0; ai < 2; ++ai)
#pragma unroll
            for (int mm = 0; mm < 4; ++mm) {
                const int row = u.pm * 256 + ai * 128 + wr * 64 + mm * 16 + fr;
                const float* gp = mod + modidx(row) * 6144 + gate_off;
#pragma unroll
                for (int bj = 0; bj < 2; ++bj) {
                    const int col = u.pn * 256 + bj * 128 + wc * 32 + 8 * fq;
                    const pg8::f32x4 v0 = acc[ai][bj][mm][0], v1 = acc[ai][bj][mm][1];
                    const float4 g0 = *(const float4*)(gp + col), g1 = *(const float4*)(gp + col + 4);
                    *(uint4*)(R + (size_t)row * 1024 + col) = make_uint4(pk2(g0.x * v0[0], g0.y * v0[1]), pk2(g0.z * v0[2], g0.w * v0[3]), pk2(g1.x * v1[0], g1.y * v1[1]), pk2(g1.z * v1[2], g1.w * v1[3]));
                }
            }
    }
};

struct EpiResid {
    static constexpr bool PERM = false, AFTER_DRAIN = false;
    float* out; const float* xp; const float* xs; const float* mod; int gate_off; int inplace;
    __device__ __forceinline__ void operator()(const pg8::f32x4 (&acc)[2][2][4][2], const pg8::Unit& u, int wr, int wc, int fr, int fq) const {
#pragma unroll
        for (int ai = 0; ai < 2; ++ai)
#pragma unroll
            for (int mm = 0; mm < 4; ++mm) {
                const int row = u.pm * 256 + ai * 128 + wr * 64 + mm * 16 + fr;
                const float* gp = mod + modidx(row) * 6144 + gate_off;
                float* orow = out + (size_t)row * 1024;
                const float* brow = inplace ? orow : (row < TP ? xp + (size_t)row * 1024 : xs + (size_t)(row - TP) * 1024);
#pragma unroll
                for (int bj = 0; bj < 2; ++bj)
#pragma unroll
                    for (int n = 0; n < 2; ++n) {
                        const int col = u.pn * 256 + bj * 128 + wc * 32 + 16 * n + 4 * fq;
                        const pg8::f32x4 v = acc[ai][bj][mm][n];
                        const float4 x = *(const float4*)(brow + col), g = *(const float4*)(gp + col);
                        *(float4*)(orow + col) = make_float4(x.x + g.x * v[0], x.y + g.y * v[1], x.z + g.z * v[2], x.w + g.w * v[3]);
                    }
            }
    }
};

__device__ __forceinline__ void phase_merge(const Params& p, unsigned char* lds) {
    const bf16_t* gates = (const bf16_t*)((unsigned char*)p.out + DO_GATES);
    bf16_t* m = (bf16_t*)(p.ws + WS_M);
    pg8::StaticOrder S; S.init(T, 1024, (int)gridDim.x, (int)blockIdx.x);
    if (gridDim.x == 256 && blockIdx.x >= 192) {
#pragma unroll 1
        for (int tI = 2832 + ((int)blockIdx.x - 192); tI < 5136; tI += 64) transpose_tile(p, tI, lds);
        return;
    }
    {
        pg8::Gemm g{(const bf16_t*)(p.ws + WS_YFM), (const bf16_t*)(p.ws + WS_WF), T, 1024, 1024};
        EpiMerge E{m, gates, 0};
        pg8::gemm_phase<EpiMerge, pg8::StaticOrder, false>((PG8_LAS unsigned char*)lds, g, S, E, nullptr);
    }
    {
        pg8::Gemm g{(const bf16_t*)(p.ws + WS_YSSD), (const bf16_t*)(p.ws + WS_WSO), T, 1024, 2048};
        EpiMerge E{m, gates, 1};
        pg8::gemm_phase<EpiMerge, pg8::StaticOrder, false>((PG8_LAS unsigned char*)lds, g, S, E, nullptr);
    }
}

__device__ __forceinline__ void phase_out(const Params& p, unsigned char* lds) {
    pg8::Gemm g{(const bf16_t*)(p.ws + WS_M), (const bf16_t*)(p.ws + WS_WO), T, 1024, 1024};
    pg8::StaticOrder S; S.init(T, 1024, (int)gridDim.x, (int)blockIdx.x);
    EpiGateBf16 E{(bf16_t*)(p.ws + WS_R), (const float*)(p.ws + WS_MOD), 2048};
    pg8::gemm_phase<EpiGateBf16, pg8::StaticOrder, false>((PG8_LAS unsigned char*)lds, g, S, E, nullptr);
}

struct EpiFF1 {
    static constexpr bool PERM = true, AFTER_DRAIN = false;
    bf16_t* f;
    __device__ __forceinline__ void operator()(const pg8::f32x4 (&acc)[2][2][4][2], const pg8::Unit& u, int wr, int wc, int fr, int fq) const {
#pragma unroll
        for (int ai = 0; ai < 2; ++ai)
#pragma unroll
            for (int m = 0; m < 4; ++m) {
                bf16_t* rowp = f + (size_t)(u.pm * 256 + ai * 128 + wr * 64 + m * 16 + fr) * 4096 + u.pn * 256 + wc * 32 + 8 * fq;
#pragma unroll
                for (int bj = 0; bj < 2; ++bj) {
                    const pg8::f32x4 v0 = acc[ai][bj][m][0], v1 = acc[ai][bj][m][1];
                    const float r0 = fmaxf(v0[0], 0.f), r1 = fmaxf(v0[1], 0.f), r2 = fmaxf(v0[2], 0.f), r3 = fmaxf(v0[3], 0.f);
                    const float r4 = fmaxf(v1[0], 0.f), r5 = fmaxf(v1[1], 0.f), r6 = fmaxf(v1[2], 0.f), r7 = fmaxf(v1[3], 0.f);
                    *(uint4*)(rowp + bj * 128) = make_uint4(pk2(r0 * r0, r1 * r1), pk2(r2 * r2, r3 * r3), pk2(r4 * r4, r5 * r5), pk2(r6 * r6, r7 * r7));
                }
            }
    }
};

__device__ __forceinline__ void phase_ff1(const Params& p, unsigned char* lds) {
    pg8::Gemm g{(const bf16_t*)(p.ws + WS_H2), (const bf16_t*)(p.ws + WS_W1), T, 4096, 1024};
    pg8::StaticOrder S; S.init(T, 4096, (int)gridDim.x, (int)blockIdx.x);
    EpiFF1 E{(bf16_t*)(p.ws + WS_F)};
    pg8::gemm_phase<EpiFF1, pg8::StaticOrder, false>((PG8_LAS unsigned char*)lds, g, S, E, nullptr);
}

__device__ __forceinline__ void phase_ff2(const Params& p, unsigned char* lds) {
    pg8::Gemm g{(const bf16_t*)(p.ws + WS_F), (const bf16_t*)(p.ws + WS_W2), T, 1024, 4096};
    pg8::StaticOrder S; S.init(T, 1024, (int)gridDim.x, (int)blockIdx.x);
    EpiGateBf16 E{(bf16_t*)(p.ws + WS_R), (const float*)(p.ws + WS_MOD), 5120};
    pg8::gemm_phase<EpiGateBf16, pg8::StaticOrder, false>((PG8_LAS unsigned char*)lds, g, S, E, nullptr);
}

__global__ void __launch_bounds__(NT) fwd_megakernel(Params p) {
    extern __shared__ __attribute__((aligned(16))) unsigned char lds[];
    cg::grid_group grid = cg::this_grid();
    if (__builtin_amdgcn_workitem_id_x() == 0) *(uint4*)(lds + LDS_ST) = make_uint4(0u, 0u, 0u, 0u);
    __syncthreads();
    if (blockIdx.x == 0) { unsigned* bw = (unsigned*)(p.ws + WS_BAR); for (int i = tid_opaque(); i < XCD_BAR_WORDS; i += NT) bw[i] = 0u; }
#define RUN(k, call) if (PH_ON(k) && p.ph_lo <= (k) && (k) < p.ph_hi) { call; } if ((k) == REPEAT_PH) { call; } if (p.ph_lo <= (k) && (k) + 1 < p.ph_hi) { if ((k) == 0) grid.sync(); else xcd_barrier(xb); }
    if (PH_ON(0) && p.ph_lo <= 0 && 0 < p.ph_hi) { phase_prep(p, lds); }
    grid.sync();
    XcdBarrier xb = xcd_barrier_post((unsigned*)(p.ws + WS_BAR), (volatile LAS unsigned*)(lds + LDS_ST));
    RUN(1, phase_norm(p, 0))
    RUN(2, phase_inproj(p, lds))
    RUN(3, phase_conv_f1(p, lds))
    RUN(4, phase_f1(p, lds))
    RUN(5, phase_f2(p, lds))
    RUN(6, phase_ssd(p, lds))
    RUN(7, phase_combine(p))
    RUN(8, phase_merge(p, lds))
    RUN(9, phase_out(p, lds))
    RUN(10, phase_norm(p, 1))
    RUN(11, phase_ff1(p, lds))
    RUN(12, phase_ff2(p, lds))
    if (PH_ON(13) && p.ph_lo <= 13 && 13 < p.ph_hi) phase_norm(p, 2);
}

extern "C" void kernel_launch(void* const* d_in, const int* in_sizes, int n_in, void* d_out, int out_size, void* d_ws, size_t ws_size, hipStream_t stream) {
    static int grid_blocks = 0;
    if (grid_blocks == 0) {
        if (n_in != 23 || ws_size < WS_END || out_size != T * 1024 + 2 * 8388608) { fprintf(stderr, "kernel_launch: unexpected shapes (n_in %d, ws %zu, out %d)\n", n_in, ws_size, out_size); grid_blocks = -1; return; }
        int dev = 0, cus = 0, per_cu = 0;
        (void)hipGetDevice(&dev);
        (void)hipDeviceGetAttribute(&cus, hipDeviceAttributeMultiprocessorCount, dev);
        if (hipFuncSetAttribute((const void*)fwd_megakernel, hipFuncAttributeMaxDynamicSharedMemorySize, LDS_BYTES) != hipSuccess) { fprintf(stderr, "kernel_launch: hipFuncSetAttribute failed\n"); grid_blocks = -1; return; }
        if (hipOccupancyMaxActiveBlocksPerMultiprocessor(&per_cu, (const void*)fwd_megakernel, NT, LDS_BYTES) != hipSuccess || per_cu < 1) { fprintf(stderr, "kernel_launch: occupancy query failed (%d)\n", per_cu); grid_blocks = -1; return; }
        grid_blocks = cus * per_cu;
    }
    if (grid_blocks < 0) return;
    Params p{};
    for (int i = 0; i < 23; ++i) p.in[i] = (const float*)d_in[i];
    p.out = (float*)d_out; p.ws = (unsigned char*)d_ws;
#if ONE_LAUNCH
    p.ph_lo = 0; p.ph_hi = NPH + 1;
    void* args[] = {&p};
    hipError_t e = hipLaunchCooperativeKernel((const void*)fwd_megakernel, dim3(grid_blocks), dim3(NT), args, LDS_BYTES, stream);
    if (e != hipSuccess) fprintf(stderr, "cooperative launch failed: %s (grid %d)\n", hipGetErrorString(e), grid_blocks);
#else
    for (int ph = 0; ph <= NPH; ++ph) {
        p.ph_lo = ph; p.ph_hi = ph + 1;
        hipLaunchKernelGGL(fwd_megakernel, dim3(grid_blocks), dim3(NT), LDS_BYTES, stream, p);
    }
#endif
}
```

```cpp
#include <hip/hip_runtime.h>
#include <hip/hip_cooperative_groups.h>
#include <cstdio>
#include <cstdint>
namespace cg = cooperative_groups;

#ifndef PHMASK
#define PHMASK 0xFFFF
#endif
#define PH_ON(n) ((PHMASK >> (n)) & 1)
#ifndef REPEAT_PH
#define REPEAT_PH -1
#endif
#ifndef ONE_LAUNCH
#define ONE_LAUNCH 1
#endif

typedef unsigned short bf16_t;
typedef short bf16x8 __attribute__((ext_vector_type(8)));
typedef float f32x16 __attribute__((ext_vector_type(16)));

#define NT 512
constexpr int T = 12288, TP = 8192;
constexpr int NPH = 13;
constexpr size_t MiB = 1048576;
constexpr size_t WS_WF = 0, WS_WSO = 2 * MiB, WS_WO = 6 * MiB, WS_W1 = 8 * MiB, WS_W2 = 16 * MiB;
constexpr size_t WS_CSC = 24 * MiB, WS_A256 = 24 * MiB + 262144, WS_MOD = 24 * MiB + 524288, WS_DTB = 25 * MiB;
constexpr size_t WS_WIN = 28 * MiB;
constexpr size_t WS_YSB2 = 28 * MiB;
constexpr size_t WS_ZS = 45 * MiB;
constexpr size_t WS_XBC = 93 * MiB;
constexpr size_t WS_Z1P = 93 * MiB;
constexpr size_t WS_Z1S = 125 * MiB;
constexpr size_t WS_YFM = 141 * MiB;
constexpr size_t WS_YSSD = 93 * MiB;
constexpr size_t WS_XT = 165 * MiB;
constexpr size_t WS_CM = 213 * MiB, WS_BM = 225 * MiB, WS_BT = 237 * MiB;
constexpr size_t WS_M = 165 * MiB;
constexpr size_t WS_H2 = 189 * MiB;
constexpr size_t WS_R = 141 * MiB;
constexpr size_t WS_F = 45 * MiB;
constexpr size_t WS_BAR = 249 * MiB;
constexpr size_t WS_END = 250 * MiB;
constexpr size_t DO_GATES = 0, DO_H1 = 48 * MiB, DO_UF = 72 * MiB, DO_APOS = 96 * MiB;
constexpr int LDS_ST = 147456;
constexpr int LDS_BYTES = 147472;

struct Params {
    const float* in[23];
    float* out;
    unsigned char* ws;
    int ph_lo, ph_hi;
};

__device__ __forceinline__ int tid_opaque() { int t = (int)__builtin_amdgcn_workitem_id_x(); asm volatile("" : "+v"(t)); return t; }
typedef __bf16 bf16x2v __attribute__((ext_vector_type(2)));
typedef float f32x2v __attribute__((ext_vector_type(2)));
__device__ __forceinline__ unsigned pk2(float lo, float hi) { f32x2v v = {lo, hi}; bf16x2v b = __builtin_convertvector(v, bf16x2v); return __builtin_bit_cast(unsigned, b); }
__device__ __forceinline__ bf16_t f2bf(float f) { return (bf16_t)(pk2(f, f) & 0xffffu); }
__device__ __forceinline__ float bf2f(bf16_t h) { return __uint_as_float(((unsigned)h) << 16); }
__device__ __forceinline__ float sigmf(float v) { return __builtin_amdgcn_rcpf(1.f + __expf(-v)); }
__device__ __forceinline__ float siluf(float v) { return v * sigmf(v); }
__device__ __forceinline__ int rowmap(int reg, int lane) { return (reg & 3) + 8 * (reg >> 2) + 4 * (lane >> 5); }


#define XB_TMO      128
#define XB_XCNT(j)  (256  + 64 * (j))
#define XB_XSUB(j)  (1280 + 64 * (j))
#define XB_XGEN(j)  (2304 + 64 * (j))
#define XB_TOP      3328
#define XB_TOPGEN   3392
#define XCD_BAR_WORDS 3456
#define XB_SPIN_CAP (1u << 18)
#define LAS __attribute__((address_space(3)))
__device__ __forceinline__ unsigned xb_ld(unsigned* p)              { return __hip_atomic_load(p, __ATOMIC_RELAXED, __HIP_MEMORY_SCOPE_AGENT); }
__device__ __forceinline__ unsigned xb_add(unsigned* p, unsigned v) { return __hip_atomic_fetch_add(p, v, __ATOMIC_RELAXED, __HIP_MEMORY_SCOPE_AGENT); }
__device__ __forceinline__ unsigned xb_xcc_id() { return (unsigned)__builtin_amdgcn_s_getreg((3 << 11) | 20) & 0xFu; }
#define XB_SPIN(cond, bar) do { unsigned _sp = 0; while (cond) { __builtin_amdgcn_s_sleep(1); \
    if ((++_sp & 255u) == 0u) { if (xb_ld(&(bar)[XB_TMO])) break; if (_sp > XB_SPIN_CAP) { atomicAdd(&(bar)[XB_TMO], 1u); break; } } } } while (0)
struct XcdBarrier { unsigned* bar; unsigned x; volatile LAS unsigned* st; };
__device__ __forceinline__ XcdBarrier xcd_barrier_post(unsigned* bar, volatile LAS unsigned* st) {
    XcdBarrier b; b.bar = bar; b.x = xb_xcc_id(); b.st = st;
    if (__builtin_amdgcn_workitem_id_x() == 0) (void)xb_add(&bar[XB_XCNT(b.x)], 1u);
    return b;
}
__device__ __forceinline__ void xcd_barrier_complete(unsigned* bar, unsigned x, unsigned& nloc, unsigned& nx) {
    const unsigned G = gridDim.x * gridDim.y * gridDim.z;
    unsigned sum, cnt, mine, sp = 0u;
    for (;;) {
        sum = 0u; cnt = 0u; mine = 0u;
#pragma unroll
        for (unsigned j = 0; j < 16; ++j) { const unsigned c = xb_ld(&bar[XB_XCNT(j)]); sum += c; cnt += (c > 0u) ? 1u : 0u; mine = (j == x) ? c : mine; }
        if (sum == G) break;
        __builtin_amdgcn_s_sleep(1);
        if ((++sp & 255u) == 0u) { if (xb_ld(&bar[XB_TMO])) break; if (sp > XB_SPIN_CAP) { atomicAdd(&bar[XB_TMO], 1u); break; } }
    }
    nloc = mine > 0u ? mine : 1u; nx = cnt > 0u ? cnt : 1u;
}
__device__ __forceinline__ void xcd_barrier(const XcdBarrier& b) {
    asm volatile("s_waitcnt vmcnt(0)" ::: "memory");
    __syncthreads();
    if (__builtin_amdgcn_workitem_id_x() == 0) {
        unsigned* bar = b.bar;
        __builtin_amdgcn_s_waitcnt(0);
        unsigned nloc = b.st[0], nx = b.st[1];
        if (nloc == 0u) { xcd_barrier_complete(bar, b.x, nloc, nx); b.st[0] = nloc; b.st[1] = nx; }
        const unsigned old = xb_add(&bar[XB_XSUB(b.x)], 1u);
        const unsigned gen = old / nloc;
        if (old + 1u == (gen + 1u) * nloc) {
            __builtin_amdgcn_fence(__ATOMIC_RELEASE, "agent");
            asm volatile("s_waitcnt vmcnt(0)" ::: "memory");
            const unsigned og = xb_add(&bar[XB_TOP], 1u);
            const unsigned tg = og / nx;
            if (og + 1u == (tg + 1u) * nx) xb_add(&bar[XB_TOPGEN], 1u);
            else XB_SPIN(xb_ld(&bar[XB_TOPGEN]) == tg, bar);
            __builtin_amdgcn_fence(__ATOMIC_ACQUIRE, "agent");
            xb_add(&bar[XB_XGEN(b.x)], 1u);
            asm volatile("s_waitcnt vmcnt(0)" ::: "memory");
        } else {
            XB_SPIN(xb_ld(&bar[XB_XGEN(b.x)]) == gen, bar);
            __builtin_amdgcn_fence(__ATOMIC_ACQUIRE, "agent");
            asm volatile("s_waitcnt vmcnt(0)" ::: "memory");
        }
    }
    __syncthreads();
}

namespace pg8 {
#define PG8_LAS __attribute__((address_space(3)))
typedef unsigned short bf16_t;
typedef short bf16x8 __attribute__((ext_vector_type(8)));
typedef float f32x4 __attribute__((ext_vector_type(4)));
typedef unsigned u32x4 __attribute__((ext_vector_type(4)));
constexpr int BM = 256, BK = 64, HALF = 128, HTB = HALF * BK * 2  , STAGE_BYTES = 8 * HTB, NXCD = 8, WGM = 8;

__host__ __device__ __forceinline__ int lds_byte(int r, int c) { const int st = (r >> 4) * 2 + (c >> 5), rr = r & 15, cc = c & 31, ob = rr * 64 + cc * 2; return st * 1024 + (ob ^ (((ob >> 9) & 1) << 5)); }
__host__ __device__ __forceinline__ void stage_rc(int b, int& R, int& C) { const int st = b / 1024, sb = b % 1024, swz = sb ^ (((sb >> 9) & 1) << 5); R = (st >> 1) * 16 + swz / 64; C = (st & 1) * 32 + (swz % 64) / 2; }
__host__ __device__ __forceinline__ int perm32(int rho) { const int n = rho >> 4, i = rho & 15; return 8 * (i >> 2) + 4 * n + (i & 3); }

struct Unit { int pm, pn; };
struct Gemm { const bf16_t* A; const bf16_t* Bt; int M, N, K; };

struct StaticOrder {
    int nM, nN, nwg, G, c;
    __host__ __device__ void init(int M, int N, int G_, int c_) { nM = M / BM; nN = N / BM; nwg = nM * nN; G = G_; c = c_; }
    __host__ __device__ bool next(int i, Unit& u) const {
        const long L = (long)i * G + c; if (L >= nwg) return false;
        int wgid = (int)L; { const int q = nwg / NXCD, r = nwg % NXCD, xcd = wgid % NXCD, off = wgid / NXCD; wgid = (xcd < r ? xcd * (q + 1) : r * (q + 1) + (xcd - r) * q) + off; }
        const int nig = WGM * nN, gid = wgid / nig, fm = gid * WGM, gsz = (nM - fm) < WGM ? (nM - fm) : WGM;
        u.pm = fm + ((wgid % nig) % gsz); u.pn = (wgid % nig) / gsz; return true;
    }
    __device__ __forceinline__ void a_ready(const Unit&) const {}
    __device__ __forceinline__ void done(const Unit&) const {}
};
template <class Epi, class Sched, bool STAMP = false>
__device__ __forceinline__ void gemm_phase(PG8_LAS unsigned char* lds, const Gemm g, const Sched& S, const Epi& E, unsigned long long* stamps) {
    const int tid = threadIdx.x, wid = __builtin_amdgcn_readfirstlane(tid >> 6), lane = tid & 63, wr = wid >> 2, wc = wid & 3, fr = lane & 15, fq = lane >> 4;
    const int K = g.K, nt = K / BK;
    int ts_lo = 0, ts_hi = 0, nts = 0; const unsigned long long rt_entry = STAMP ? (unsigned long long)wall_clock64() : 0ull;
#define PG8_STAMP() do { if (STAMP && wid == 0 && nts < 64) { const unsigned long long _c = (unsigned long long)clock64(); \
        ts_lo = (lane == nts) ? (int)(unsigned)_c : ts_lo; ts_hi = (lane == nts) ? (int)(unsigned)(_c >> 32) : ts_hi; ++nts; } } while (0)
    PG8_STAMP();
    unsigned voffA[2], voffB[2];
#pragma unroll
    for (int i = 0; i < 2; ++i) { int R, C; stage_rc(tid * 16 + i * 8192, R, C); const int Rb = Epi::PERM ? ((R & ~31) + perm32(R & 31)) : R;
        voffA[i] = (unsigned)(R * K + C) * 2u; voffB[i] = (unsigned)(Rb * K + C) * 2u; }
    const size_t kstep = (size_t)(BK * 2);
    const size_t hstep = (size_t)HALF * K * 2;
    const size_t tstep = 2 * hstep;
    const unsigned ldsw = (unsigned)wid * 1024u;
    const int aoff = lds_byte(wr * 64 + fr, fq * 8), boff = lds_byte(wc * 32 + fr, fq * 8);
#define PG8_SA(b, h) (((b) * 2 + (h)) * HTB)
#define PG8_SB(b, h) ((4 + (b) * 2 + (h)) * HTB)
#define PG8_STAGE(bufoff, gbase, voff) do { _Pragma("unroll") for (int _i = 0; _i < 2; ++_i) \
        __builtin_amdgcn_global_load_lds((const unsigned*)((const char*)(gbase) + (voff)[_i]), (PG8_LAS unsigned*)(lds + (bufoff) + ldsw + _i * 8192), 16, 0, 0); } while (0)
#define PG8_LDA(dst, b, h) do { _Pragma("unroll") for (int m = 0; m < 4; ++m) _Pragma("unroll") for (int k = 0; k < 2; ++k) dst[m][k] = *(const PG8_LAS bf16x8*)(lds + PG8_SA(b, h) + aoff + m * 2048 + k * 1024); } while (0)
#define PG8_LDB(dst, b, h) do { _Pragma("unroll") for (int n = 0; n < 2; ++n) _Pragma("unroll") for (int k = 0; k < 2; ++k) dst[n][k] = *(const PG8_LAS bf16x8*)(lds + PG8_SB(b, h) + boff + n * 2048 + k * 1024); } while (0)
#define PG8_MMA(ai, bj, At, Bt) do { __builtin_amdgcn_s_setprio(1); _Pragma("unroll") for (int m = 0; m < 4; ++m) _Pragma("unroll") for (int n = 0; n < 2; ++n) _Pragma("unroll") for (int k = 0; k < 2; ++k) \
        acc[ai][bj][m][n] = __builtin_amdgcn_mfma_f32_16x16x32_bf16(Bt[n][k], At[m][k], acc[ai][bj][m][n], 0, 0, 0); __builtin_amdgcn_s_setprio(0); } while (0)
#define PG8_WAIT_V(n) asm volatile("s_waitcnt vmcnt(" #n ")" ::: "memory")
#define PG8_WAIT_L(n) asm volatile("s_waitcnt lgkmcnt(" #n ")" ::: "memory")
#define PG8_BAR __builtin_amdgcn_s_barrier()
#define PG8_SCHED __builtin_amdgcn_sched_barrier(0)
    Unit cur, nxt; int ui = 0;
    if (!S.next(0, cur)) return;
    f32x4 acc[2][2][4][2];
#pragma unroll
    for (int a = 0; a < 2; ++a)
#pragma unroll
        for (int b = 0; b < 2; ++b)
#pragma unroll
            for (int m = 0; m < 4; ++m)
#pragma unroll
                for (int n = 0; n < 2; ++n) acc[a][b][m][n] = (f32x4){0.f, 0.f, 0.f, 0.f};
    bf16x8 At[4][2], B0[2][2], B1[2][2];
    const char* cA = (const char*)g.A + (size_t)cur.pm * tstep; const char* cB = (const char*)g.Bt + (size_t)cur.pn * tstep;
    S.a_ready(cur);
    PG8_STAGE(PG8_SB(0, 0), cB, voffB); PG8_STAGE(PG8_SA(0, 0), cA, voffA); PG8_STAGE(PG8_SB(0, 1), cB + hstep, voffB); PG8_STAGE(PG8_SA(0, 1), cA + hstep, voffA);
    if (wr == 1) PG8_BAR;
    PG8_WAIT_V(4); PG8_BAR;
    PG8_STAGE(PG8_SB(1, 0), cB + kstep, voffB); PG8_STAGE(PG8_SA(1, 0), cA + kstep, voffA); PG8_STAGE(PG8_SB(1, 1), cB + hstep + kstep, voffB);
    PG8_WAIT_V(6); PG8_BAR;
    PG8_STAMP();
    for (;;) {
        const bool has_next = S.next(ui + 1, nxt);
        const char* nA = has_next ? (const char*)g.A + (size_t)nxt.pm * tstep : cA; const char* nB = has_next ? (const char*)g.Bt + (size_t)nxt.pn * tstep : cB;
        for (int t = 0; t < nt; t += 2) {
            const bool last = (t == nt - 2);
            const char* a1 = cA + (size_t)(t + 1) * kstep;
            const char* a2 = last ? nA : cA + (size_t)(t + 2) * kstep; const char* b2 = last ? nB : cB + (size_t)(t + 2) * kstep;
            const char* a3 = a2 + kstep; const char* b3 = b2 + kstep;
            if (last && has_next) S.a_ready(nxt);
            PG8_LDB(B0, 0, 0); PG8_SCHED; PG8_LDA(At, 0, 0); PG8_STAGE(PG8_SA(1, 1), a1 + hstep, voffA);
            PG8_WAIT_L(8); PG8_BAR; PG8_WAIT_L(0); PG8_MMA(0, 0, At, B0); PG8_BAR; PG8_SCHED;
            PG8_LDB(B1, 0, 1); PG8_STAGE(PG8_SB(0, 0), b2, voffB);
            PG8_BAR; PG8_WAIT_L(0); PG8_MMA(0, 1, At, B1); PG8_BAR;
            PG8_LDA(At, 0, 1); PG8_STAGE(PG8_SA(0, 0), a2, voffA);
            PG8_BAR; PG8_WAIT_L(0); PG8_MMA(1, 0, At, B0); PG8_BAR; PG8_SCHED;
            PG8_STAGE(PG8_SB(0, 1), b2 + hstep, voffB);
            PG8_WAIT_V(6); PG8_BAR; PG8_MMA(1, 1, At, B1); PG8_BAR;
            PG8_LDB(B0, 1, 0); PG8_SCHED; PG8_LDA(At, 1, 0); PG8_STAGE(PG8_SA(0, 1), a2 + hstep, voffA);
            PG8_WAIT_L(8); PG8_BAR; PG8_WAIT_L(0); PG8_MMA(0, 0, At, B0); PG8_BAR; PG8_SCHED;
            PG8_LDB(B1, 1, 1); PG8_STAGE(PG8_SB(1, 0), b3, voffB);
            PG8_BAR; PG8_WAIT_L(0); PG8_MMA(0, 1, At, B1); PG8_BAR;
            PG8_LDA(At, 1, 1); PG8_STAGE(PG8_SA(1, 0), a3, voffA);
            PG8_BAR; PG8_WAIT_L(0); PG8_MMA(1, 0, At, B0); PG8_BAR; PG8_SCHED;
            PG8_STAGE(PG8_SB(1, 1), b3 + hstep, voffB);
            PG8_WAIT_V(6); PG8_BAR; PG8_MMA(1, 1, At, B1); PG8_BAR;
        }
        PG8_STAMP();
        if constexpr (!Epi::AFTER_DRAIN) { E(acc, cur, wr, wc, fr, fq); S.done(cur); }
        PG8_STAMP();
        if (!has_next) break;
#pragma unroll
        for (int a = 0; a < 2; ++a)
#pragma unroll
            for (int b = 0; b < 2; ++b)
#pragma unroll
                for (int m = 0; m < 4; ++m)
#pragma unroll
                    for (int n = 0; n < 2; ++n) acc[a][b][m][n] = (f32x4){0.f, 0.f, 0.f, 0.f};
        cur = nxt; cA = nA; cB = nB; ++ui;
    }
    PG8_WAIT_V(0);
    if (wr == 0) PG8_BAR;
    PG8_BAR;
    if constexpr (Epi::AFTER_DRAIN) { E.fused(acc, cur, wr, wc, fr, fq, lds, wid, lane); S.done(cur); }
    PG8_STAMP();
    if (STAMP && wid == 0) { stamps[lane] = lane < nts ? (((unsigned long long)(unsigned)ts_hi << 32) | (unsigned)ts_lo) : 0ull;
        if (lane == 62) stamps[62] = rt_entry; if (lane == 63) stamps[63] = (unsigned long long)wall_clock64(); }
#undef PG8_STAMP
#undef PG8_SA
#undef PG8_SB
#undef PG8_STAGE
#undef PG8_LDA
#undef PG8_LDB
#undef PG8_MMA
#undef PG8_WAIT_V
#undef PG8_WAIT_L
#undef PG8_BAR
#undef PG8_SCHED
}
}

template <int MI, int BK = 64, int NI = 2, int WR = 4, bool TR = false>
__device__ __forceinline__ void gemm_mainloop(f32x16 (&acc)[MI][NI], const bf16_t* __restrict__ A, int lda, const bf16_t* __restrict__ Bt, int ldb, int K, unsigned char* lds) {
    constexpr int WC = 8 / WR;
    constexpr int BM = 32 * MI * WR, BN = 32 * NI * WC;
    constexpr int RS = (BK + 8) * 2;
    constexpr int VPR = BK / 8;
    constexpr int RPP = NT / VPR;
    constexpr int NA = BM / RPP, NB = BN / RPP;
    constexpr int ABYTES = BM * RS, BBYTES = BN * RS, STAGE = ABYTES + BBYTES;
    static_assert(NA >= 2 && NA <= 4 && NB >= 2 && NB <= 4 && BM % RPP == 0 && BN % RPP == 0, "tile config");
    const int tid = tid_opaque(), lane = tid & 63, wid = tid >> 6, wr = wid / WC, wc = wid % WC;
    const int lr = tid / VPR, lk = tid % VPR;
    uint4 ra0, ra1, ra2, ra3, rb0, rb1, rb2, rb3;
    const bf16_t* Ap = A + (size_t)lr * lda + lk * 8;
    const bf16_t* Bp = Bt + (size_t)lr * ldb + lk * 8;
    const int nk = K / BK;
    const int wo = lr * RS + lk * 16;
#define G_LOAD(k0) { ra0 = *(const uint4*)(Ap + (k0)); ra1 = *(const uint4*)(Ap + (size_t)RPP * lda + (k0)); \
        if (NA >= 3) ra2 = *(const uint4*)(Ap + (size_t)(2 * RPP) * lda + (k0)); \
        if (NA >= 4) ra3 = *(const uint4*)(Ap + (size_t)(3 * RPP) * lda + (k0)); \
        rb0 = *(const uint4*)(Bp + (k0)); rb1 = *(const uint4*)(Bp + (size_t)RPP * ldb + (k0)); \
        if (NB >= 3) rb2 = *(const uint4*)(Bp + (size_t)(2 * RPP) * ldb + (k0)); \
        if (NB >= 4) rb3 = *(const uint4*)(Bp + (size_t)(3 * RPP) * ldb + (k0)); }
#define S_STORE(buf) { *(uint4*)((buf) + wo) = ra0; *(uint4*)((buf) + wo + RPP * RS) = ra1; \
        if (NA >= 3) *(uint4*)((buf) + wo + 2 * RPP * RS) = ra2; \
        if (NA >= 4) *(uint4*)((buf) + wo + 3 * RPP * RS) = ra3; \
        *(uint4*)((buf) + ABYTES + wo) = rb0; *(uint4*)((buf) + ABYTES + wo + RPP * RS) = rb1; \
        if (NB >= 3) *(uint4*)((buf) + ABYTES + wo + 2 * RPP * RS) = rb2; \
        if (NB >= 4) *(uint4*)((buf) + ABYTES + wo + 3 * RPP * RS) = rb3; }
    ra2 = ra3 = rb2 = rb3 = make_uint4(0, 0, 0, 0);
    __syncthreads();
    G_LOAD(0)
    S_STORE(lds)
    __syncthreads();
    const int aoff = (wr * 32 * MI + (lane & 31)) * RS + (lane >> 5) * 16;
    const int boff = ABYTES + (wc * 32 * NI + (lane & 31)) * RS + (lane >> 5) * 16;
#pragma unroll 1
    for (int kt = 0; kt < nk; ++kt) {
        unsigned char* cur = lds + (kt & 1) * STAGE;
        unsigned char* nxt = lds + ((kt + 1) & 1) * STAGE;
        const bool more = (kt + 1 < nk);
        if (more) { const int k0 = (kt + 1) * BK; G_LOAD(k0) }
#pragma unroll
        for (int ks = 0; ks < BK / 16; ++ks) {
            bf16x8 af[MI], bfr[NI];
#pragma unroll
            for (int mi = 0; mi < MI; ++mi) af[mi] = *(const bf16x8*)(cur + aoff + mi * 32 * RS + ks * 32);
#pragma unroll
            for (int ni = 0; ni < NI; ++ni) bfr[ni] = *(const bf16x8*)(cur + boff + ni * 32 * RS + ks * 32);
#pragma unroll
            for (int mi = 0; mi < MI; ++mi)
#pragma unroll
                for (int ni = 0; ni < NI; ++ni)
                    acc[mi][ni] = TR ? __builtin_amdgcn_mfma_f32_32x32x16_bf16(bfr[ni], af[mi], acc[mi][ni], 0, 0, 0)
                                     : __builtin_amdgcn_mfma_f32_32x32x16_bf16(af[mi], bfr[ni], acc[mi][ni], 0, 0, 0);
        }
        if (more) S_STORE(nxt)
        __syncthreads();
    }
#undef G_LOAD
#undef S_STORE
}

template <int MI, int NI = 2>
__device__ __forceinline__ void zero_acc(f32x16 (&acc)[MI][NI]) {
#pragma unroll
    for (int mi = 0; mi < MI; ++mi)
#pragma unroll
        for (int ni = 0; ni < NI; ++ni)
#pragma unroll
            for (int r = 0; r < 16; ++r) acc[mi][ni][r] = 0.f;
}

template <int MI, int NI = 2, int WR = 4, class F>
__device__ __forceinline__ void for_each_acc(f32x16 (&acc)[MI][NI], int row0, int col0, F f) {
    constexpr int WC = 8 / WR;
    const int lane = tid_opaque() & 63, wid = tid_opaque() >> 6, wr = wid / WC, wc = wid % WC;
#pragma unroll
    for (int mi = 0; mi < MI; ++mi)
#pragma unroll
        for (int ni = 0; ni < NI; ++ni) {
            const int col = col0 + wc * 32 * NI + ni * 32 + (lane & 31);
            const int rb = row0 + wr * 32 * MI + mi * 32 + 4 * (lane >> 5);
#pragma unroll
            for (int r = 0; r < 16; ++r) { float v = acc[mi][ni][r]; f(rb + (r & 3) + 8 * (r >> 2), col, v); acc[mi][ni][r] = v; }
        }
}

template <int MI, int NI = 2, int WR = 4, class F>
__device__ __forceinline__ void for_each_acc4(f32x16 (&acc)[MI][NI], int row0, int col0, F f) {
    constexpr int WC = 8 / WR;
    const int lane = tid_opaque() & 63, wid = tid_opaque() >> 6, wr = wid / WC, wc = wid % WC;
#pragma unroll
    for (int mi = 0; mi < MI; ++mi)
#pragma unroll
        for (int ni = 0; ni < NI; ++ni) {
            const int row = row0 + wr * 32 * MI + mi * 32 + (lane & 31);
            const int cb = col0 + wc * 32 * NI + ni * 32 + 4 * (lane >> 5);
#pragma unroll
            for (int g = 0; g < 4; ++g) {
                float4 v = make_float4(acc[mi][ni][4 * g], acc[mi][ni][4 * g + 1], acc[mi][ni][4 * g + 2], acc[mi][ni][4 * g + 3]);
                f(row, cb + 8 * g, v);
                acc[mi][ni][4 * g] = v.x; acc[mi][ni][4 * g + 1] = v.y; acc[mi][ni][4 * g + 2] = v.z; acc[mi][ni][4 * g + 3] = v.w;
            }
        }
}
__device__ __forceinline__ float4 bf4_to_f4(uint2 u) { return make_float4(__uint_as_float(u.x << 16), __uint_as_float(u.x & 0xffff0000u), __uint_as_float(u.y << 16), __uint_as_float(u.y & 0xffff0000u)); }
__device__ __forceinline__ uint2 f4_to_bf4(float4 v) { return make_uint2(pk2(v.x, v.y), pk2(v.z, v.w)); }

template <class F>
__device__ __forceinline__ void for_tiles(int n_mt, int n_nt, F f) {
    const int G = gridDim.x, b = blockIdx.x;
    const bool ok = ((G & 7) == 0) && ((n_mt & 7) == 0);
    const int xcd = ok ? (b & 7) : 0, mul = ok ? 8 : 1, mpx = ok ? (n_mt >> 3) : n_mt;
    const int t0 = ok ? (b >> 3) : b, tstep = ok ? (G >> 3) : G, ntot = mpx * n_nt;
#pragma unroll 1
    for (int t = t0; t < ntot; t += tstep) f(xcd + mul * (t % mpx), t / mpx);
}

__device__ __forceinline__ const float* xrow(const Params& p, int t) { return t < TP ? p.in[0] + (size_t)t * 1024 : p.in[1] + (size_t)(t - TP) * 1024; }
__device__ __forceinline__ int modidx(int t) { return t < TP ? 0 : 1 + ((t - TP) >> 11); }

__device__ __forceinline__ void transpose_tile(const Params& p, int tI, unsigned char* lds) {
    const int tid = tid_opaque();
    const float* src; bf16_t* dst; int K, N;
    if (tI < 2064) { src = p.in[9]; dst = (bf16_t*)(p.ws + WS_WIN); K = 1024; N = 8256; }
    else if (tI < 2320) { tI -= 2064; src = p.in[10]; dst = (bf16_t*)(p.ws + WS_WF); K = 1024; N = 1024; }
    else if (tI < 2832) { tI -= 2320; src = p.in[17]; dst = (bf16_t*)(p.ws + WS_WSO); K = 2048; N = 1024; }
    else if (tI < 3088) { tI -= 2832; src = p.in[18]; dst = (bf16_t*)(p.ws + WS_WO); K = 1024; N = 1024; }
    else if (tI < 4112) { tI -= 3088; src = p.in[20]; dst = (bf16_t*)(p.ws + WS_W1); K = 1024; N = 4096; }
    else { tI -= 4112; src = p.in[21]; dst = (bf16_t*)(p.ws + WS_W2); K = 4096; N = 1024; }
    const int nkt = K >> 6; const int k0 = (tI % nkt) * 64, n0 = (tI / nkt) * 64;
    bf16_t* ts = (bf16_t*)lds;
    __syncthreads();
#pragma unroll
    for (int i = 0; i < 2; ++i) { const int idx = tid + i * NT, kr = idx >> 4, nv = idx & 15;
        const float4 v = *(const float4*)(src + (size_t)(k0 + kr) * N + n0 + nv * 4);
        ts[(nv * 4 + 0) * 72 + kr] = f2bf(v.x); ts[(nv * 4 + 1) * 72 + kr] = f2bf(v.y); ts[(nv * 4 + 2) * 72 + kr] = f2bf(v.z); ts[(nv * 4 + 3) * 72 + kr] = f2bf(v.w); }
    __syncthreads();
    { const int n = tid >> 3, kv = tid & 7; *(uint4*)(dst + (size_t)(n0 + n) * K + k0 + kv * 8) = *(const uint4*)(ts + n * 72 + kv * 8); }
}

__device__ __forceinline__ void phase_prep(const Params& p, unsigned char* lds) {
    const int tid = tid_opaque();
    float* mod = (float*)(p.ws + WS_MOD);
    const bool defer = (gridDim.x == 256);
    constexpr int N_GEMV = 192, N_TR = 5136, N_ZERO = 1, N_TAB = 32 + 32 + 2048;
    constexpr int NITEMS = N_GEMV + N_TR + N_ZERO + N_TAB;
    for (int item = blockIdx.x; item < NITEMS; item += gridDim.x) {
        if (item < N_GEMV) {
            float* sv = (float*)lds;
            float* part = sv + 3072;
            __syncthreads();
            for (int i = tid; i < 3072; i += NT) { const int r = i >> 10, k = i & 1023; const float v = (r == 0) ? p.in[5][k] : p.in[4][(r - 1) * 1024 + k]; sv[i] = siluf(v); }
            __syncthreads();
            const int col = tid & 31, kq = tid >> 5, col0 = item * 32;
            const float* w = p.in[6] + (size_t)(kq * 64) * 6144 + col0 + col;
            float a0 = 0.f, a1 = 0.f, a2 = 0.f;
#pragma unroll 16
            for (int k = 0; k < 64; ++k) { const float wv = w[(size_t)k * 6144]; const int kk = kq * 64 + k; a0 += sv[kk] * wv; a1 += sv[1024 + kk] * wv; a2 += sv[2048 + kk] * wv; }
            part[(kq * 3 + 0) * 32 + col] = a0; part[(kq * 3 + 1) * 32 + col] = a1; part[(kq * 3 + 2) * 32 + col] = a2;
            __syncthreads();
            if (tid < 96) { const int r = tid >> 5, c = tid & 31; float s = p.in[7][col0 + c];
                for (int q = 0; q < 16; ++q) s += part[(q * 3 + r) * 32 + c];
                mod[r * 6144 + col0 + c] = s; }
        } else if (item < N_GEMV + N_TR) {
            const int tI = item - N_GEMV;
            if (defer && tI >= 2832) continue;
            transpose_tile(p, tI, lds);
        } else if (item < N_GEMV + N_TR + N_ZERO) {
            uint4* d = (uint4*)(p.ws + WS_WIN + (size_t)8256 * 1024 * 2);
            for (int i = tid; i < 64 * 1024 * 2 / 16; i += NT) d[i] = make_uint4(0, 0, 0, 0);
        } else {
            const int tb = item - (N_GEMV + N_TR + N_ZERO);
            unsigned pk[4];
            bf16_t* dst; size_t e0;
            if (tb < 32) { dst = (bf16_t*)(p.ws + WS_CSC); e0 = (size_t)tb * 4096 + tid * 8;
#pragma unroll
                for (int j = 0; j < 8; j += 2) { float v[2];
                    for (int u = 0; u < 2; ++u) { const int e = (int)e0 + j + u, m = e >> 8, k = e & 255, cs = m >> 8, chp = m & 255; const float ang = (float)((chp * k) & 255) * (1.f / 128.f);
                        v[u] = (cs == 0 ? cospif(ang) : sinpif(ang)) * 0.0625f; }
                    pk[j >> 1] = pk2(v[0], v[1]); }
            } else if (tb < 64) { dst = (bf16_t*)(p.ws + WS_A256); e0 = (size_t)(tb - 32) * 4096 + tid * 8;
#pragma unroll
                for (int j = 0; j < 8; j += 2) { float v[2];
                    for (int u = 0; u < 2; ++u) { const int e = (int)e0 + j + u, lp = e >> 9, kk = e & 511, cs = kk >> 8, l = kk & 255; const float ang = (float)((lp * l) & 255) * (1.f / 128.f);
                        v[u] = (cs == 0 ? cospif(ang) : -sinpif(ang)) * 0.0625f; }
                    pk[j >> 1] = pk2(v[0], v[1]); }
            } else { dst = (bf16_t*)((unsigned char*)p.out + DO_APOS); e0 = (size_t)(tb - 64) * 4096 + tid * 8;
#pragma unroll
                for (int j = 0; j < 8; j += 2) { float v[2];
                    for (int u = 0; u < 2; ++u) { const int e = (int)e0 + j + u, lp = e >> 12, kk = e & 4095, cs = kk >> 11, l = kk & 2047;
                        const int r = l >> 6, c = l & 63, rp = lp >> 6, cp = lp & 63; const float ang = (float)((2 * r * rp + c * cp) & 63) * (1.f / 32.f);
                        v[u] = (cs == 0 ? cospif(ang) : -sinpif(ang)) * 0.02209708691f; }
                    pk[j >> 1] = pk2(v[0], v[1]); }
            }
            *(uint4*)(dst + e0) = make_uint4(pk[0], pk[1], pk[2], pk[3]);
        }
    }
}

__device__ __forceinline__ void phase_norm(const Params& p, int which) {
    const int lane = tid_opaque() & 63, wid = tid_opaque() >> 6;
    const float* mod = (const float*)(p.ws + WS_MOD);
    const float* g = which == 0 ? p.in[8] : (which == 1 ? p.in[19] : p.in[22]);
    bf16_t* dst = which == 0 ? (bf16_t*)((unsigned char*)p.out + DO_H1) : (bf16_t*)(p.ws + WS_H2);
    for (int t0 = (blockIdx.x * 8 + wid) * 2; t0 < T; t0 += gridDim.x * 16) {
        float4 v[2][4]; float ss[2] = {0.f, 0.f};
#pragma unroll
        for (int u = 0; u < 2; ++u) { const int t = t0 + u; const float* src = which == 2 ? p.out + (size_t)t * 1024 : xrow(p, t);
#pragma unroll
            for (int i = 0; i < 4; ++i) v[u][i] = *(const float4*)(src + i * 256 + lane * 4);
            if (which != 0) {
                const bf16_t* rr = (const bf16_t*)(p.ws + WS_R) + (size_t)t * 1024;
#pragma unroll
                for (int i = 0; i < 4; ++i) { const float4 r = bf4_to_f4(*(const uint2*)(rr + i * 256 + lane * 4));
                    v[u][i].x += r.x; v[u][i].y += r.y; v[u][i].z += r.z; v[u][i].w += r.w; }
                if (which == 1) {
#pragma unroll
                    for (int i = 0; i < 4; ++i) *(float4*)(p.out + (size_t)t * 1024 + i * 256 + lane * 4) = v[u][i];
                }
            } }
#pragma unroll
        for (int u = 0; u < 2; ++u) {
#pragma unroll
            for (int i = 0; i < 4; ++i) ss[u] += v[u][i].x * v[u][i].x + v[u][i].y * v[u][i].y + v[u][i].z * v[u][i].z + v[u][i].w * v[u][i].w;
#pragma unroll
            for (int o = 32; o > 0; o >>= 1) ss[u] += __shfl_xor(ss[u], o);
        }
#pragma unroll
        for (int u = 0; u < 2; ++u) {
            const int t = t0 + u;
            const float rstd = rsqrtf(ss[u] * (1.f / 1024.f) + 1e-6f);
            if (which == 2) {
#pragma unroll
                for (int i = 0; i < 4; ++i) { const int c = i * 256 + lane * 4; const float4 gg = *(const float4*)(g + c);
                    float4 o; o.x = v[u][i].x * rstd * gg.x; o.y = v[u][i].y * rstd * gg.y; o.z = v[u][i].z * rstd * gg.z; o.w = v[u][i].w * rstd * gg.w;
                    *(float4*)(p.out + (size_t)t * 1024 + c) = o; }
            } else {
                const float* mrow = mod + modidx(t) * 6144 + (which == 0 ? 0 : 3072);
#pragma unroll
                for (int i = 0; i < 4; ++i) { const int c = i * 256 + lane * 4; const float4 gg = *(const float4*)(g + c);
                    const float4 sh = *(const float4*)(mrow + c), sc = *(const float4*)(mrow + 1024 + c);
                    const float o0 = v[u][i].x * rstd * gg.x * (1.f + sc.x) + sh.x, o1 = v[u][i].y * rstd * gg.y * (1.f + sc.y) + sh.y;
                    const float o2 = v[u][i].z * rstd * gg.z * (1.f + sc.z) + sh.z, o3 = v[u][i].w * rstd * gg.w * (1.f + sc.w) + sh.w;
                    *(uint2*)(dst + (size_t)t * 1024 + c) = make_uint2(pk2(o0, o1), pk2(o2, o3)); }
            }
        }
    }
}

struct EpiInProj {
    static constexpr bool PERM = true, AFTER_DRAIN = false;
    bf16_t* uf; bf16_t* zs; bf16_t* xbc; float* dtb; bf16_t* gates; const float* dt_bias;
    __device__ __forceinline__ void operator()(const pg8::f32x4 (&acc)[2][2][4][2], const pg8::Unit& u, int wr, int wc, int fr, int fq) const {
#pragma unroll
        for (int bj = 0; bj < 2; ++bj) {
            const int cb = __builtin_amdgcn_readfirstlane(u.pn * 256 + bj * 128 + wc * 32);
            const int rbase = u.pm * 256 + wr * 64 + fr;
            if (cb >= 6144 && cb < 6208) {
                const int j = cb - 6144 + 8 * fq;
                const float4 b0 = *(const float4*)(dt_bias + j), b1 = *(const float4*)(dt_bias + j + 4);
#pragma unroll
                for (int ai = 0; ai < 2; ++ai)
#pragma unroll
                    for (int m = 0; m < 4; ++m) {
                        const pg8::f32x4 v0 = acc[ai][bj][m][0], v1 = acc[ai][bj][m][1];
                        float x[8] = {v0[0] + b0.x, v0[1] + b0.y, v0[2] + b0.z, v0[3] + b0.w, v1[0] + b1.x, v1[1] + b1.y, v1[2] + b1.z, v1[3] + b1.w};
#pragma unroll
                        for (int e = 0; e < 8; ++e) x[e] = x[e] > 20.f ? x[e] : log1pf(__expf(x[e]));
                        float* d = dtb + (size_t)(rbase + ai * 128 + m * 16) * 64 + j;
                        *(float4*)d = make_float4(x[0], x[1], x[2], x[3]); *(float4*)(d + 4) = make_float4(x[4], x[5], x[6], x[7]);
                    }
            } else {
                bf16_t* dst; int ld, c0; bool sg = false;
                if (cb < 1024) { dst = uf; ld = 1024; c0 = cb; }
                else if (cb < 3072) { dst = zs; ld = 2048; c0 = cb - 1024; }
                else if (cb < 6144) { dst = xbc; ld = 3072; c0 = cb - 3072; }
                else { dst = gates; ld = 2048; c0 = cb - 6208; sg = true; }
                bf16_t* dp = dst + (size_t)rbase * ld + c0 + 8 * fq;
                if (sg) {
#pragma unroll
                    for (int ai = 0; ai < 2; ++ai)
#pragma unroll
                        for (int m = 0; m < 4; ++m) { const pg8::f32x4 v0 = acc[ai][bj][m][0], v1 = acc[ai][bj][m][1];
                            *(uint4*)(dp + (size_t)(ai * 128 + m * 16) * ld) = make_uint4(pk2(sigmf(v0[0]), sigmf(v0[1])), pk2(sigmf(v0[2]), sigmf(v0[3])), pk2(sigmf(v1[0]), sigmf(v1[1])), pk2(sigmf(v1[2]), sigmf(v1[3]))); }
                } else {
#pragma unroll
                    for (int ai = 0; ai < 2; ++ai)
#pragma unroll
                        for (int m = 0; m < 4; ++m) { const pg8::f32x4 v0 = acc[ai][bj][m][0], v1 = acc[ai][bj][m][1];
                            *(uint4*)(dp + (size_t)(ai * 128 + m * 16) * ld) = make_uint4(pk2(v0[0], v0[1]), pk2(v0[2], v0[3]), pk2(v1[0], v1[1]), pk2(v1[2], v1[3])); }
                }
            }
        }
    }
};

__device__ __forceinline__ void phase_inproj(const Params& p, unsigned char* lds) {
    const bf16_t* h1 = (const bf16_t*)((unsigned char*)p.out + DO_H1);
    const bf16_t* W = (const bf16_t*)(p.ws + WS_WIN);
    bf16_t* uf = (bf16_t*)((unsigned char*)p.out + DO_UF);
    bf16_t* zs = (bf16_t*)(p.ws + WS_ZS);
    bf16_t* xbc = (bf16_t*)(p.ws + WS_XBC);
    float* dtb = (float*)(p.ws + WS_DTB);
    bf16_t* gates = (bf16_t*)((unsigned char*)p.out + DO_GATES);
    const float* dt_bias = p.in[13];
    auto epi = [&](const f32x16& a, int rb, int cb, int lane) {
        if (cb >= 8256) return;
        if (cb >= 6144 && cb < 6208) {
            const int j = cb - 6144 + (lane & 31); const float bias = dt_bias[j];
#pragma unroll
            for (int r = 0; r < 16; ++r) { const float x = a[r] + bias; dtb[(size_t)(rb + (r & 3) + 8 * (r >> 2)) * 64 + j] = x > 20.f ? x : log1pf(__expf(x)); }
        } else {
            bf16_t* dst; int ld, c0; bool sg = false;
            if (cb < 1024) { dst = uf; ld = 1024; c0 = cb; }
            else if (cb < 3072) { dst = zs; ld = 2048; c0 = cb - 1024; }
            else if (cb < 6144) { dst = xbc; ld = 3072; c0 = cb - 3072; }
            else { dst = gates; ld = 2048; c0 = cb - 6208; sg = true; }
            bf16_t* dp = dst + (size_t)rb * ld + c0 + (lane & 31);
            if (sg) {
#pragma unroll
                for (int r = 0; r < 16; ++r) dp[(size_t)((r & 3) + 8 * (r >> 2)) * ld] = f2bf(sigmf(a[r]));
            } else {
#pragma unroll
                for (int r = 0; r < 16; ++r) dp[(size_t)((r & 3) + 8 * (r >> 2)) * ld] = f2bf(a[r]);
            }
        }
    };
    {
        pg8::Gemm g{h1, W, T, 8192, 1024};
        pg8::StaticOrder S; S.init(T, 8192, (int)gridDim.x, (int)blockIdx.x);
        EpiInProj E{uf, zs, xbc, dtb, gates, dt_bias};
        pg8::gemm_phase<EpiInProj, pg8::StaticOrder, false>((PG8_LAS unsigned char*)lds, g, S, E, nullptr);
    }
    for (int mt = (int)gridDim.x - 1 - (int)blockIdx.x; mt < 48; mt += gridDim.x) {
        f32x16 acc[2][2]; zero_acc<2>(acc);
        gemm_mainloop<2>(acc, h1 + (size_t)mt * 256 * 1024, 1024, W + (size_t)8192 * 1024, 1024, 1024, lds);
        const int lane = tid_opaque() & 63, wid = tid_opaque() >> 6, wr = wid >> 1, wc = wid & 1;
#pragma unroll
        for (int mi = 0; mi < 2; ++mi)
#pragma unroll
            for (int ni = 0; ni < 2; ++ni)
                epi(acc[mi][ni], mt * 256 + wr * 64 + mi * 32 + 4 * (lane >> 5), __builtin_amdgcn_readfirstlane(8192 + wc * 64 + ni * 32), lane);
    }
}

struct ConvPre { uint4 v0, v1, v2; float w; };
__device__ __forceinline__ void conv_prefetch(const Params& p, int item, int tid, ConvPre& r) {
    const int q = item / 48, sl = item % 48;
    const int sstart = q < 64 ? (q >> 1) * 256 : TP + ((q - 64) >> 4) * 2048;
    const int send = sstart + (q < 64 ? 256 : 2048);
    const int t0 = q * 128;
    const bf16_t* xbc = (const bf16_t*)(p.ws + WS_XBC);
    r.v0 = r.v1 = r.v2 = make_uint4(0, 0, 0, 0); r.w = 0.f;
    { const int idx = tid, row = idx >> 3, v = idx & 7; const int t = t0 - 2 + row; if (t >= sstart && t < send) r.v0 = *(const uint4*)(xbc + (size_t)t * 3072 + sl * 64 + v * 8); }
    { const int idx = tid + NT, row = idx >> 3, v = idx & 7; const int t = t0 - 2 + row; if (t >= sstart && t < send) r.v1 = *(const uint4*)(xbc + (size_t)t * 3072 + sl * 64 + v * 8); }
    { const int idx = tid + 2 * NT, row = idx >> 3, v = idx & 7; const int t = t0 - 2 + row; if (idx < 132 * 8 && t >= sstart && t < send) r.v2 = *(const uint4*)(xbc + (size_t)t * 3072 + sl * 64 + v * 8); }
    if (tid < 320) r.w = p.in[11][(tid >> 6) * 3072 + sl * 64 + (tid & 63)];
    else if (tid < 384) r.w = p.in[12][sl * 64 + (tid - 320)];
}

__device__ __forceinline__ void conv_item(const Params& p, int item, int next_item, ConvPre& pre, unsigned char* lds) {
    const int tid = tid_opaque();
    const int q = item / 48, sl = item % 48;
    bf16_t* sIn = (bf16_t*)lds;
    bf16_t* sOut = (bf16_t*)(lds + 132 * 144);
    float* sW = (float*)(lds + 132 * 144 + 128 * 144);
    __syncthreads();
    { const int idx = tid; *(uint4*)(sIn + (idx >> 3) * 72 + (idx & 7) * 8) = pre.v0; }
    { const int idx = tid + NT; *(uint4*)(sIn + (idx >> 3) * 72 + (idx & 7) * 8) = pre.v1; }
    { const int idx = tid + 2 * NT; if (idx < 132 * 8) *(uint4*)(sIn + (idx >> 3) * 72 + (idx & 7) * 8) = pre.v2; }
    if (tid < 384) sW[tid] = pre.w;
    if (next_item >= 0) conv_prefetch(p, next_item, tid, pre);
    __syncthreads();
    {
        const int j = tid >> 2, c0 = (tid & 3) * 16;
        float o[16];
#pragma unroll
        for (int c = 0; c < 16; ++c) o[c] = sW[320 + c0 + c];
#pragma unroll
        for (int k = 0; k < 5; ++k) {
            const uint4 a = *(const uint4*)(sIn + (j + k) * 72 + c0), b = *(const uint4*)(sIn + (j + k) * 72 + c0 + 8);
            const unsigned w[8] = {a.x, a.y, a.z, a.w, b.x, b.y, b.z, b.w};
#pragma unroll
            for (int u = 0; u < 8; ++u) { o[2 * u] += sW[k * 64 + c0 + 2 * u] * __uint_as_float(w[u] << 16); o[2 * u + 1] += sW[k * 64 + c0 + 2 * u + 1] * __uint_as_float(w[u] & 0xffff0000u); }
        }
        unsigned pk[8];
#pragma unroll
        for (int u = 0; u < 8; ++u) pk[u] = pk2(siluf(o[2 * u]), siluf(o[2 * u + 1]));
        *(uint4*)(sOut + j * 72 + c0) = make_uint4(pk[0], pk[1], pk[2], pk[3]);
        *(uint4*)(sOut + j * 72 + c0 + 8) = make_uint4(pk[4], pk[5], pk[6], pk[7]);
    }
    __syncthreads();
    if (sl >= 32) {
        const int s2 = sl - 32, isC = s2 >= 8, g = (s2 & 7) >> 1, nh = s2 & 1;
        bf16_t* dst = (bf16_t*)(p.ws + (isC ? WS_CM : WS_BM)) + (size_t)(q * 4 + g) * 128 * 128 + nh * 64;
#pragma unroll
        for (int i = 0; i < 2; ++i) { const int idx = tid + i * NT, j = idx >> 3, v = idx & 7; *(uint4*)(dst + (size_t)j * 128 + v * 8) = *(const uint4*)(sOut + j * 72 + v * 8); }
    }
    if (sl < 40) {
        bf16_t* dst;
        if (sl < 32) dst = (bf16_t*)(p.ws + WS_XT) + (size_t)(q * 32 + sl) * 64 * 128;
        else { const int s2 = sl - 32; dst = (bf16_t*)(p.ws + WS_BT) + (size_t)(q * 4 + (s2 >> 1)) * 128 * 128 + (size_t)(s2 & 1) * 64 * 128; }
        const int ch = tid >> 3, jv = tid & 7;
#pragma unroll
        for (int i = 0; i < 2; ++i) { const int j0 = jv * 8 + i * 64; unsigned pk[4];
#pragma unroll
            for (int u = 0; u < 4; ++u) pk[u] = (unsigned)sOut[(j0 + 2 * u) * 72 + ch] | ((unsigned)sOut[(j0 + 2 * u + 1) * 72 + ch] << 16);
            *(uint4*)(dst + (size_t)ch * 128 + j0) = make_uint4(pk[0], pk[1], pk[2], pk[3]); }
    }
}

__device__ __forceinline__ void phase_conv_f1(const Params& p, unsigned char* lds) {
    const bf16_t* csc = (const bf16_t*)(p.ws + WS_CSC);
    const bf16_t* uf = (const bf16_t*)((unsigned char*)p.out + DO_UF);
    (void)csc; (void)uf;
    ConvPre pre;
    int item = blockIdx.x;
    if (item < 96 * 48) conv_prefetch(p, item, tid_opaque(), pre);
#pragma unroll 1
    for (; item < 96 * 48; item += gridDim.x) {
        const int nxt = item + (int)gridDim.x;
        conv_item(p, item, nxt < 96 * 48 ? nxt : -1, pre, lds);
    }
}

__device__ __forceinline__ void phase_f1(const Params& p, unsigned char* lds) {
    const bf16_t* csc = (const bf16_t*)(p.ws + WS_CSC);
    const bf16_t* uf = (const bf16_t*)((unsigned char*)p.out + DO_UF);
    bf16_t* z1p = (bf16_t*)(p.ws + WS_Z1P);
    bf16_t* z1s = (bf16_t*)(p.ws + WS_Z1S);
    for (int id = blockIdx.x; id < 768; id += gridDim.x) {
        const int g = id / 192, rem = id % 192, mt = rem / 96, nt = rem % 96;
        f32x16 acc[2][2]; zero_acc<2>(acc);
        gemm_mainloop<2>(acc, csc + (size_t)mt * 256 * 256, 256, uf + (size_t)nt * 128 * 1024 + g * 256, 1024, 256, lds);
        for_each_acc<2>(acc, 0, nt * 128, [&](int chp, int t, float& v) {
            if (t < TP) { const int b = t >> 8, l = t & 255; z1p[((size_t)(b * 4 + g) * 256 + chp) * 512 + mt * 256 + l] = f2bf(v); }
            else { const int ts = t - TP, b = ts >> 11, l = ts & 2047; z1s[((size_t)(b * 4 + g) * 256 + chp) * 4096 + mt * 2048 + l] = f2bf(v); }
        });
    }
}

__device__ __forceinline__ void phase_f2(const Params& p, unsigned char* lds) {
    const bf16_t* a256 = (const bf16_t*)(p.ws + WS_A256);
    const bf16_t* apos = (const bf16_t*)((unsigned char*)p.out + DO_APOS);
    const bf16_t* z1p = (const bf16_t*)(p.ws + WS_Z1P);
    const bf16_t* z1s = (const bf16_t*)(p.ws + WS_Z1S);
    bf16_t* yfm = (bf16_t*)(p.ws + WS_YFM);
    for (int id = blockIdx.x; id < 512; id += gridDim.x) {
        if (id < 256) {
            const int bg = id >> 5, rem = id & 31, mt = rem >> 1, nt = rem & 1;
            f32x16 acc[1][2]; zero_acc<1>(acc);
            gemm_mainloop<1, 128>(acc, apos + (size_t)mt * 128 * 4096, 4096, z1s + (size_t)(bg * 256 + nt * 128) * 4096, 4096, 4096, lds);
            const int b = bg >> 2, g = bg & 3;
            for_each_acc<1>(acc, mt * 128, nt * 128, [&](int lp, int chp, float& v) { yfm[(size_t)(TP + b * 2048 + lp) * 1024 + g * 256 + chp] = f2bf(v); });
        } else {
            const int i2 = id - 256, bg = i2 >> 1, nt = i2 & 1;
            f32x16 acc[2][2]; zero_acc<2>(acc);
            gemm_mainloop<2>(acc, a256, 512, z1p + (size_t)(bg * 256 + nt * 128) * 512, 512, 512, lds);
            const int b = bg >> 2, g = bg & 3;
            for_each_acc<2>(acc, 0, nt * 128, [&](int lp, int chp, float& v) { yfm[(size_t)(b * 256 + lp) * 1024 + g * 256 + chp] = f2bf(v); });
        }
    }
}

__device__ __forceinline__ void ssd_item(const Params& p, int seq, int h, int mode, unsigned char* lds) {
    const int tid = tid_opaque(), lane = tid & 63, wid = tid >> 6;
    const bool samp = seq >= 32;
    const int nc = samp ? 16 : 2;
    const int q0 = samp ? 64 + (seq - 32) * 16 : seq * 2;
    const int g = h >> 3;
    unsigned char* sC = lds;
    unsigned char* sB = lds + 34816;
    unsigned char* sX = lds + 69632;
    unsigned char* sH = lds + 87040;
    unsigned char* sXw = lds + 104448;
    float* sCum = (float*)(lds + 121856);
    float* sDt = sCum + 128;
    const bf16_t* gXT = (const bf16_t*)(p.ws + WS_XT);
    const bf16_t* gCM = (const bf16_t*)(p.ws + WS_CM);
    const bf16_t* gBM = (const bf16_t*)(p.ws + WS_BM);
    const bf16_t* gBT = (const bf16_t*)(p.ws + WS_BT);
    const float* dtb = (const float*)(p.ws + WS_DTB);
    bf16_t* yssd = (mode == 1) ? (bf16_t*)(p.ws + WS_YSB2) - (size_t)TP * 2048 : (bf16_t*)(p.ws + WS_YSSD);
    const float Dh = p.in[15][h];
    const int npass = mode == 2 ? 2 : 1;
    const int wr = wid >> 1, wc = wid & 1;
    const int wp = wid >> 2, wn = wid & 3;
    const int l31o = lane & 31;

#pragma unroll 1
    for (int pass = 0; pass < npass; ++pass) {
        const int dir = mode == 2 ? 1 - pass : mode;
        const bool rmw = (mode == 2 && pass == 1);
        const float Aneg = -__expf(p.in[14][dir * 32 + h]);
        f32x16 hacc;
        if (samp) {
            const float* st = p.in[2 + dir] + (size_t)((seq - 32) * 32 + h) * 8192;
#pragma unroll
            for (int r = 0; r < 16; ++r) hacc[r] = st[(wp * 32 + rowmap(r, lane)) * 128 + wn * 32 + l31o];
        } else {
#pragma unroll
            for (int r = 0; r < 16; ++r) hacc[r] = 0.f;
        }
#pragma unroll 1
        for (int step = 0; step < nc; ++step) {
            int ln = lane; asm volatile("" : "+v"(ln));
            const int l31 = ln & 31, lh = ln >> 5;
            const int c = dir == 0 ? step : nc - 1 - step;
            const int q = q0 + c, t0 = q * 128;
            if (wid == 0) {
                const float d0 = dtb[(size_t)(t0 + 2 * lane) * 64 + dir * 32 + h], d1 = dtb[(size_t)(t0 + 2 * lane + 1) * 64 + dir * 32 + h];
                const float a0 = d0 * Aneg, a1 = d1 * Aneg, s = a0 + a1;
                float sc = s;
#pragma unroll
                for (int o = 1; o < 64; o <<= 1) { const float n = __shfl_up(sc, o); if (lane >= o) sc += n; }
                const float tot = __shfl(sc, 63);
                const float ex = sc - s;
                float c0 = ex + a0, c1 = ex + a0 + a1;
                if (dir == 1) { c0 = tot - c0 + a0; c1 = tot - c1 + a1; }
                sCum[2 * lane] = c0; sCum[2 * lane + 1] = c1; sDt[2 * lane] = d0; sDt[2 * lane + 1] = d1;
            }
            const bf16_t* srcC = gCM + (size_t)(q * 4 + g) * 16384;
            const bf16_t* srcB = gBM + (size_t)(q * 4 + g) * 16384;
            const bf16_t* srcBT = gBT + (size_t)(q * 4 + g) * 16384;
            const bf16_t* srcX = gXT + (size_t)(q * 32 + h) * 8192;
            const int lrow = tid >> 4, lv = tid & 15;
            const int goff = lrow * 128 + lv * 8, soff = lrow * 272 + lv * 16;
#pragma unroll
            for (int i = 0; i < 4; ++i) {
                *(uint4*)(sC + soff + i * 32 * 272) = *(const uint4*)(srcC + goff + i * 32 * 128);
                *(uint4*)(sB + soff + i * 32 * 272) = *(const uint4*)(srcB + goff + i * 32 * 128); }
            const uint4 rbt0 = *(const uint4*)(srcBT + goff), rbt1 = *(const uint4*)(srcBT + goff + 32 * 128);
            const uint4 rbt2 = *(const uint4*)(srcBT + goff + 64 * 128), rbt3 = *(const uint4*)(srcBT + goff + 96 * 128);
            bf16_t* yp = yssd + (size_t)t0 * 2048 + h * 64 + wc * 32 + l31;
            f32x16 yprev;
#pragma unroll
            for (int r = 0; r < 16; ++r) yprev[r] = 0.f;
            if (rmw) {
#pragma unroll
                for (int r = 0; r < 16; ++r) yprev[r] = bf2f(yp[(size_t)(wr * 32 + rowmap(r, ln)) * 2048]);
            }
            const uint4 rx0 = *(const uint4*)(srcX + goff), rx1 = *(const uint4*)(srcX + goff + 32 * 128);
            *(uint4*)(sX + soff) = rx0; *(uint4*)(sX + soff + 32 * 272) = rx1;
#pragma unroll
            for (int r = 0; r < 16; ++r) *(bf16_t*)(sH + (wp * 32 + rowmap(r, ln)) * 272 + (wn * 32 + l31) * 2) = f2bf(hacc[r]);
            __syncthreads();
            const float cend = dir == 0 ? sCum[127] : sCum[0];
            {
                float wj[8];
#pragma unroll
                for (int u = 0; u < 8; ++u) wj[u] = __expf(cend - sCum[lv * 8 + u]) * sDt[lv * 8 + u];
#define XW(w, a, b) pk2(__uint_as_float((w) << 16) * wj[a], __uint_as_float((w) & 0xffff0000u) * wj[b])
                *(uint4*)(sXw + soff) = make_uint4(XW(rx0.x, 0, 1), XW(rx0.y, 2, 3), XW(rx0.z, 4, 5), XW(rx0.w, 6, 7));
                *(uint4*)(sXw + soff + 32 * 272) = make_uint4(XW(rx1.x, 0, 1), XW(rx1.y, 2, 3), XW(rx1.z, 4, 5), XW(rx1.w, 6, 7));
#undef XW
            }
            f32x16 cb0, cb1, yo;
#pragma unroll
            for (int r = 0; r < 16; ++r) { cb0[r] = 0.f; cb1[r] = 0.f; yo[r] = 0.f; }
#pragma unroll 2
            for (int ks = 0; ks < 8; ++ks) {
                const int ko = ks * 32 + lh * 16;
                const bf16x8 a = *(const bf16x8*)(sC + (wr * 32 + l31) * 272 + ko);
                const bf16x8 b0 = *(const bf16x8*)(sB + (wc * 64 + l31) * 272 + ko);
                const bf16x8 b1 = *(const bf16x8*)(sB + (wc * 64 + 32 + l31) * 272 + ko);
                const bf16x8 bh = *(const bf16x8*)(sH + (wc * 32 + l31) * 272 + ko);
                cb0 = __builtin_amdgcn_mfma_f32_32x32x16_bf16(a, b0, cb0, 0, 0, 0);
                cb1 = __builtin_amdgcn_mfma_f32_32x32x16_bf16(a, b1, cb1, 0, 0, 0);
                yo = __builtin_amdgcn_mfma_f32_32x32x16_bf16(a, bh, yo, 0, 0, 0);
            }
            {
                const int j0 = wc * 64 + l31, j1 = j0 + 32;
                const float cj0 = sCum[j0], cj1 = sCum[j1], dj0 = sDt[j0], dj1 = sDt[j1];
#pragma unroll
                for (int r = 0; r < 16; ++r) {
                    const int i = wr * 32 + rowmap(r, ln); const float ci = sCum[i];
                    const bool v0 = dir == 0 ? (j0 <= i) : (j0 >= i), v1 = dir == 0 ? (j1 <= i) : (j1 >= i);
                    float m0 = v0 ? cb0[r] * __expf(ci - cj0) * dj0 : 0.f;
                    float m1 = v1 ? cb1[r] * __expf(ci - cj1) * dj1 : 0.f;
                    if (dir == 0) { if (i == j0) m0 += Dh; if (i == j1) m1 += Dh; }
                    cb0[r] = m0; cb1[r] = m1;
                    yo[r] *= __expf(ci);
                }
            }
            __syncthreads();
            {
                const int j0 = wc * 64 + l31;
#pragma unroll
                for (int r = 0; r < 16; ++r) { const int i = wr * 32 + rowmap(r, ln);
                    *(bf16_t*)(sB + i * 272 + j0 * 2) = f2bf(cb0[r]); *(bf16_t*)(sB + i * 272 + (j0 + 32) * 2) = f2bf(cb1[r]); }
                *(uint4*)(sC + soff) = rbt0; *(uint4*)(sC + soff + 32 * 272) = rbt1; *(uint4*)(sC + soff + 64 * 272) = rbt2; *(uint4*)(sC + soff + 96 * 272) = rbt3;
            }
            __syncthreads();
            const float cdec = __expf(cend);
#pragma unroll
            for (int r = 0; r < 16; ++r) hacc[r] *= cdec;
#pragma unroll 2
            for (int ks = 0; ks < 8; ++ks) {
                const int ko = ks * 32 + lh * 16;
                const bf16x8 am = *(const bf16x8*)(sB + (wr * 32 + l31) * 272 + ko);
                const bf16x8 bx = *(const bf16x8*)(sX + (wc * 32 + l31) * 272 + ko);
                yo = __builtin_amdgcn_mfma_f32_32x32x16_bf16(am, bx, yo, 0, 0, 0);
                const bf16x8 ax = *(const bf16x8*)(sXw + (wp * 32 + l31) * 272 + ko);
                const bf16x8 bb = *(const bf16x8*)(sC + (wn * 32 + l31) * 272 + ko);
                hacc = __builtin_amdgcn_mfma_f32_32x32x16_bf16(ax, bb, hacc, 0, 0, 0);
            }
            {
#pragma unroll
                for (int r = 0; r < 16; ++r) { const int i = wr * 32 + rowmap(r, ln); yp[(size_t)i * 2048] = f2bf(yo[r] + yprev[r]); }
            }
            __syncthreads();
        }
        if (!samp) {
            float* dst = p.out + (size_t)T * 1024 + (size_t)dir * 8388608 + (size_t)(seq * 32 + h) * 8192;
#pragma unroll
            for (int r = 0; r < 16; ++r) dst[(wp * 32 + rowmap(r, lane)) * 128 + wn * 32 + l31o] = hacc[r];
        }
    }
}

template <bool ALPHA, bool BETA>
__device__ __forceinline__ void ssd_cstep(const Params& p, unsigned char* lds, int q, int h, float AnegF, float AnegB, float Dh,
                                          const f32x16& enter, int enterDir, bool scaleB, f32x16& accF, f32x16& accB, float& piF) {
    const int tid = tid_opaque(), lane = tid & 63, wid = tid >> 6;
    const int g = h >> 3, t0 = q * 128;
    unsigned char* sC = lds;
    unsigned char* sB = lds + 34816;
    unsigned char* sX = lds + 69632;
    unsigned char* sH = lds + 87040;
    unsigned char* sXwF = lds + 104448;
    unsigned char* sXwB = lds + 121856;
    float* sCumF = (float*)(lds + 139264);
    float* sCumB = sCumF + 128;
    float* sDtF = sCumF + 256;
    float* sDtB = sCumF + 384;
    const bf16_t* srcC = (const bf16_t*)(p.ws + WS_CM) + (size_t)(q * 4 + g) * 16384;
    const bf16_t* srcB = (const bf16_t*)(p.ws + WS_BM) + (size_t)(q * 4 + g) * 16384;
    const bf16_t* srcBT = (const bf16_t*)(p.ws + WS_BT) + (size_t)(q * 4 + g) * 16384;
    const bf16_t* srcX = (const bf16_t*)(p.ws + WS_XT) + (size_t)(q * 32 + h) * 8192;
    const float* dtb = (const float*)(p.ws + WS_DTB);
    bf16_t* yssd = (bf16_t*)(p.ws + WS_YSSD);
    const int wr = wid >> 1, wc = wid & 1, wp = wid >> 2, wn = wid & 3;
    const int l31 = lane & 31, lh = lane >> 5;
    if (wid == 0) {
        const float f0 = dtb[(size_t)(t0 + 2 * lane) * 64 + h], f1 = dtb[(size_t)(t0 + 2 * lane + 1) * 64 + h];
        const float b0 = dtb[(size_t)(t0 + 2 * lane) * 64 + 32 + h], b1 = dtb[(size_t)(t0 + 2 * lane + 1) * 64 + 32 + h];
        const float af0 = f0 * AnegF, af1 = f1 * AnegF, ab0 = b0 * AnegB, ab1 = b1 * AnegB;
        float sf = af0 + af1, sb = ab0 + ab1;
        const float sf0 = sf, sb0 = sb;
#pragma unroll
        for (int o = 1; o < 64; o <<= 1) { const float nf = __shfl_up(sf, o), nb = __shfl_up(sb, o); if (lane >= o) { sf += nf; sb += nb; } }
        const float totb = __shfl(sb, 63);
        const float exf = sf - sf0, exb = sb - sb0;
        sCumF[2 * lane] = exf + af0; sCumF[2 * lane + 1] = exf + af0 + af1;
        sCumB[2 * lane] = totb - exb; sCumB[2 * lane + 1] = totb - exb - ab0;
        sDtF[2 * lane] = f0; sDtF[2 * lane + 1] = f1; sDtB[2 * lane] = b0; sDtB[2 * lane + 1] = b1;
    }
    const int lrow = tid >> 4, lv = tid & 15;
    const int goff = lrow * 128 + lv * 8, soff = lrow * 272 + lv * 16;
    if (BETA) {
#pragma unroll
        for (int i = 0; i < 4; ++i) {
            *(uint4*)(sC + soff + i * 32 * 272) = *(const uint4*)(srcC + goff + i * 32 * 128);
            *(uint4*)(sB + soff + i * 32 * 272) = *(const uint4*)(srcB + goff + i * 32 * 128); }
    }
    uint4 rbt0 = make_uint4(0, 0, 0, 0), rbt1 = rbt0, rbt2 = rbt0, rbt3 = rbt0;
    if (ALPHA) {
        rbt0 = *(const uint4*)(srcBT + goff); rbt1 = *(const uint4*)(srcBT + goff + 32 * 128);
        rbt2 = *(const uint4*)(srcBT + goff + 64 * 128); rbt3 = *(const uint4*)(srcBT + goff + 96 * 128);
        if (!BETA) { *(uint4*)(sC + soff) = rbt0; *(uint4*)(sC + soff + 32 * 272) = rbt1; *(uint4*)(sC + soff + 64 * 272) = rbt2; *(uint4*)(sC + soff + 96 * 272) = rbt3; }
    }
    const uint4 rx0 = *(const uint4*)(srcX + goff), rx1 = *(const uint4*)(srcX + goff + 32 * 128);
    if (BETA) {
        *(uint4*)(sX + soff) = rx0; *(uint4*)(sX + soff + 32 * 272) = rx1;
#pragma unroll
        for (int r = 0; r < 16; ++r) *(bf16_t*)(sH + (wp * 32 + rowmap(r, lane)) * 272 + (wn * 32 + l31) * 2) = f2bf(enter[r]);
    }
    __syncthreads();
    const float pF = __expf(sCumF[127]), pB = __expf(sCumB[0]);
    if (ALPHA) {
        float wf[8], wb[8];
#pragma unroll
        for (int u = 0; u < 8; ++u) { wf[u] = __expf(sCumF[127] - sCumF[lv * 8 + u]) * sDtF[lv * 8 + u]; wb[u] = __expf(sCumB[0] - sCumB[lv * 8 + u]) * sDtB[lv * 8 + u]; }
#define XWF(w, a, b) pk2(__uint_as_float((w) << 16) * wf[a], __uint_as_float((w) & 0xffff0000u) * wf[b])
#define XWB(w, a, b) pk2(__uint_as_float((w) << 16) * wb[a], __uint_as_float((w) & 0xffff0000u) * wb[b])
        *(uint4*)(sXwF + soff) = make_uint4(XWF(rx0.x, 0, 1), XWF(rx0.y, 2, 3), XWF(rx0.z, 4, 5), XWF(rx0.w, 6, 7));
        *(uint4*)(sXwF + soff + 32 * 272) = make_uint4(XWF(rx1.x, 0, 1), XWF(rx1.y, 2, 3), XWF(rx1.z, 4, 5), XWF(rx1.w, 6, 7));
        *(uint4*)(sXwB + soff) = make_uint4(XWB(rx0.x, 0, 1), XWB(rx0.y, 2, 3), XWB(rx0.z, 4, 5), XWB(rx0.w, 6, 7));
        *(uint4*)(sXwB + soff + 32 * 272) = make_uint4(XWB(rx1.x, 0, 1), XWB(rx1.y, 2, 3), XWB(rx1.z, 4, 5), XWB(rx1.w, 6, 7));
#undef XWF
#undef XWB
    }
    f32x16 yo;
#pragma unroll
    for (int r = 0; r < 16; ++r) yo[r] = 0.f;
    if (BETA) {
        f32x16 cb0, cb1;
#pragma unroll
        for (int r = 0; r < 16; ++r) { cb0[r] = 0.f; cb1[r] = 0.f; }
#pragma unroll 2
        for (int ks = 0; ks < 8; ++ks) {
            const int ko = ks * 32 + lh * 16;
            const bf16x8 a = *(const bf16x8*)(sC + (wr * 32 + l31) * 272 + ko);
            const bf16x8 b0 = *(const bf16x8*)(sB + (wc * 64 + l31) * 272 + ko);
            const bf16x8 b1 = *(const bf16x8*)(sB + (wc * 64 + 32 + l31) * 272 + ko);
            const bf16x8 bh = *(const bf16x8*)(sH + (wc * 32 + l31) * 272 + ko);
            cb0 = __builtin_amdgcn_mfma_f32_32x32x16_bf16(a, b0, cb0, 0, 0, 0);
            cb1 = __builtin_amdgcn_mfma_f32_32x32x16_bf16(a, b1, cb1, 0, 0, 0);
            yo = __builtin_amdgcn_mfma_f32_32x32x16_bf16(a, bh, yo, 0, 0, 0);
        }
        {
            const int j0 = wc * 64 + l31, j1 = j0 + 32;
            const float fj0 = sCumF[j0], fj1 = sCumF[j1], bj0 = sCumB[j0], bj1 = sCumB[j1];
            const float df0 = sDtF[j0], df1 = sDtF[j1], db0 = sDtB[j0], db1 = sDtB[j1];
            const float* sCe = enterDir == 0 ? sCumF : sCumB;
#pragma unroll
            for (int r = 0; r < 16; ++r) {
                const int i = wr * 32 + rowmap(r, lane); const float fi = sCumF[i], bi = sCumB[i];
                const float e0 = j0 <= i ? __expf(fi - fj0) * df0 : 0.f, g0 = j0 >= i ? __expf(bi - bj0) * db0 : 0.f;
                const float e1 = j1 <= i ? __expf(fi - fj1) * df1 : 0.f, g1 = j1 >= i ? __expf(bi - bj1) * db1 : 0.f;
                float m0 = cb0[r] * (e0 + g0), m1 = cb1[r] * (e1 + g1);
                if (i == j0) m0 += Dh;
                if (i == j1) m1 += Dh;
                cb0[r] = m0; cb1[r] = m1;
                yo[r] *= __expf(sCe[i]);
            }
        }
        __syncthreads();
        {
            const int j0 = wc * 64 + l31;
#pragma unroll
            for (int r = 0; r < 16; ++r) { const int i = wr * 32 + rowmap(r, lane);
                *(bf16_t*)(sB + i * 272 + j0 * 2) = f2bf(cb0[r]); *(bf16_t*)(sB + i * 272 + (j0 + 32) * 2) = f2bf(cb1[r]); }
            if (ALPHA) { *(uint4*)(sC + soff) = rbt0; *(uint4*)(sC + soff + 32 * 272) = rbt1; *(uint4*)(sC + soff + 64 * 272) = rbt2; *(uint4*)(sC + soff + 96 * 272) = rbt3; }
        }
    }
    __syncthreads();
    if (ALPHA) {
        if (scaleB) {
#pragma unroll
            for (int r = 0; r < 16; ++r) accB[r] *= pB;
        }
    }
#pragma unroll 2
    for (int ks = 0; ks < 8; ++ks) {
        const int ko = ks * 32 + lh * 16;
        if (BETA) {
            const bf16x8 am = *(const bf16x8*)(sB + (wr * 32 + l31) * 272 + ko);
            const bf16x8 bx = *(const bf16x8*)(sX + (wc * 32 + l31) * 272 + ko);
            yo = __builtin_amdgcn_mfma_f32_32x32x16_bf16(am, bx, yo, 0, 0, 0);
        }
        if (ALPHA) {
            const bf16x8 bb = *(const bf16x8*)(sC + (wn * 32 + l31) * 272 + ko);
            const bf16x8 axf = *(const bf16x8*)(sXwF + (wp * 32 + l31) * 272 + ko);
            const bf16x8 axb = *(const bf16x8*)(sXwB + (wp * 32 + l31) * 272 + ko);
            accF = __builtin_amdgcn_mfma_f32_32x32x16_bf16(axf, bb, accF, 0, 0, 0);
            accB = __builtin_amdgcn_mfma_f32_32x32x16_bf16(axb, bb, accB, 0, 0, 0);
        }
    }
    if (BETA) {
        bf16_t* yp = yssd + (size_t)t0 * 2048 + h * 64 + wc * 32 + l31;
#pragma unroll
        for (int r = 0; r < 16; ++r) { const int i = wr * 32 + rowmap(r, lane); yp[(size_t)i * 2048] = f2bf(yo[r]); }
    }
    piF = pF;
    __syncthreads();
}

__device__ __forceinline__ void ssd_prompt_item(const Params& p, int seq, int h, unsigned char* lds) {
    const int lane = tid_opaque() & 63, wid = tid_opaque() >> 6, wp = wid >> 2, wn = wid & 3, l31 = lane & 31;
    const float AnegF = -__expf(p.in[14][h]), AnegB = -__expf(p.in[14][32 + h]), Dh = p.in[15][h];
    const int q0 = seq * 2;
    f32x16 SF1, SB, SF0, zero;
#pragma unroll
    for (int r = 0; r < 16; ++r) { SF1[r] = 0.f; SB[r] = 0.f; SF0[r] = 0.f; zero[r] = 0.f; }
    float piF1 = 1.f, piF0 = 1.f;
    ssd_cstep<true, false>(p, lds, q0 + 1, h, AnegF, AnegB, Dh, zero, 0, false, SF1, SB, piF1);
    ssd_cstep<true, true>(p, lds, q0, h, AnegF, AnegB, Dh, SB, 1, true, SF0, SB, piF0);
    {
        float* dstF = p.out + (size_t)T * 1024 + (size_t)(seq * 32 + h) * 8192;
        float* dstB = dstF + 8388608;
#pragma unroll
        for (int r = 0; r < 16; ++r) { const int o = (wp * 32 + rowmap(r, lane)) * 128 + wn * 32 + l31; dstF[o] = SF0[r] * piF1 + SF1[r]; dstB[o] = SB[r]; }
    }
    ssd_cstep<false, true>(p, lds, q0 + 1, h, AnegF, AnegB, Dh, SF0, 0, false, SF1, SB, piF0);
}

__device__ __forceinline__ void phase_ssd(const Params& p, unsigned char* lds) {
    const int G = gridDim.x, b = blockIdx.x;
    const bool bal = (G == 256);
    if (!bal || b < 128) {
#pragma unroll 1
        for (int v = b; v < 128; v += G) ssd_item(p, 32 + (v >> 6), v & 31, (v >> 5) & 1, lds);
    }
    const int p0 = bal ? (b < 128 ? 896 + b : (b - 128) * 7) : b, pstep = bal ? 1 : G, pend = bal ? (b < 128 ? 897 + b : (b - 128) * 7 + 7) : 1024;
#pragma unroll 1
    for (int pi = p0; pi < pend; pi += pstep) ssd_prompt_item(p, pi >> 5, pi & 31, lds);
}

__device__ __forceinline__ void phase_combine(const Params& p) {
    const int lane = tid_opaque() & 63, wid = tid_opaque() >> 6;
    bf16_t* yssd = (bf16_t*)(p.ws + WS_YSSD);
    const bf16_t* zs = (const bf16_t*)(p.ws + WS_ZS);
    const bf16_t* ysb2 = (const bf16_t*)(p.ws + WS_YSB2);
    const float* g = p.in[16];
    for (int t = blockIdx.x * 8 + wid; t < T; t += gridDim.x * 8) {
        float y[32]; float ss = 0.f;
#pragma unroll
        for (int i = 0; i < 4; ++i) { const int c = i * 512 + lane * 8;
            const uint4 a = *(const uint4*)(yssd + (size_t)t * 2048 + c), b = *(const uint4*)(zs + (size_t)t * 2048 + c);
            uint4 a2 = make_uint4(0u, 0u, 0u, 0u);
            if (t >= TP) a2 = *(const uint4*)(ysb2 + (size_t)(t - TP) * 2048 + c);
            const unsigned aw[4] = {a.x, a.y, a.z, a.w}, bw[4] = {b.x, b.y, b.z, b.w}, cw[4] = {a2.x, a2.y, a2.z, a2.w};
#pragma unroll
            for (int u = 0; u < 4; ++u) { const float y0 = (__uint_as_float(aw[u] << 16) + __uint_as_float(cw[u] << 16)) * siluf(__uint_as_float(bw[u] << 16)), y1 = (__uint_as_float(aw[u] & 0xffff0000u) + __uint_as_float(cw[u] & 0xffff0000u)) * siluf(__uint_as_float(bw[u] & 0xffff0000u));
                y[i * 8 + 2 * u] = y0; y[i * 8 + 2 * u + 1] = y1; ss += y0 * y0 + y1 * y1; } }
#pragma unroll
        for (int o = 32; o > 0; o >>= 1) ss += __shfl_xor(ss, o);
        const float rstd = rsqrtf(ss * (1.f / 2048.f) + 1e-6f);
#pragma unroll
        for (int i = 0; i < 4; ++i) { const int c = i * 512 + lane * 8; const float4 g0 = *(const float4*)(g + c), g1 = *(const float4*)(g + c + 4);
            *(uint4*)(yssd + (size_t)t * 2048 + c) = make_uint4(pk2(y[i * 8] * rstd * g0.x, y[i * 8 + 1] * rstd * g0.y), pk2(y[i * 8 + 2] * rstd * g0.z, y[i * 8 + 3] * rstd * g0.w),
                                                                pk2(y[i * 8 + 4] * rstd * g1.x, y[i * 8 + 5] * rstd * g1.y), pk2(y[i * 8 + 6] * rstd * g1.z, y[i * 8 + 7] * rstd * g1.w)); }
    }
}

struct EpiMerge {
    static constexpr bool PERM = true, AFTER_DRAIN = false;
    bf16_t* m; const bf16_t* gates; int second;
    __device__ __forceinline__ void operator()(const pg8::f32x4 (&acc)[2][2][4][2], const pg8::Unit& u, int wr, int wc, int fr, int fq) const {
#pragma unroll
        for (int ai = 0; ai < 2; ++ai)
#pragma unroll
            for (int mm = 0; mm < 4; ++mm) {
                const int row = u.pm * 256 + ai * 128 + wr * 64 + mm * 16 + fr;
#pragma unroll
                for (int bj = 0; bj < 2; ++bj) {
                    const int col = u.pn * 256 + bj * 128 + wc * 32 + 8 * fq;
                    const pg8::f32x4 v0 = acc[ai][bj][mm][0], v1 = acc[ai][bj][mm][1];
                    const uint4 gq = *(const uint4*)(gates + (size_t)row * 2048 + (second ? 1024 : 0) + col);
                    const float4 g0 = bf4_to_f4(make_uint2(gq.x, gq.y)), g1 = bf4_to_f4(make_uint2(gq.z, gq.w));
                    uint4* d = (uint4*)(m + (size_t)row * 1024 + col);
                    float4 o0 = make_float4(0.f, 0.f, 0.f, 0.f), o1 = o0;
                    if (second) { const uint4 oq = *d; o0 = bf4_to_f4(make_uint2(oq.x, oq.y)); o1 = bf4_to_f4(make_uint2(oq.z, oq.w)); }
                    *d = make_uint4(pk2(o0.x + v0[0] * g0.x, o0.y + v0[1] * g0.y), pk2(o0.z + v0[2] * g0.z, o0.w + v0[3] * g0.w),
                                    pk2(o1.x + v1[0] * g1.x, o1.y + v1[1] * g1.y), pk2(o1.z + v1[2] * g1.z, o1.w + v1[3] * g1.w));
                }
            }
    }
};

struct EpiGateBf16 {
    static constexpr bool PERM = true, AFTER_DRAIN = false;
    bf16_t* R; const float* mod; int gate_off;
    __device__ __forceinline__ void operator()(const pg8::f32x4 (&acc)[2][2][4][2], const pg8::Unit& u, int wr, int wc, int fr, int fq) const {
#pragma unroll
        for (int ai = 0; ai < 2; ++ai)
#pragma unroll
            for (int mm = 0; mm < 4; ++mm) {
                const int row = u.pm * 256 + ai * 128 + wr * 64 + mm * 16 + fr;
                const float* gp = mod + modidx(row) * 6144 + gate_off;
#pragma unroll
                for (int bj = 0; bj < 2; ++bj) {
                    const int col = u.pn * 256 + bj * 128 + wc * 32 + 8 * fq;
                    const pg8::f32x4 v0 = acc[ai][bj][mm][0], v1 = acc[ai][bj][mm][1];
                    const float4 g0 = *(const float4*)(gp + col), g1 = *(const float4*)(gp + col + 4);
                    *(uint4*)(R + (size_t)row * 1024 + col) = make_uint4(pk2(g0.x * v0[0], g0.y * v0[1]), pk2(g0.z * v0[2], g0.w * v0[3]), pk2(g1.x * v1[0], g1.y * v1[1]), pk2(g1.z * v1[2], g1.w * v1[3]));
                }
            }
    }
};

struct EpiResid {
    static constexpr bool PERM = false, AFTER_DRAIN = false;
    float* out; const float* xp; const float* xs; const float* mod; int gate_off; int inplace;
    __device__ __forceinline__ void operator()(const pg8::f32x4 (&acc)[2][2][4][2], const pg8::Unit& u, int wr, int wc, int fr, int fq) const {
#pragma unroll
        for (int ai = 0; ai < 2; ++ai)
#pragma unroll
            for (int mm = 0; mm < 4; ++mm) {
                const int row = u.pm * 256 + ai * 128 + wr * 64 + mm * 16 + fr;
                const float* gp = mod + modidx(row) * 6144 + gate_off;
                float* orow = out + (size_t)row * 1024;
                const float* brow = inplace ? orow : (row < TP ? xp + (size_t)row * 1024 : xs + (size_t)(row - TP) * 1024);
#pragma unroll
                for (int bj = 0; bj < 2; ++bj)
#pragma unroll
                    for (int n = 0; n < 2; ++n) {
                        const int col = u.pn * 256 + bj * 128 + wc * 32 + 16 * n + 4 * fq;
                        const pg8::f32x4 v = acc[ai][bj][mm][n];
                        const float4 x = *(const float4*)(brow + col), g = *(const float4*)(gp + col);
                        *(float4*)(orow + col) = make_float4(x.x + g.x * v[0], x.y + g.y * v[1], x.z + g.z * v[2], x.w + g.w * v[3]);
                    }
            }
    }
};

__device__ __forceinline__ void phase_merge(const Params& p, unsigned char* lds) {
    const bf16_t* gates = (const bf16_t*)((unsigned char*)p.out + DO_GATES);
    bf16_t* m = (bf16_t*)(p.ws + WS_M);
    pg8::StaticOrder S; S.init(T, 1024, (int)gridDim.x, (int)blockIdx.x);
    if (gridDim.x == 256 && blockIdx.x >= 192) {
#pragma unroll 1
        for (int tI = 2832 + ((int)blockIdx.x - 192); tI < 5136; tI += 64) transpose_tile(p, tI, lds);
        return;
    }
    {
        pg8::Gemm g{(const bf16_t*)(p.ws + WS_YFM), (const bf16_t*)(p.ws + WS_WF), T, 1024, 1024};
        EpiMerge E{m, gates, 0};
        pg8::gemm_phase<EpiMerge, pg8::StaticOrder, false>((PG8_LAS unsigned char*)lds, g, S, E, nullptr);
    }
    {
        pg8::Gemm g{(const bf16_t*)(p.ws + WS_YSSD), (const bf16_t*)(p.ws + WS_WSO), T, 1024, 2048};
        EpiMerge E{m, gates, 1};
        pg8::gemm_phase<EpiMerge, pg8::StaticOrder, false>((PG8_LAS unsigned char*)lds, g, S, E, nullptr);
    }
}

__device__ __forceinline__ void phase_out(const Params& p, unsigned char* lds) {
    pg8::Gemm g{(const bf16_t*)(p.ws + WS_M), (const bf16_t*)(p.ws + WS_WO), T, 1024, 1024};
    pg8::StaticOrder S; S.init(T, 1024, (int)gridDim.x, (int)blockIdx.x);
    EpiGateBf16 E{(bf16_t*)(p.ws + WS_R), (const float*)(p.ws + WS_MOD), 2048};
    pg8::gemm_phase<EpiGateBf16, pg8::StaticOrder, false>((PG8_LAS unsigned char*)lds, g, S, E, nullptr);
}

struct EpiFF1 {
    static constexpr bool PERM = true, AFTER_DRAIN = false;
    bf16_t* f;
    __device__ __forceinline__ void operator()(const pg8::f32x4 (&acc)[2][2][4][2], const pg8::Unit& u, int wr, int wc, int fr, int fq) const {
#pragma unroll
        for (int ai = 0; ai < 2; ++ai)
#pragma unroll
            for (int m = 0; m < 4; ++m) {
                bf16_t* rowp = f + (size_t)(u.pm * 256 + ai * 128 + wr * 64 + m * 16 + fr) * 4096 + u.pn * 256 + wc * 32 + 8 * fq;
#pragma unroll
                for (int bj = 0; bj < 2; ++bj) {
                    const pg8::f32x4 v0 = acc[ai][bj][m][0], v1 = acc[ai][bj][m][1];
                    const float r0 = fmaxf(v0[0], 0.f), r1 = fmaxf(v0[1], 0.f), r2 = fmaxf(v0[2], 0.f), r3 = fmaxf(v0[3], 0.f);
                    const float r4 = fmaxf(v1[0], 0.f), r5 = fmaxf(v1[1], 0.f), r6 = fmaxf(v1[2], 0.f), r7 = fmaxf(v1[3], 0.f);
                    *(uint4*)(rowp + bj * 128) = make_uint4(pk2(r0 * r0, r1 * r1), pk2(r2 * r2, r3 * r3), pk2(r4 * r4, r5 * r5), pk2(r6 * r6, r7 * r7));
                }
            }
    }
};

__device__ __forceinline__ void phase_ff1(const Params& p, unsigned char* lds) {
    pg8::Gemm g{(const bf16_t*)(p.ws + WS_H2), (const bf16_t*)(p.ws + WS_W1), T, 4096, 1024};
    pg8::StaticOrder S; S.init(T, 4096, (int)gridDim.x, (int)blockIdx.x);
    EpiFF1 E{(bf16_t*)(p.ws + WS_F)};
    pg8::gemm_phase<EpiFF1, pg8::StaticOrder, false>((PG8_LAS unsigned char*)lds, g, S, E, nullptr);
}

__device__ __forceinline__ void phase_ff2(const Params& p, unsigned char* lds) {
    pg8::Gemm g{(const bf16_t*)(p.ws + WS_F), (const bf16_t*)(p.ws + WS_W2), T, 1024, 4096};
    pg8::StaticOrder S; S.init(T, 1024, (int)gridDim.x, (int)blockIdx.x);
    EpiGateBf16 E{(bf16_t*)(p.ws + WS_R), (const float*)(p.ws + WS_MOD), 5120};
    pg8::gemm_phase<EpiGateBf16, pg8::StaticOrder, false>((PG8_LAS unsigned char*)lds, g, S, E, nullptr);
}

__global__ void __launch_bounds__(NT) fwd_megakernel(Params p) {
    extern __shared__ __attribute__((aligned(16))) unsigned char lds[];
    cg::grid_group grid = cg::this_grid();
    if (__builtin_amdgcn_workitem_id_x() == 0) *(uint4*)(lds + LDS_ST) = make_uint4(0u, 0u, 0u, 0u);
    __syncthreads();
    XcdBarrier xb = xcd_barrier_post((unsigned*)(p.ws + WS_BAR), (volatile LAS unsigned*)(lds + LDS_ST));
#define RUN(k, call) if (PH_ON(k) && p.ph_lo <= (k) && (k) < p.ph_hi) { call; } if ((k) == REPEAT_PH) { call; } if (p.ph_lo <= (k) && (k) + 1 < p.ph_hi) { if (p.ph_hi > 100) grid.sync(); else xcd_barrier(xb); }
    RUN(0, phase_prep(p, lds))
    RUN(1, phase_norm(p, 0))
    RUN(2, phase_inproj(p, lds))
    RUN(3, phase_conv_f1(p, lds))
    RUN(4, phase_f1(p, lds))
    RUN(5, phase_f2(p, lds))
    RUN(6, phase_ssd(p, lds))
    RUN(7, phase_combine(p))
    RUN(8, phase_merge(p, lds))
    RUN(9, phase_out(p, lds))
    RUN(10, phase_norm(p, 1))
    RUN(11, phase_ff1(p, lds))
    RUN(12, phase_ff2(p, lds))
    if (PH_ON(13) && p.ph_lo <= 13 && 13 < p.ph_hi) phase_norm(p, 2);
}

extern "C" void kernel_launch(void* const* d_in, const int* in_sizes, int n_in, void* d_out, int out_size, void* d_ws, size_t ws_size, hipStream_t stream) {
    static int grid_blocks = 0;
    if (grid_blocks == 0) {
        if (n_in != 23 || ws_size < WS_END || out_size != T * 1024 + 2 * 8388608) { fprintf(stderr, "kernel_launch: unexpected shapes (n_in %d, ws %zu, out %d)\n", n_in, ws_size, out_size); grid_blocks = -1; return; }
        int dev = 0, cus = 0, per_cu = 0;
        (void)hipGetDevice(&dev);
        (void)hipDeviceGetAttribute(&cus, hipDeviceAttributeMultiprocessorCount, dev);
        if (hipFuncSetAttribute((const void*)fwd_megakernel, hipFuncAttributeMaxDynamicSharedMemorySize, LDS_BYTES) != hipSuccess) { fprintf(stderr, "kernel_launch: hipFuncSetAttribute failed\n"); grid_blocks = -1; return; }
        if (hipOccupancyMaxActiveBlocksPerMultiprocessor(&per_cu, (const void*)fwd_megakernel, NT, LDS_BYTES) != hipSuccess || per_cu < 1) { fprintf(stderr, "kernel_launch: occupancy query failed (%d)\n", per_cu); grid_blocks = -1; return; }
        grid_blocks = cus * per_cu;
    }
    if (grid_blocks < 0) return;
    Params p{};
    for (int i = 0; i < 23; ++i) p.in[i] = (const float*)d_in[i];
    p.out = (float*)d_out; p.ws = (unsigned char*)d_ws;
    if (hipMemsetAsync((unsigned char*)d_ws + WS_BAR, 0, XCD_BAR_WORDS * 4, stream) != hipSuccess) { fprintf(stderr, "kernel_launch: memset failed\n"); return; }
#if ONE_LAUNCH
    p.ph_lo = 0; p.ph_hi = NPH + 1;
    void* args[] = {&p};
    hipError_t e = hipLaunchCooperativeKernel((const void*)fwd_megakernel, dim3(grid_blocks), dim3(NT), args, LDS_BYTES, stream);
    if (e != hipSuccess) fprintf(stderr, "cooperative launch failed: %s (grid %d)\n", hipGetErrorString(e), grid_blocks);
#else
    for (int ph = 0; ph <= NPH; ++ph) {
        p.ph_lo = ph; p.ph_hi = ph + 1;
        hipLaunchKernelGGL(fwd_megakernel, dim3(grid_blocks), dim3(NT), LDS_BYTES, stream, p);
    }
#endif
}
```
